# Optimizing an MI355X kernel written in HIP

```python
import math
import jax
import jax.numpy as jnp
from jax import lax
import numpy as np

D_MODEL = 2048
BATCH = 16
SEQ = 2048
DEPTH = 2

CONV_WIDTH = 3
CONV_CHANNELS = D_MODEL // 2
RET_HEADS = 4
RET_HEAD_DIM = (D_MODEL // 2) // RET_HEADS
RET_CHUNK = 128
ATT_HEADS = 16
ATT_HEAD_DIM = D_MODEL // ATT_HEADS
IDX_HEADS = 16
IDX_DIM = 64
DSA_TOPK_MAX = 256
Q_BLOCK = 128
N_BUCKETS = 32
MAX_DISTANCE = 128
N_EXPERTS = 16
N_GROUPS = 4
EXPERTS_PER_GROUP = N_EXPERTS // N_GROUPS
TOP_K = 2
D_EXPERT = D_MODEL // 2
MOE_BLOCK = 128
RMS_EPS = 1e-6

kernel_name = 'hybrid_conv_retention_dsa_moe_block'


def rms_norm(x):
    xf = x.astype(jnp.float32)
    return (xf * lax.rsqrt(jnp.mean(xf * xf, axis=-1, keepdims=True) + RMS_EPS)).astype(x.dtype)


def ada_pre(x, cond, norm_w, ada_w, ada_b):
    mod = jax.nn.silu(cond) @ ada_w + ada_b
    shift, scale, gate = jnp.split(mod, 3, axis=-1)
    h = rms_norm(x) * norm_w * (1.0 + scale[:, None, :]) + shift[:, None, :]
    return h, gate[:, None, :]


def rotary(x, pos):
    half = x.shape[-1] // 2
    inv = 1.0 / (10000.0 ** jnp.linspace(0.0, 1.0, half, dtype=jnp.float32))
    ang = pos.astype(jnp.float32)[:, None] * inv[None, :]
    cos = jnp.cos(ang)[None, :, None, :]
    sin = jnp.sin(ang)[None, :, None, :]
    x1, x2 = x[..., :half], x[..., half:]
    return jnp.concatenate([x1 * cos - x2 * sin, x1 * sin + x2 * cos], axis=-1).astype(x.dtype)


def retention_chunkwise(q, k, v):
    bsz, seq, nh, dk = q.shape
    dv = v.shape[-1]
    nc = seq // RET_CHUNK
    log_g = jnp.log(1.0 - 2.0 ** (-5.0 - jnp.arange(nh, dtype=jnp.float32)))
    i = jnp.arange(RET_CHUNK, dtype=jnp.float32)
    diff = i[:, None] - i[None, :]
    d_intra = jnp.where(diff >= 0, jnp.exp(log_g[:, None, None] * jnp.maximum(diff, 0.0)), 0.0)
    d_cross = jnp.exp(log_g[:, None] * (i[None, :] + 1.0))
    d_state = jnp.exp(log_g[:, None] * (RET_CHUNK - 1.0 - i[None, :]))
    g_chunk = jnp.exp(log_g * RET_CHUNK)

    def chunks(a):
        return a.reshape(bsz, nc, RET_CHUNK, nh, a.shape[-1]).transpose(1, 0, 3, 2, 4)

    def step(state, inp):
        qc, kc, vc = inp
        intra = jnp.einsum('bhid,bhjd->bhij', qc, kc) * d_intra
        out = (jnp.einsum('bhij,bhje->bhie', intra, vc)
               + jnp.einsum('bhid,bhde->bhie', qc, state) * d_cross[..., None])
        state = state * g_chunk[:, None, None] + jnp.einsum('bhjd,bhje->bhde', kc * d_state[..., None], vc)
        return state, out

    state0 = jnp.zeros((bsz, nh, dk, dv), jnp.float32)
    _, out = lax.scan(step, state0, (chunks(q), chunks(k), chunks(v)))
    return out.transpose(1, 0, 3, 2, 4).reshape(bsz, seq, nh, dv).astype(q.dtype)


def mixer_conv_retention(h, w_in, conv_w, conv_b, w_out):
    bsz, seq, _ = h.shape
    a_b, a_c, a_v, r_q, r_k, r_v, r_g = jnp.split(h @ w_in, 7, axis=-1)
    u = a_c * a_v
    up = jnp.pad(u, ((0, 0), (CONV_WIDTH - 1, 0), (0, 0)))
    conv = conv_b + sum(up[:, j:j + seq] * conv_w[j] for j in range(CONV_WIDTH))
    y_a = a_b * conv
    pos = jnp.arange(seq)
    heads = lambda z: z.reshape(bsz, seq, RET_HEADS, RET_HEAD_DIM)
    q = rotary(heads(r_q), pos)
    k = rotary(heads(r_k), pos) * (RET_HEAD_DIM ** -0.5)
    o = retention_chunkwise(q, k, heads(r_v))
    y_b = (rms_norm(o) * jax.nn.silu(heads(r_g))).reshape(bsz, seq, -1)
    return jnp.concatenate([y_a, y_b], axis=-1) @ w_out


def t5_bucket(n):
    max_exact = N_BUCKETS // 2
    nf = jnp.maximum(n, 1).astype(jnp.float32)
    large = max_exact + (jnp.log(nf / max_exact) / math.log(MAX_DISTANCE / max_exact)
                         * (N_BUCKETS - max_exact)).astype(jnp.int32)
    large = jnp.minimum(large, N_BUCKETS - 1)
    return jnp.where(n < max_exact, n, large)


def dsa_attention(q, k, v, qi, ki, wi, rel_bias):
    bsz, seq = q.shape[:2]
    topk = min(DSA_TOPK_MAX, seq // 4)
    nb = seq // Q_BLOCK
    s_pos = jnp.arange(seq)
    scale = ATT_HEAD_DIM ** -0.5

    def to_blocks(a):
        return a.reshape(bsz, nb, Q_BLOCK, *a.shape[2:]).swapaxes(0, 1)

    def one_block(args):
        qb, qib, wb, blk = args
        t_pos = blk * Q_BLOCK + jnp.arange(Q_BLOCK)
        causal = s_pos[None, :] <= t_pos[:, None]
        rel = jax.nn.relu(jnp.einsum('bthd,bsd->bths', qib, ki).astype(jnp.float32))
        score = jnp.einsum('bth,bths->bts', wb.astype(jnp.float32), rel)
        score = jnp.where(causal[None], score, -jnp.inf)
        _, idx = lax.top_k(score, topk)
        gather = jax.vmap(lambda arr, ii: arr[ii])
        k_sel = gather(k, idx)
        v_sel = gather(v, idx)
        dist = t_pos[None, :, None] - idx
        valid = dist >= 0
        bias = jnp.moveaxis(rel_bias[t5_bucket(jnp.maximum(dist, 0))], -1, 2)
        logits = jnp.einsum('bthd,btkd->bthk', qb, k_sel).astype(jnp.float32) * scale + bias
        logits = jnp.where(valid[:, :, None, :], logits, -jnp.inf)
        p = jax.nn.softmax(logits, axis=-1)
        return jnp.einsum('bthk,btkd->bthd', p.astype(v_sel.dtype), v_sel)

    out = lax.map(one_block, (to_blocks(q), to_blocks(qi), to_blocks(wi), jnp.arange(nb)))
    return out.swapaxes(0, 1).reshape(bsz, seq, ATT_HEADS, ATT_HEAD_DIM)


def mixer_sparse_attention(h, w_in, q_norm, k_norm, w_out, rel_bias):
    bsz, seq, _ = h.shape
    sizes = [ATT_HEADS * ATT_HEAD_DIM, ATT_HEAD_DIM, ATT_HEAD_DIM, IDX_HEADS * IDX_DIM, IDX_DIM, IDX_HEADS]
    cuts, acc = [], 0
    for s in sizes[:-1]:
        acc += s
        cuts.append(acc)
    q, k, v, qi, ki, wi = jnp.split(h @ w_in, cuts, axis=-1)
    q = rms_norm(q.reshape(bsz, seq, ATT_HEADS, ATT_HEAD_DIM)) * q_norm
    k = rms_norm(k) * k_norm
    qi = qi.reshape(bsz, seq, IDX_HEADS, IDX_DIM)
    o = dsa_attention(q, k, v, qi, ki, wi, rel_bias)
    return o.reshape(bsz, seq, -1) @ w_out


def moe_ffn(h, w_router, b_router, w1, w3, w2):
    bsz, seq, d = h.shape
    t = bsz * seq
    hf = h.reshape(t, d)
    probs = jax.nn.softmax((hf @ w_router).astype(jnp.float32), axis=-1)
    sel = (probs + b_router.astype(jnp.float32)).reshape(t, N_GROUPS, EXPERTS_PER_GROUP)
    group_score = lax.top_k(sel, TOP_K)[0].sum(-1)
    grp = jnp.argmax(group_score, axis=-1)
    in_grp = sel[jnp.arange(t), grp]
    local = lax.top_k(in_grp, TOP_K)[1]
    expert = grp[:, None] * EXPERTS_PER_GROUP + local
    p = jnp.take_along_axis(probs, expert, axis=1)
    gates = p / jnp.sum(p, axis=-1, keepdims=True)
    a = t * TOP_K
    flat_e = expert.reshape(a)
    flat_tok = jnp.repeat(jnp.arange(t), TOP_K)
    flat_g = gates.reshape(a)
    order = jnp.argsort(flat_e)
    e_sorted = flat_e[order]
    tok_sorted = flat_tok[order]
    counts = jnp.bincount(flat_e, length=N_EXPERTS)
    padded = (counts + MOE_BLOCK - 1) // MOE_BLOCK * MOE_BLOCK
    start = jnp.cumsum(counts) - counts
    ends = jnp.cumsum(padded)
    pstart = ends - padded
    dest = pstart[e_sorted] + jnp.arange(a) - start[e_sorted]
    n_rows = (a + MOE_BLOCK - 1) // MOE_BLOCK * MOE_BLOCK + N_EXPERTS * MOE_BLOCK
    n_blocks = n_rows // MOE_BLOCK
    row_tok = jnp.zeros((n_rows,), jnp.int32).at[dest].set(tok_sorted)
    row_used = jnp.zeros((n_rows,), hf.dtype).at[dest].set(1)
    xs = (hf[row_tok] * row_used[:, None]).reshape(n_blocks, MOE_BLOCK, d)
    block_e = jnp.minimum(jnp.searchsorted(ends, jnp.arange(n_blocks) * MOE_BLOCK, side='right'),
                          N_EXPERTS - 1)

    def block_ffn(args):
        xb, e = args
        return (jax.nn.silu(xb @ w1[e]) * (xb @ w3[e])) @ w2[e]

    ys = lax.map(block_ffn, (xs, block_e)).reshape(n_rows, d)
    out_sorted = ys[dest] * flat_g[order][:, None].astype(ys.dtype)
    out = jnp.zeros((t, d), ys.dtype).at[tok_sorted].add(out_sorted)
    return out.reshape(bsz, seq, d)


def setup_inputs(seed: int = 0) -> dict:
    key = jax.random.key(seed)
    ks = jax.random.split(key, 24)
    ne = (DEPTH + 1) // 2
    no = DEPTH // 2
    f32 = jnp.float32
    nrm = lambda k, shape, s: jax.random.normal(k, shape, f32) * s
    d = D_MODEL
    ab_cols = 3 * CONV_CHANNELS + 4 * RET_HEADS * RET_HEAD_DIM
    c_cols = ATT_HEADS * ATT_HEAD_DIM + 2 * ATT_HEAD_DIM + IDX_HEADS * IDX_DIM + IDX_DIM + IDX_HEADS
    return {
        'x': nrm(ks[0], (BATCH, SEQ, d), 1.0),
        'c': nrm(ks[1], (BATCH, d), 1.0),
        'rel_bias': nrm(ks[2], (N_BUCKETS, ATT_HEADS), 0.5),
        'w_router': nrm(ks[3], (d, N_EXPERTS), d ** -0.5),
        'b_router': nrm(ks[4], (N_EXPERTS,), 0.01),
        'norm_mix': 1.0 + nrm(ks[5], (DEPTH, d), 0.02),
        'ada_w_mix': nrm(ks[6], (DEPTH, d, 3 * d), 0.5 * d ** -0.5),
        'ada_b_mix': nrm(ks[7], (DEPTH, 3 * d), 0.02),
        'norm_ffn': 1.0 + nrm(ks[8], (DEPTH, d), 0.02),
        'ada_w_ffn': nrm(ks[9], (DEPTH, d, 3 * d), 0.5 * d ** -0.5),
        'ada_b_ffn': nrm(ks[10], (DEPTH, 3 * d), 0.02),
        'ab_w_in': nrm(ks[11], (ne, d, ab_cols), d ** -0.5),
        'ab_conv_w': nrm(ks[12], (ne, CONV_WIDTH, CONV_CHANNELS), CONV_WIDTH ** -0.5),
        'ab_conv_b': nrm(ks[13], (ne, CONV_CHANNELS), 0.02),
        'ab_w_out': nrm(ks[14], (ne, CONV_CHANNELS + RET_HEADS * RET_HEAD_DIM, d), d ** -0.5),
        'c_w_in': nrm(ks[15], (no, d, c_cols), d ** -0.5),
        'c_q_norm': 1.0 + nrm(ks[16], (no, ATT_HEAD_DIM), 0.02),
        'c_k_norm': 1.0 + nrm(ks[17], (no, ATT_HEAD_DIM), 0.02),
        'c_w_out': nrm(ks[18], (no, ATT_HEADS * ATT_HEAD_DIM, d), d ** -0.5),
        'moe_w1': nrm(ks[19], (DEPTH, N_EXPERTS, d, D_EXPERT), d ** -0.5),
        'moe_w3': nrm(ks[20], (DEPTH, N_EXPERTS, d, D_EXPERT), d ** -0.5),
        'moe_w2': nrm(ks[21], (DEPTH, N_EXPERTS, D_EXPERT, d), D_EXPERT ** -0.5),
    }


def reference(x, c, rel_bias, w_router, b_router, norm_mix, ada_w_mix, ada_b_mix,
              norm_ffn, ada_w_ffn, ada_b_ffn, ab_w_in, ab_conv_w, ab_conv_b, ab_w_out,
              c_w_in, c_q_norm, c_k_norm, c_w_out, moe_w1, moe_w3, moe_w2):
    for layer in range(DEPTH):
        i = layer // 2
        h, gate = ada_pre(x, c, norm_mix[layer], ada_w_mix[layer], ada_b_mix[layer])
        if layer % 2 == 0:
            y = mixer_conv_retention(h, ab_w_in[i], ab_conv_w[i], ab_conv_b[i], ab_w_out[i])
        else:
            y = mixer_sparse_attention(h, c_w_in[i], c_q_norm[i], c_k_norm[i], c_w_out[i], rel_bias)
        x = x + gate * y
        h, gate = ada_pre(x, c, norm_ffn[layer], ada_w_ffn[layer], ada_b_ffn[layer])
        x = x + gate * moe_ffn(h, w_router, b_router, moe_w1[layer], moe_w3[layer], moe_w2[layer])
    return x
```

```cpp
#include <hip/hip_runtime.h>
#include <stdint.h>
#include <stdio.h>

#define XB_TMO      128
#define XB_XCNT(j)  (256  + 64 * (j))
#define XB_XSUB(j)  (1280 + 64 * (j))
#define XB_XGEN(j)  (2304 + 64 * (j))
#define XB_TOP      3328
#define XB_TOPGEN   3392
#define XCD_BAR_WORDS 3456
#define XB_SPIN_CAP (1u << 18)
#define LAS __attribute__((address_space(3)))
#define GAS __attribute__((address_space(1)))

__device__ __forceinline__ unsigned xb_ld(unsigned* p)              { return __hip_atomic_load(p, __ATOMIC_RELAXED, __HIP_MEMORY_SCOPE_AGENT); }
__device__ __forceinline__ unsigned xb_add(unsigned* p, unsigned v) { return __hip_atomic_fetch_add(p, v, __ATOMIC_RELAXED, __HIP_MEMORY_SCOPE_AGENT); }
__device__ __forceinline__ unsigned xb_xcc_id() { return (unsigned)__builtin_amdgcn_s_getreg((3 << 11) | 20) & 0xFu; }
#define XB_SPIN(cond, bar) do { unsigned _sp = 0; while (cond) { __builtin_amdgcn_s_sleep(1); \
    if ((++_sp & 255u) == 0u) { if (xb_ld(&(bar)[XB_TMO])) break; if (_sp > XB_SPIN_CAP) { atomicAdd(&(bar)[XB_TMO], 1u); break; } } } } while (0)

struct XcdBarrier { unsigned* bar; unsigned x; volatile LAS unsigned* st; int wv; };
__device__ __forceinline__ bool xb_thread0(int wv) { int l; asm volatile("v_mbcnt_lo_u32_b32 %0, -1, 0\n\tv_mbcnt_hi_u32_b32 %0, -1, %0" : "=v"(l)); return wv == 0 && l == 0; }

__device__ __forceinline__ XcdBarrier xcd_barrier_post(unsigned* bar, volatile LAS unsigned* st, int wv) {
    XcdBarrier b; b.bar = bar; b.x = xb_xcc_id(); b.st = st; b.wv = wv;
    if (xb_thread0(wv)) (void)xb_add(&bar[XB_XCNT(b.x)], 1u);
    return b;
}
__device__ __forceinline__ void xcd_barrier_complete(unsigned* bar, unsigned x, unsigned& nloc, unsigned& nx) {
    const unsigned G = gridDim.x * gridDim.y * gridDim.z;
    unsigned sum, cnt, mine, sp = 0u;
    for (;;) {
        sum = 0u; cnt = 0u; mine = 0u;
#pragma unroll
        for (unsigned j = 0; j < 16; ++j) { const unsigned c = xb_ld(&bar[XB_XCNT(j)]); sum += c; cnt += (c > 0u) ? 1u : 0u; mine = (j == x) ? c : mine; }
        if (sum == G) break;
        __builtin_amdgcn_s_sleep(1);
        if ((++sp & 255u) == 0u) { if (xb_ld(&bar[XB_TMO])) break; if (sp > XB_SPIN_CAP) { atomicAdd(&bar[XB_TMO], 1u); break; } }
    }
    nloc = mine > 0u ? mine : 1u; nx = cnt > 0u ? cnt : 1u;
}
__device__ __forceinline__ void xcd_barrier(const XcdBarrier& b) {
    asm volatile("s_waitcnt vmcnt(0)" ::: "memory");
    __syncthreads();
    if (xb_thread0(b.wv)) {
        unsigned* bar = b.bar; asm volatile("" : "+s"(bar));
        __builtin_amdgcn_s_waitcnt(0);
        unsigned nloc = b.st[0], nx = b.st[1];
        if (nloc == 0u) { xcd_barrier_complete(bar, b.x, nloc, nx); b.st[0] = nloc; b.st[1] = nx; }
        const unsigned old = xb_add(&bar[XB_XSUB(b.x)], 1u);
        const unsigned gen = old / nloc;
        if (old + 1u == (gen + 1u) * nloc) {
            __builtin_amdgcn_fence(__ATOMIC_RELEASE, "agent");
            asm volatile("s_waitcnt vmcnt(0)" ::: "memory");
            const unsigned og = xb_add(&bar[XB_TOP], 1u);
            const unsigned tg = og / nx;
            if (og + 1u == (tg + 1u) * nx) xb_add(&bar[XB_TOPGEN], 1u);
            else XB_SPIN(xb_ld(&bar[XB_TOPGEN]) == tg, bar);
            __builtin_amdgcn_fence(__ATOMIC_ACQUIRE, "agent");
            xb_add(&bar[XB_XGEN(b.x)], 1u);
            asm volatile("s_waitcnt vmcnt(0)" ::: "memory");
        } else {
            XB_SPIN(xb_ld(&bar[XB_XGEN(b.x)]) == gen, bar);
            __builtin_amdgcn_fence(__ATOMIC_ACQUIRE, "agent");
            asm volatile("s_waitcnt vmcnt(0)" ::: "memory");
        }
    }
    __syncthreads();
}

typedef unsigned short bf16_t;
typedef short bf16x8 __attribute__((ext_vector_type(8)));
typedef float f32x4 __attribute__((ext_vector_type(4)));
typedef unsigned u32x4 __attribute__((ext_vector_type(4)));
typedef unsigned u32x2 __attribute__((ext_vector_type(2)));

constexpr int NT = 512;
constexpr int NB = 16, NS = 2048, ND = 2048, NTOK = NB * NS;
constexpr int NE = 16, DEXP = 1024;
constexpr int N_IN0 = 7168, N_IN1 = 3408, N_IN1P = 3584;
constexpr float RMS_EPS = 1e-6f;
constexpr int LDS_MISC = 131072 + 2 * 64 * 144;
constexpr int LDS_BYTES = LDS_MISC + 8192;

constexpr size_t MiB = 1024ull * 1024ull;
constexpr size_t WS_CTL   = 0;
constexpr size_t CTL_CNT  = 16384;
constexpr size_t WS_MOD   = 64 * 1024;
constexpr size_t WS_ROT   = WS_MOD + 4ull * 16 * 6144 * 4;
constexpr size_t WS_IDX   = WS_ROT + 2048ull * 128 * 8;
constexpr size_t WS_GT    = WS_IDX + 16ull * 32768 * 4;
constexpr size_t WS_MASK  = WS_GT + 16ull * 32768 * 4;
constexpr size_t WS_WIN0  = 16 * MiB;
constexpr size_t WS_WOUT0 = WS_WIN0 + 28 * MiB;
constexpr size_t WS_WIN1  = WS_WOUT0 + 8 * MiB;
constexpr size_t WS_WOUT1 = WS_WIN1 + 14 * MiB;
constexpr size_t WS_W13   = WS_WOUT1 + 8 * MiB;
constexpr size_t WS_XB    = WS_W13 + 128 * MiB;
constexpr size_t WS_W2    = WS_W13 + 256 * MiB;
constexpr size_t WS_H     = WS_W2 + 128 * MiB;
constexpr size_t WS_O     = WS_H + 128 * MiB;
constexpr size_t WS_TMP   = WS_O + 64 * MiB;
constexpr size_t WS_PROJ  = WS_TMP + 128 * MiB;
constexpr size_t WS_END   = WS_PROJ + 448 * MiB;
constexpr size_t WS_TMP1  = WS_PROJ + 128 * MiB;
constexpr size_t WS_H8    = WS_O;
constexpr size_t WS_WIN0F8 = WS_W2 + 64 * MiB;
constexpr size_t PJ_AB = 0, PJ_U = 64 * MiB, PJ_Q = 128 * MiB, PJ_K = 192 * MiB, PJ_KT = 256 * MiB, PJ_VT = 320 * MiB, PJ_SG = 384 * MiB;
constexpr size_t PJ_Q1 = 0, PJ_QI = 128 * MiB, PJ_KR = 192 * MiB, PJ_VT1 = 200 * MiB, PJ_KI = 208 * MiB, PJ_WI = 212 * MiB, PJ_KN = 216 * MiB;
constexpr size_t PJ_ACT = 0;

struct Args { const float* in[22]; float* out; unsigned char* ws; };
#define CAS __attribute__((address_space(4)))
struct KA {
    const CAS unsigned char* kp;
    __device__ __forceinline__ KA() { kp = (const CAS unsigned char*)__builtin_amdgcn_kernarg_segment_ptr(); asm volatile("" : "+s"(kp)); }
    __device__ __forceinline__ const float* in(int i) const { return *(const float* const CAS*)(kp + 8 * i); }
    __device__ __forceinline__ float* out() const { return *(float* const CAS*)(kp + 8 * 22); }
    __device__ __forceinline__ unsigned char* ws() const { return *(unsigned char* const CAS*)(kp + 8 * 23); }
};
enum { I_X = 0, I_C, I_RELB, I_WR, I_BR, I_NORM_MIX, I_ADAW_MIX, I_ADAB_MIX, I_NORM_FFN, I_ADAW_FFN, I_ADAB_FFN, I_AB_WIN, I_CONVW, I_CONVB, I_AB_WOUT,
       I_C_WIN, I_QN, I_KN, I_C_WOUT, I_W1, I_W3, I_W2 };

typedef __bf16 bf16x2_t __attribute__((ext_vector_type(2)));
__device__ __forceinline__ unsigned cvt_pk_bf16(float lo, float hi) { bf16x2_t v = {(__bf16)lo, (__bf16)hi}; return __builtin_bit_cast(unsigned, v); }
__device__ __forceinline__ float bflo(unsigned u) { return __uint_as_float(u << 16); }
__device__ __forceinline__ float bfhi(unsigned u) { return __uint_as_float(u & 0xffff0000u); }
__device__ __forceinline__ f32x4 ld_bf16x4(const bf16_t* p) { const u32x2 t = *(const GAS u32x2*)p; return (f32x4){bflo(t.x), bfhi(t.x), bflo(t.y), bfhi(t.y)}; }
__device__ __forceinline__ float bf2f(bf16_t h) { return __uint_as_float((unsigned)h << 16); }
__device__ __forceinline__ bf16_t f2bf(float f) { return (bf16_t)(cvt_pk_bf16(f, 0.f) & 0xffffu); }
__device__ __forceinline__ float silu_f(float v) { return v * __builtin_amdgcn_rcpf(1.f + __builtin_amdgcn_exp2f(-1.4426950408889634f * v)); }
__device__ __forceinline__ int tid_fresh(int wv) {
    int l; asm volatile("v_mbcnt_lo_u32_b32 %0, -1, 0\n\tv_mbcnt_hi_u32_b32 %0, -1, %0" : "=v"(l));
    return wv * 64 + l;
}
__device__ __forceinline__ float shx(float v, int o, int lane) { return __int_as_float(__builtin_amdgcn_ds_bpermute((lane ^ o) << 2, __float_as_int(v))); }
__device__ __forceinline__ float shi(float v, int src) { return __int_as_float(__builtin_amdgcn_ds_bpermute(src << 2, __float_as_int(v))); }
__device__ __forceinline__ float wave_sum(float v, int lane) {
#pragma unroll
    for (int o = 32; o >= 1; o >>= 1) v += shx(v, o, lane);
    return v;
}

#ifndef F8_L1
#define F8_L1 1
#endif
#ifndef F8_P2_TILES
#define F8_P2_TILES 0xFFFFFFFu
#endif
#define F8_P2 ((F8_P2_TILES) == 0xFFFFFFFu)
#define F8_P2_MIX ((F8_P2_TILES) != 0u && (F8_P2_TILES) != 0xFFFFFFFu)

#ifndef F8_P5
#define F8_P5 0
#endif
constexpr float Y8_SCALE = 4.0f;
constexpr float W8_SCALE = 64.0f, A8_SCALE = 8.0f;
__device__ __forceinline__ float clamp8(float v) { return fminf(fmaxf(v, -448.0f), 448.0f); }
__device__ __forceinline__ unsigned pack_fp8x4(float a, float b, float c, float d) { int w; asm volatile("" : "=v"(w));     w = __builtin_amdgcn_cvt_pk_fp8_f32(clamp8(a), clamp8(b), w, false); w = __builtin_amdgcn_cvt_pk_fp8_f32(clamp8(c), clamp8(d), w, true); return (unsigned)w; }
template <bool FP8OUT>
__device__ __forceinline__ void tr_tile(int wv, const float* __restrict__ src, int ldn, int N, int k0, int n0, float* tile, bf16_t* dstbase, int ldk, int rowmap_kind) {
    const int tid = tid_fresh(wv);
#pragma unroll
    for (int it = 0; it < 2; ++it) {
        const int i = tid + it * NT, k = i >> 4, q = i & 15, n = n0 + q * 4;
        float4 v = make_float4(0.f, 0.f, 0.f, 0.f);
        if (n < N) v = *(const float4*)(src + (size_t)(k0 + k) * ldn + n);
        float* tp = tile + k * 65 + q * 4;
        tp[0] = v.x; tp[1] = v.y; tp[2] = v.z; tp[3] = v.w;
    }
    __syncthreads();
    {
        const int nl = tid >> 3, kc = tid & 7, n = n0 + nl;
        if (n < N) {
            float f[8];
#pragma unroll
            for (int j = 0; j < 8; ++j) f[j] = tile[(kc * 8 + j) * 65 + nl];
            int row = n;
            if (rowmap_kind == 1) {
                const int s = n >> 10, c = n & 1023;
                if (s == 1) row = 1024 + (c >> 7) * 256 + (c & 127);
                else if (s == 2) row = 1024 + (c >> 7) * 256 + 128 + (c & 127);
            } else if (rowmap_kind == 2) {
                row = (n >> 7) * 256 + (n & 127);
            } else if (rowmap_kind == 3) {
                row = (n >> 7) * 256 + 128 + (n & 127);
            }
            if (FP8OUT) {
                u32x2 o; o.x = pack_fp8x4(f[0] * W8_SCALE, f[1] * W8_SCALE, f[2] * W8_SCALE, f[3] * W8_SCALE); o.y = pack_fp8x4(f[4] * W8_SCALE, f[5] * W8_SCALE, f[6] * W8_SCALE, f[7] * W8_SCALE);
                *(u32x2*)((unsigned char*)dstbase + (size_t)row * ldk + k0 + kc * 8) = o;
            } else {
                u32x4 o; o.x = cvt_pk_bf16(f[0], f[1]); o.y = cvt_pk_bf16(f[2], f[3]); o.z = cvt_pk_bf16(f[4], f[5]); o.w = cvt_pk_bf16(f[6], f[7]);
                *(u32x4*)(dstbase + (size_t)row * ldk + k0 + kc * 8) = o;
            }
        }
    }
    __syncthreads();
}

__device__ __forceinline__ void p0_prologue(int wv, unsigned char* lds) {
    const int tid = tid_fresh(wv), G = gridDim.x, bx = blockIdx.x;
    const KA a; unsigned char* ws = a.ws();
    {
        float2* rot = (float2*)(ws + WS_ROT);
        for (int i = bx * NT + tid; i < 2048 * 128; i += G * NT) {
            const int pos = i >> 7, j = i & 127;
            const float inv = 1.0f / powf(10000.0f, (float)j / 127.0f);
            const float ang = (float)pos * inv;
            float s, c; sincosf(ang, &s, &c);
            rot[i] = make_float2(c, s);
        }
    }
    {
        constexpr int esz = F8_L1 ? 1 : 2;
        u32x4* z = (u32x4*)(ws + WS_WIN1 + (size_t)N_IN1 * 2048 * esz);
        const int n16 = (N_IN1P - N_IN1) * 2048 * esz / 16;
        for (int i = bx * NT + tid; i < n16; i += G * NT) z[i] = (u32x4){0u, 0u, 0u, 0u};
    }
    {
        float* sc = (float*)lds;
        float* red = (float*)(lds + 65536);
        float* mod = (float*)(ws + WS_MOD);
        const int lane = tid & 63, wave = tid >> 6;
        const int q = lane & 15, kg = (lane >> 4) + wave * 4;
        int cur_half = -1;
        for (int item = bx; item < 2 * 4 * 96; item += G) {
            const int half = item / (4 * 96), it2 = item % (4 * 96);
            const int w = it2 / 96, col0 = (it2 % 96) * 64;
            const float* adaw = (w & 1) ? a.in(I_ADAW_FFN) : a.in(I_ADAW_MIX);
            const float* adab = (w & 1) ? a.in(I_ADAB_FFN) : a.in(I_ADAB_MIX);
            const int layer = w >> 1;
            adaw += (size_t)layer * 2048 * 6144; adab += (size_t)layer * 6144;
            if (half != cur_half) {
                __syncthreads();
                for (int i = tid; i < 1024 * 16; i += NT) { const int k = i >> 4, b = i & 15; sc[i] = silu_f(a.in(I_C)[b * 2048 + half * 1024 + k]); }
                cur_half = half;
                __syncthreads();
            }
            float acc[16][4];
#pragma unroll
            for (int b = 0; b < 16; ++b) { acc[b][0] = 0.f; acc[b][1] = 0.f; acc[b][2] = 0.f; acc[b][3] = 0.f; }
            const float* wp = adaw + (size_t)(half * 1024 + kg * 32) * 6144 + col0 + q * 4;
            for (int kk0 = 0; kk0 < 32; kk0 += 4) {
                float4 wv8[4];
#pragma unroll
                for (int j = 0; j < 4; ++j) wv8[j] = *(const float4*)(wp + (size_t)(kk0 + j) * 6144);
#pragma unroll
                for (int j = 0; j < 4; ++j) {
                    const float4* sp = (const float4*)(sc + (kg * 32 + kk0 + j) * 16);
#pragma unroll
                    for (int b4 = 0; b4 < 4; ++b4) {
                        const float4 s4 = sp[b4];
                        const float sv[4] = {s4.x, s4.y, s4.z, s4.w};
#pragma unroll
                        for (int bb = 0; bb < 4; ++bb) {
                            acc[b4 * 4 + bb][0] += sv[bb] * wv8[j].x; acc[b4 * 4 + bb][1] += sv[bb] * wv8[j].y;
                            acc[b4 * 4 + bb][2] += sv[bb] * wv8[j].z; acc[b4 * 4 + bb][3] += sv[bb] * wv8[j].w;
                        }
                    }
                }
            }
#pragma unroll
            for (int b = 0; b < 16; ++b)
#pragma unroll
                for (int j = 0; j < 4; ++j) { float v = acc[b][j]; v += shx(v, 16, lane); v += shx(v, 32, lane); acc[b][j] = v; }
            __syncthreads();
            if (lane < 16) {
#pragma unroll
                for (int b = 0; b < 16; ++b) *(float4*)(red + (wave * 16 + b) * 64 + q * 4) = make_float4(acc[b][0], acc[b][1], acc[b][2], acc[b][3]);
            }
            __syncthreads();
            for (int i = tid; i < 1024; i += NT) {
                const int b = i >> 6, cidx = i & 63;
                float sm = (half == 0) ? adab[col0 + cidx] : 0.f;
#pragma unroll
                for (int wvi = 0; wvi < 8; ++wvi) sm += red[(wvi * 16 + b) * 64 + cidx];
                atomicAdd(mod + ((size_t)w * 16 + b) * 6144 + col0 + cidx, sm);
            }
        }
        __syncthreads();
    }
    {
        constexpr int T0 = 16 * 56, T1 = T0 + 256, T2 = T1 + 16 * 27, T3 = T2 + 256, T4 = T3 + 4096, T5 = T4 + 4096, T6 = T5 + 4096;
        struct TD { const float* src; unsigned char* dst; int ldn, N, k0, n0, ldk, kind, f8; };
        auto decode = [&](int t) {
            TD d;
            if (t < T0) { const int kt = t / 56, nt = t % 56;
                const int n = nt * 128, sct = n >> 10, c = n & 1023; const int row = (sct == 0) ? c : (sct == 1) ? 1024 + (c >> 7) * 256 + (c & 127) : (sct == 2) ? 1024 + (c >> 7) * 256 + 128 + (c & 127) : n;
                const int f8 = (int)(((unsigned)F8_P2_TILES >> (row >> 8)) & 1u);
                d = TD{a.in(I_AB_WIN), f8 ? ws + WS_WIN0F8 : ws + WS_WIN0, 7168, 7168, kt * 128, nt * 128, 2048, 1, f8}; }
            else if (t < T1) { const int u = t - T0, kt = u / 16, nt = u % 16; d = TD{a.in(I_AB_WOUT), ws + WS_WOUT0, 2048, 2048, kt * 128, nt * 128, 2048, 0, F8_P5}; }
            else if (t < T2) { const int u = t - T1, kt = u / 27, nt = u % 27; d = TD{a.in(I_C_WIN), ws + WS_WIN1, N_IN1, N_IN1, kt * 128, nt * 128, 2048, 0, F8_L1}; }
            else if (t < T3) { const int u = t - T2, kt = u / 16, nt = u % 16; d = TD{a.in(I_C_WOUT), ws + WS_WOUT1, 2048, 2048, kt * 128, nt * 128, 2048, 0, F8_L1}; }
            else if (t < T5) { const bool is3 = t >= T4; const int u = t - (is3 ? T4 : T3), mat = u / 128, v = u % 128, kt = v / 8, nt = v % 8;
                d = TD{(is3 ? a.in(I_W3) : a.in(I_W1)) + (size_t)mat * 2048 * 1024, ws + WS_W13 + (size_t)mat * 2048 * 2048, 1024, 1024, kt * 128, nt * 128, 2048, is3 ? 3 : 2, 1}; }
            else { const int u = t - T5, mat = u / 128, v = u % 128, kt = v / 16, nt = v % 16;
                d = TD{a.in(I_W2) + (size_t)mat * 1024 * 2048, ws + WS_W2 + (size_t)mat * 2048 * 1024, 2048, 2048, kt * 128, nt * 128, 1024, 0, 1}; }
            return d;
        };
        auto load8 = [&](const TD& d, float4 (&v)[8]) {
#pragma unroll
            for (int it = 0; it < 8; ++it) {
                const int i = tid + it * NT, k = i >> 5, q = i & 31, n = d.n0 + q * 4;
                v[it] = (n < d.N) ? *(const float4*)(d.src + (size_t)(d.k0 + k) * d.ldn + n) : make_float4(0.f, 0.f, 0.f, 0.f);
            }
        };
        float4 cur[8], nx1[8], nx2[8];
        int t = bx, buf = 0;
        TD d = decode(t < T6 ? t : 0), d1 = decode(t + G < T6 ? t + G : 0);
        if (t < T6) load8(d, cur);
        if (t + G < T6) load8(d1, nx1);
        __syncthreads();
        for (; t < T6; t += G) {
            float* tile = (float*)lds + buf * (128 * 129);
#pragma unroll
            for (int it = 0; it < 8; ++it) {
                const int i = tid + it * NT, k = i >> 5, q = i & 31;
                float* tp = tile + k * 129 + q * 4;
                tp[0] = cur[it].x; tp[1] = cur[it].y; tp[2] = cur[it].z; tp[3] = cur[it].w;
            }
            const TD d2 = decode(t + 2 * G < T6 ? t + 2 * G : t);
            if (t + 2 * G < T6) load8(d2, nx2);
            __syncthreads();
#pragma unroll
            for (int rep = 0; rep < 2; ++rep) {
                const int item = tid + rep * NT, nl = item >> 3, kc = item & 7, n = d.n0 + nl;
                if (n < d.N) {
                    float f[16];
#pragma unroll
                    for (int j = 0; j < 16; ++j) f[j] = tile[(kc * 16 + j) * 129 + nl];
                    int row = n;
                    if (d.kind == 1) { const int sct = n >> 10, c = n & 1023; if (sct == 1) row = 1024 + (c >> 7) * 256 + (c & 127); else if (sct == 2) row = 1024 + (c >> 7) * 256 + 128 + (c & 127); }
                    else if (d.kind == 2) row = (n >> 7) * 256 + (n & 127);
                    else if (d.kind == 3) row = (n >> 7) * 256 + 128 + (n & 127);
                    if (d.f8) {
                        u32x4 o;
                        o.x = pack_fp8x4(f[0] * W8_SCALE, f[1] * W8_SCALE, f[2] * W8_SCALE, f[3] * W8_SCALE); o.y = pack_fp8x4(f[4] * W8_SCALE, f[5] * W8_SCALE, f[6] * W8_SCALE, f[7] * W8_SCALE);
                        o.z = pack_fp8x4(f[8] * W8_SCALE, f[9] * W8_SCALE, f[10] * W8_SCALE, f[11] * W8_SCALE); o.w = pack_fp8x4(f[12] * W8_SCALE, f[13] * W8_SCALE, f[14] * W8_SCALE, f[15] * W8_SCALE);
                        *(u32x4*)(d.dst + (size_t)row * d.ldk + d.k0 + kc * 16) = o;
                    } else {
                        u32x4 o0, o1;
                        o0.x = cvt_pk_bf16(f[0], f[1]); o0.y = cvt_pk_bf16(f[2], f[3]); o0.z = cvt_pk_bf16(f[4], f[5]); o0.w = cvt_pk_bf16(f[6], f[7]);
                        o1.x = cvt_pk_bf16(f[8], f[9]); o1.y = cvt_pk_bf16(f[10], f[11]); o1.z = cvt_pk_bf16(f[12], f[13]); o1.w = cvt_pk_bf16(f[14], f[15]);
                        u32x4* op = (u32x4*)(d.dst + ((size_t)row * d.ldk + d.k0 + kc * 16) * 2);
                        op[0] = o0; op[1] = o1;
                    }
                }
            }
            d = d1; d1 = d2;
#pragma unroll
            for (int it = 0; it < 8; ++it) { cur[it] = nx1[it]; nx1[it] = nx2[it]; }
            buf ^= 1;
        }
        __syncthreads();
    }
}

template <bool ADD_TMP, bool ROUTE, bool OUT8, bool XBF, bool DUAL = false, bool WB = false>
__device__ __forceinline__ void norm_phase(int wv, const void* xsrc_, const bf16_t* __restrict__ tmp, const float* __restrict__ normw, const float* __restrict__ mod  ,
                           bf16_t* __restrict__ H, unsigned char* lds, const float* __restrict__ w_router, const float* __restrict__ b_router,
                           unsigned* __restrict__ cnt  , int* __restrict__ idx, float* __restrict__ gts, const bf16_t* __restrict__ tmp2 = nullptr, const float* __restrict__ gatev = nullptr  ) {
    const int tid = tid_fresh(wv), lane = tid & 63, wave = tid >> 6;
    float* wr_lds = (float*)lds;
    int* rt_e = (int*)(lds + 131072 + 64);
    (void)rt_e;
    if (ROUTE) {
        for (int i = tid; i < 2048 * 16; i += NT) { const int k = i >> 4, e = i & 15; wr_lds[e * 2048 + k] = w_router[i]; }
        __syncthreads();
    }
    float br[16];
    if (ROUTE) {
#pragma unroll
        for (int e = 0; e < 16; ++e) br[e] = b_router[e];
    }
    const int rows_per_block = NTOK / (int)gridDim.x;
    const int rows_per_wave = rows_per_block / 8;
    const int row0 = blockIdx.x * rows_per_block + wave * rows_per_wave;
    const int b = row0 / NS;
    float g[32], sh[32];
#pragma unroll
    for (int i = 0; i < 8; ++i) {
        const int c = i * 256 + lane * 4;
        const float4 nw = *(const float4*)(normw + c);
        const float4 s4 = *(const float4*)(mod + (size_t)b * 6144 + c);
        const float4 c4 = *(const float4*)(mod + (size_t)b * 6144 + 2048 + c);
        g[i * 4 + 0] = nw.x * (1.f + c4.x); g[i * 4 + 1] = nw.y * (1.f + c4.y); g[i * 4 + 2] = nw.z * (1.f + c4.z); g[i * 4 + 3] = nw.w * (1.f + c4.w);
        sh[i * 4 + 0] = s4.x; sh[i * 4 + 1] = s4.y; sh[i * 4 + 2] = s4.z; sh[i * 4 + 3] = s4.w;
    }
    float gt[32];
    if (WB) {
#pragma unroll
        for (int i = 0; i < 8; ++i) { const float4 g4 = *(const float4*)(gatev + (size_t)b * 6144 + i * 256 + lane * 4); gt[i * 4 + 0] = g4.x * (1.0f / 16.0f); gt[i * 4 + 1] = g4.y * (1.0f / 16.0f); gt[i * 4 + 2] = g4.z * (1.0f / 16.0f); gt[i * 4 + 3] = g4.w * (1.0f / 16.0f); }
    }
    for (int r = 0; r < rows_per_wave; ++r) {
        const int t = row0 + r;
        float v[32];
        float ss = 0.f;
#pragma unroll
        for (int i = 0; i < 8; ++i) {
            const int c = i * 256 + lane * 4;
            float4 x4;
            if (XBF) { const f32x4 xb = ld_bf16x4((const bf16_t*)xsrc_ + (size_t)t * ND + c); x4 = make_float4(xb[0], xb[1], xb[2], xb[3]); }
            else x4 = *(const float4*)((const float*)xsrc_ + (size_t)t * ND + c);
            if (ADD_TMP && !WB) {
                const u32x2 tv = *(const u32x2*)(tmp + (size_t)t * ND + c);
                x4.x += bflo(tv.x); x4.y += bfhi(tv.x); x4.z += bflo(tv.y); x4.w += bfhi(tv.y);
            }
            if (WB) {
                const int tv = *(const int*)((const unsigned char*)tmp + (size_t)t * ND + c), tw = *(const int*)((const unsigned char*)tmp2 + (size_t)t * ND + c);
                x4.x += (__builtin_amdgcn_cvt_f32_fp8(tv, 0) + __builtin_amdgcn_cvt_f32_fp8(tw, 0)) * gt[i * 4 + 0]; x4.y += (__builtin_amdgcn_cvt_f32_fp8(tv, 1) + __builtin_amdgcn_cvt_f32_fp8(tw, 1)) * gt[i * 4 + 1];
                x4.z += (__builtin_amdgcn_cvt_f32_fp8(tv, 2) + __builtin_amdgcn_cvt_f32_fp8(tw, 2)) * gt[i * 4 + 2]; x4.w += (__builtin_amdgcn_cvt_f32_fp8(tv, 3) + __builtin_amdgcn_cvt_f32_fp8(tw, 3)) * gt[i * 4 + 3];
                u32x2 o; o.x = cvt_pk_bf16(x4.x, x4.y); o.y = cvt_pk_bf16(x4.z, x4.w);
                *(u32x2*)((bf16_t*)xsrc_ + (size_t)t * ND + c) = o;
            }
            v[i * 4 + 0] = x4.x; v[i * 4 + 1] = x4.y; v[i * 4 + 2] = x4.z; v[i * 4 + 3] = x4.w;
            ss += x4.x * x4.x + x4.y * x4.y + x4.z * x4.z + x4.w * x4.w;
        }
        ss = wave_sum(ss, lane);
        const float rs = rsqrtf(ss * (1.0f / ND) + RMS_EPS);
#pragma unroll
        for (int i = 0; i < 32; ++i) v[i] = v[i] * rs * g[i] + sh[i];
#pragma unroll
        for (int i = 0; i < 8; ++i) {
            const int c = i * 256 + lane * 4;
            if (DUAL) *(unsigned*)((unsigned char*)H + (size_t)(WS_H8 - WS_H) + (size_t)t * ND + c) = pack_fp8x4(v[i * 4 + 0], v[i * 4 + 1], v[i * 4 + 2], v[i * 4 + 3]);
            if (OUT8) {
                *(unsigned*)((unsigned char*)H + (size_t)t * ND + c) = pack_fp8x4(v[i * 4 + 0], v[i * 4 + 1], v[i * 4 + 2], v[i * 4 + 3]);
            } else {
                u32x2 o; o.x = cvt_pk_bf16(v[i * 4 + 0], v[i * 4 + 1]); o.y = cvt_pk_bf16(v[i * 4 + 2], v[i * 4 + 3]);
                *(u32x2*)(H + (size_t)t * ND + c) = o;
            }
        }
        if (ROUTE) {
            float lg[16];
            int lo = lane * 4; asm volatile("" : "+v"(lo));
#pragma unroll
            for (int e = 0; e < 16; ++e) {
                float s = 0.f;
#pragma unroll
                for (int i = 0; i < 8; ++i) {
                    const float4 w4 = *(const float4*)(wr_lds + e * 2048 + i * 256 + lo);
                    s += v[i * 4 + 0] * w4.x + v[i * 4 + 1] * w4.y + v[i * 4 + 2] * w4.z + v[i * 4 + 3] * w4.w;
                }
                lg[e] = wave_sum(s, lane);
            }
            float mx = lg[0];
#pragma unroll
            for (int e = 1; e < 16; ++e) mx = fmaxf(mx, lg[e]);
            float p[16], sum = 0.f;
#pragma unroll
            for (int e = 0; e < 16; ++e) { p[e] = __expf(lg[e] - mx); sum += p[e]; }
            const float isum = 1.f / sum;
            float sel[16];
#pragma unroll
            for (int e = 0; e < 16; ++e) { p[e] *= isum; sel[e] = p[e] + br[e]; }
            int grp = 0; float best = -1e30f;
#pragma unroll
            for (int gI = 0; gI < 4; ++gI) {
                float m1 = -1e30f, m2 = -1e30f;
#pragma unroll
                for (int j = 0; j < 4; ++j) { const float s = sel[gI * 4 + j]; if (s > m1) { m2 = m1; m1 = s; } else if (s > m2) { m2 = s; } }
                const float gs = m1 + m2;
                if (gs > best) { best = gs; grp = gI; }
            }
            float s4[4], p4[4];
#pragma unroll
            for (int j = 0; j < 4; ++j) { s4[j] = 0.f; p4[j] = 0.f; }
#pragma unroll
            for (int gI = 0; gI < 4; ++gI)
#pragma unroll
                for (int j = 0; j < 4; ++j) if (grp == gI) { s4[j] = sel[gI * 4 + j]; p4[j] = p[gI * 4 + j]; }
            int i1 = 0; float v1 = s4[0];
#pragma unroll
            for (int j = 1; j < 4; ++j) if (s4[j] > v1) { v1 = s4[j]; i1 = j; }
            int i2 = -1; float v2 = -1e30f;
#pragma unroll
            for (int j = 0; j < 4; ++j) if (j != i1 && s4[j] > v2) { v2 = s4[j]; i2 = j; }
            float pa = 0.f, pb = 0.f;
#pragma unroll
            for (int j = 0; j < 4; ++j) { if (j == i1) pa = p4[j]; if (j == i2) pb = p4[j]; }
            const float inv = 1.f / (pa + pb);
            if (lane == 0) {
                const int e0 = grp * 4 + i1, e1 = grp * 4 + i2;
                const unsigned p0 = atomicAdd(cnt + e0 * 64, 1u);
                const unsigned p1 = atomicAdd(cnt + e1 * 64, 1u);
                idx[e0 * 32768 + p0] = t * 2 + 0; gts[e0 * 32768 + p0] = pa * inv;
                idx[e1 * 32768 + p1] = t * 2 + 1; gts[e1 * 32768 + p1] = pb * inv;
            }
        }
    }
    __syncthreads();
}

#define DPP_ADD(v, CTRL) ((v) + __int_as_float(__builtin_amdgcn_update_dpp(0, __float_as_int(v), (CTRL), 0xf, 0xf, false)))
#define DPP_GET(v, CTRL) __int_as_float(__builtin_amdgcn_update_dpp(0, __float_as_int(v), (CTRL), 0xf, 0xf, false))
__device__ __forceinline__ float swap32_sum(float a, float b) {
    const auto r = __builtin_amdgcn_permlane32_swap(__float_as_uint(a), __float_as_uint(b), false, false);
    return __uint_as_float(r[0]) + __uint_as_float(r[1]);
}
__device__ __forceinline__ float swap16_sum(float a, float b) {
    const auto r = __builtin_amdgcn_permlane16_swap(__float_as_uint(a), __float_as_uint(b), false, false);
    return __uint_as_float(r[0]) + __uint_as_float(r[1]);
}
__device__ __forceinline__ float bfly16(const float (&pl)[16], int lane) {
    float a8[8], a4[4], a2[2], a1;
#pragma unroll
    for (int i = 0; i < 8; ++i) a8[i] = swap32_sum(pl[i], pl[8 + i]);
#pragma unroll
    for (int i = 0; i < 4; ++i) a4[i] = swap16_sum(a8[i], a8[4 + i]);
    { const bool hi = (lane & 2) != 0;
#pragma unroll
      for (int i = 0; i < 2; ++i) { const float keep = hi ? a4[2 + i] : a4[i], send = hi ? a4[i] : a4[2 + i]; a2[i] = keep + DPP_GET(send, 0x4e  ); } }
    { const bool hi = (lane & 1) != 0; const float keep = hi ? a2[1] : a2[0], send = hi ? a2[0] : a2[1]; a1 = keep + DPP_GET(send, 0xb1  ); }
    return a1 + DPP_GET(a1, 0x124) + DPP_GET(a1, 0x128) + DPP_GET(a1, 0x12c);
}
__device__ __forceinline__ int bfly16_slot(int lane) { return ((lane >> 5) & 1) * 8 + ((lane >> 4) & 1) * 4 + (lane & 3); }
__device__ __forceinline__ float wave_total(float v) {
    v = swap32_sum(v, v); v = swap16_sum(v, v);
    v = v + DPP_GET(v, 0x124) + DPP_GET(v, 0x128) + DPP_GET(v, 0x12c);
    v = DPP_ADD(v, 0x4e); v = DPP_ADD(v, 0xb1);
    return v;
}
__device__ __forceinline__ void route_phase(int wv, const bf16_t* __restrict__ XB, const float* __restrict__ normw, const float* __restrict__ mod, unsigned char* __restrict__ H8, unsigned char* lds,
                                            const float* __restrict__ w_router, const float* __restrict__ b_router, unsigned* __restrict__ cnt, int* __restrict__ idx, float* __restrict__ gts) {
    const int tid = tid_fresh(wv), lane = tid & 63, w = tid >> 6, fr = lane & 15, fq = lane >> 4;
    constexpr int RB = 128;
    constexpr int GWP = 2048 + 8;
    bf16_t* gwh = (bf16_t*)lds;
    bf16_t* gwl = gwh + 16 * GWP;
    float* part = (float*)(gwl + 16 * GWP);
    float* part_c = part + RB * 17;
    float* rs_lds = part_c + 128;
    unsigned* lcnt = (unsigned*)(rs_lds + RB);
    const int row0 = blockIdx.x * RB;
    const int st = w & 3, rh = w >> 2;
    const int b = row0 / NS, col0 = st * 512 + lane * 8;
    float gg[8], shv[8];
#pragma unroll
    for (int h4 = 0; h4 < 2; ++h4) {
        const float4 nw = *(const float4*)(normw + col0 + h4 * 4);
        const float4 s4 = *(const float4*)(mod + (size_t)b * 6144 + col0 + h4 * 4);
        const float4 c4 = *(const float4*)(mod + (size_t)b * 6144 + 2048 + col0 + h4 * 4);
        gg[h4 * 4 + 0] = nw.x * (1.f + c4.x); gg[h4 * 4 + 1] = nw.y * (1.f + c4.y); gg[h4 * 4 + 2] = nw.z * (1.f + c4.z); gg[h4 * 4 + 3] = nw.w * (1.f + c4.w);
        shv[h4 * 4 + 0] = s4.x; shv[h4 * 4 + 1] = s4.y; shv[h4 * 4 + 2] = s4.z; shv[h4 * 4 + 3] = s4.w;
    }
    __syncthreads();
    {
        const int k0 = tid * 4;
        const float4 nw = *(const float4*)(normw + k0);
        const float4 s4 = *(const float4*)(mod + (size_t)b * 6144 + k0);
        const float4 c4 = *(const float4*)(mod + (size_t)b * 6144 + 2048 + k0);
        const float gk[4] = {nw.x * (1.f + c4.x), nw.y * (1.f + c4.y), nw.z * (1.f + c4.z), nw.w * (1.f + c4.w)};
        const float sk[4] = {s4.x, s4.y, s4.z, s4.w};
        float ce[16];
#pragma unroll
        for (int e = 0; e < 16; ++e) ce[e] = 0.f;
        float wk[4][16];
#pragma unroll
        for (int j = 0; j < 4; ++j)
#pragma unroll
            for (int e4 = 0; e4 < 4; ++e4) {
                const float4 wr = *(const float4*)(w_router + (size_t)(k0 + j) * 16 + e4 * 4);
                wk[j][e4 * 4 + 0] = wr.x; wk[j][e4 * 4 + 1] = wr.y; wk[j][e4 * 4 + 2] = wr.z; wk[j][e4 * 4 + 3] = wr.w;
            }
#pragma unroll
        for (int e = 0; e < 16; ++e) {
            float hi[4], lo[4];
#pragma unroll
            for (int j = 0; j < 4; ++j) { const float v = gk[j] * wk[j][e]; ce[e] += sk[j] * wk[j][e]; hi[j] = bf2f(f2bf(v)); lo[j] = v - hi[j]; }
            u32x2 oh, ol; oh.x = cvt_pk_bf16(hi[0], hi[1]); oh.y = cvt_pk_bf16(hi[2], hi[3]); ol.x = cvt_pk_bf16(lo[0], lo[1]); ol.y = cvt_pk_bf16(lo[2], lo[3]);
            *(u32x2*)(gwh + e * GWP + k0) = oh; *(u32x2*)(gwl + e * GWP + k0) = ol;
        }
        const float ct = bfly16(ce, lane);
        if ((lane & 12) == 0) part_c[w * 16 + bfly16_slot(lane)] = ct;
        if (tid < 16) lcnt[tid] = 0u;
    }
    __syncthreads();
    {
        const bf16_t* xp = XB + (size_t)(row0 + w * 16 + fr) * ND + fq * 8;
        const bf16_t* hp = gwh + fr * GWP + fq * 8;
        const bf16_t* lp = gwl + fr * GWP + fq * 8;
        f32x4 ah[2], al[2], sq[2];
        ah[0] = ah[1] = al[0] = al[1] = sq[0] = sq[1] = (f32x4){0.f, 0.f, 0.f, 0.f};
        bf16x8 xa[8], xn[8];
#pragma unroll
        for (int i = 0; i < 8; ++i) xa[i] = *(const bf16x8*)(xp + i * 32);
        for (int kb = 0; kb < 64; kb += 8) {
            const int kn = (kb + 8 < 64) ? kb + 8 : kb;
#pragma unroll
            for (int i = 0; i < 8; ++i) xn[i] = *(const bf16x8*)(xp + (kn + i) * 32);
#pragma unroll
            for (int i = 0; i < 8; ++i) {
                const bf16x8 bh = *(const bf16x8*)(hp + (kb + i) * 32), bl = *(const bf16x8*)(lp + (kb + i) * 32);
                ah[i & 1] = __builtin_amdgcn_mfma_f32_16x16x32_bf16(xa[i], bh, ah[i & 1], 0, 0, 0);
                al[i & 1] = __builtin_amdgcn_mfma_f32_16x16x32_bf16(xa[i], bl, al[i & 1], 0, 0, 0);
                sq[i & 1] = __builtin_amdgcn_mfma_f32_16x16x32_bf16(xa[i], xa[i], sq[i & 1], 0, 0, 0);
            }
#pragma unroll
            for (int i = 0; i < 8; ++i) xa[i] = xn[i];
        }
#pragma unroll
        for (int j = 0; j < 4; ++j) {
            float* pr = part + (size_t)(w * 16 + fq * 4 + j) * 17;
            pr[fr] = (ah[0][j] + ah[1][j]) + (al[0][j] + al[1][j]);
            if (fr == fq * 4 + j) pr[16] = sq[0][j] + sq[1][j];
        }
    }
    __syncthreads();
    int re0 = 0, re1 = 0; unsigned rp0 = 0, rp1 = 0; float rg0 = 0.f, rg1 = 0.f;
    if (tid < RB) {
        float lg[16], ss = 0.f;
#pragma unroll
        for (int e = 0; e < 16; ++e) lg[e] = 0.f;
        {
            const float* pr = part + (size_t)tid * 17;
#pragma unroll
            for (int e = 0; e < 16; ++e) lg[e] += pr[e];
            ss += pr[16];
        }
        const float rs = rsqrtf(ss * (1.0f / ND) + RMS_EPS);
        rs_lds[tid] = rs;
#pragma unroll
        for (int e = 0; e < 16; ++e) {
            float c = 0.f;
#pragma unroll
            for (int ww = 0; ww < 8; ++ww) c += part_c[ww * 16 + e];
            lg[e] = lg[e] * rs + c;
        }
        float mx = lg[0];
#pragma unroll
        for (int e = 1; e < 16; ++e) mx = fmaxf(mx, lg[e]);
        float p[16], sum = 0.f;
#pragma unroll
        for (int e = 0; e < 16; ++e) { p[e] = __expf(lg[e] - mx); sum += p[e]; }
        const float isum = 1.f / sum;
        float sel[16];
#pragma unroll
        for (int e = 0; e < 16; ++e) { p[e] *= isum; sel[e] = p[e] + b_router[e]; }
        int grp = 0; float best = -1e30f;
#pragma unroll
        for (int gI = 0; gI < 4; ++gI) {
            float m1 = -1e30f, m2 = -1e30f;
#pragma unroll
            for (int j = 0; j < 4; ++j) { const float sv = sel[gI * 4 + j]; if (sv > m1) { m2 = m1; m1 = sv; } else if (sv > m2) { m2 = sv; } }
            const float gs = m1 + m2;
            if (gs > best) { best = gs; grp = gI; }
        }
        float s4[4], p4[4];
#pragma unroll
        for (int j = 0; j < 4; ++j) { s4[j] = 0.f; p4[j] = 0.f; }
#pragma unroll
        for (int gI = 0; gI < 4; ++gI)
#pragma unroll
            for (int j = 0; j < 4; ++j) if (grp == gI) { s4[j] = sel[gI * 4 + j]; p4[j] = p[gI * 4 + j]; }
        int i1 = 0; float v1 = s4[0];
#pragma unroll
        for (int j = 1; j < 4; ++j) if (s4[j] > v1) { v1 = s4[j]; i1 = j; }
        int i2 = -1; float v2 = -1e30f;
#pragma unroll
        for (int j = 0; j < 4; ++j) if (j != i1 && s4[j] > v2) { v2 = s4[j]; i2 = j; }
        float pa = 0.f, pb = 0.f;
#pragma unroll
        for (int j = 0; j < 4; ++j) { if (j == i1) pa = p4[j]; if (j == i2) pb = p4[j]; }
        const float inv = 1.f / (pa + pb);
        re0 = grp * 4 + i1; re1 = grp * 4 + i2; rg0 = pa * inv; rg1 = pb * inv;
        rp0 = atomicAdd(&lcnt[re0], 1u);
        rp1 = atomicAdd(&lcnt[re1], 1u);
    }
    __syncthreads();
    if (tid < 16) lcnt[16 + tid] = atomicAdd(cnt + tid * 64, lcnt[tid]);
    __syncthreads();
    if (tid < RB) {
        const int t = row0 + tid;
        const unsigned p0 = lcnt[16 + re0] + rp0, p1 = lcnt[16 + re1] + rp1;
        idx[re0 * 32768 + p0] = t * 2 + 0; gts[re0 * 32768 + p0] = rg0;
        idx[re1 * 32768 + p1] = t * 2 + 1; gts[re1 * 32768 + p1] = rg1;
    }
    for (int rb = 0; rb < 64; rb += 8) {
        u32x4 xr[8];
#pragma unroll
        for (int q = 0; q < 8; ++q) xr[q] = *(const u32x4*)(XB + (size_t)(row0 + rh * 64 + rb + q) * ND + col0);
#pragma unroll
        for (int q = 0; q < 8; ++q) {
            const float rs = rs_lds[rh * 64 + rb + q];
            u32x2 o;
            o.x = pack_fp8x4(bflo(xr[q].x) * rs * gg[0] + shv[0], bfhi(xr[q].x) * rs * gg[1] + shv[1], bflo(xr[q].y) * rs * gg[2] + shv[2], bfhi(xr[q].y) * rs * gg[3] + shv[3]);
            o.y = pack_fp8x4(bflo(xr[q].z) * rs * gg[4] + shv[4], bfhi(xr[q].z) * rs * gg[5] + shv[5], bflo(xr[q].w) * rs * gg[6] + shv[6], bfhi(xr[q].w) * rs * gg[7] + shv[7]);
            *(u32x2*)(H8 + (size_t)(row0 + rh * 64 + rb + q) * ND + col0) = o;
        }
    }
    __syncthreads();
}

constexpr int BM = 256, BK = 64, HALF = 128, HT = HALF * BK;
__device__ __forceinline__ int lds_byte(int r, int c) {
    const int st = (r >> 4) * 2 + (c >> 5), rr = r & 15, cc = c & 31, ob = rr * 64 + cc * 2;
    return st * 1024 + (ob ^ (((ob >> 9) & 1) << 5));
}
__device__ __forceinline__ void stage_rc(int b, int& R, int& C) {
    const int st = b / 1024, sb = b % 1024, swz = sb ^ (((sb >> 9) & 1) << 5);
    R = (st >> 1) * 16 + swz / 64; C = (st & 1) * 32 + (swz % 64) / 2;
}

typedef int v8i __attribute__((ext_vector_type(8)));
typedef int i32x4 __attribute__((ext_vector_type(4)));
template <bool F8, class RowOff, class Epi>
__device__ __forceinline__ void gemm_unit(int wv, bf16_t* shm, const bf16_t* __restrict__ A_in, const RowOff& rowoff, const bf16_t* __restrict__ Bt_in, int ldb, int K, const Epi& epi) {
    const bf16_t* A; const bf16_t* Bt;
#define SA(b, h) (shm + ((b) * 2 + (h)) * HT)
#define SB(b, h) (shm + (4 + (b) * 2 + (h)) * HT)
#define GLDS(sbase, voff, m0v) do { unsigned _keep; asm volatile("s_mov_b32 %0, m0\n\ts_mov_b32 m0, %3\n\ts_nop 0\n\tglobal_load_lds_dwordx4 %1, %2\n\ts_mov_b32 m0, %0" \
        : "=&s"(_keep) : "v"(voff), "s"(sbase), "s"(m0v) : "memory"); } while (0)
#define STAGE_A(P, h, kt) do { const char* _ab = (const char*)A + (size_t)(kt) * (BK * 2) + (h) * a_h; const unsigned _m0 = ldsb + (unsigned)((char*)(P) - (char*)shm) + (unsigned)wv * 1024u; \
        GLDS(_ab, aoff[h][0], _m0); GLDS(_ab + a_i, aoff[h][1], _m0 + 8192u); } while (0)
#define STAGE_B(P, h, kt) do { const char* _bb = (const char*)Bt + ((size_t)((h) * HALF) * ldb + (size_t)(kt) * BK) * 2; const unsigned _m0 = ldsb + (unsigned)((char*)(P) - (char*)shm) + (unsigned)wv * 1024u; \
        GLDS(_bb, boff, _m0); GLDS(_bb + (size_t)64 * ldb * 2, boff, _m0 + 8192u); } while (0)
#define LDFRAG(dst, base, row) do { const i32x4 _lo = *reinterpret_cast<const i32x4*>((char*)(base) + lds_byte((row), fq * 8)); \
        const i32x4 _hi = *reinterpret_cast<const i32x4*>((char*)(base) + lds_byte((row), 32 + fq * 8)); \
        dst = __builtin_shufflevector(_lo, _hi, 0, 1, 2, 3, 4, 5, 6, 7); } while (0)
#define LDA(dst, b, h) _Pragma("unroll") for (int m = 0; m < 4; ++m) LDFRAG(dst[m], SA(b, h), wr * 64 + m * 16 + fr)
#define LDB(dst, b, h) _Pragma("unroll") for (int n = 0; n < 2; ++n) LDFRAG(dst[n], SB(b, h), wc * 32 + n * 16 + fr)
#define MMA(ai, bj, Af, Bf) do { __builtin_amdgcn_s_setprio(1); \
        _Pragma("unroll") for (int m = 0; m < 4; ++m) _Pragma("unroll") for (int n = 0; n < 2; ++n) { \
            if (F8) acc[ai][bj][m][n] = __builtin_amdgcn_mfma_scale_f32_16x16x128_f8f6f4(Bf[n], Af[m], acc[ai][bj][m][n], 0, 0, 0, 0, 0, 0);     \
            else { acc[ai][bj][m][n] = __builtin_amdgcn_mfma_f32_16x16x32_bf16(__builtin_bit_cast(bf16x8, __builtin_shufflevector(Bf[n], Bf[n], 0, 1, 2, 3)), __builtin_bit_cast(bf16x8, __builtin_shufflevector(Af[m], Af[m], 0, 1, 2, 3)), acc[ai][bj][m][n], 0, 0, 0); \
                   acc[ai][bj][m][n] = __builtin_amdgcn_mfma_f32_16x16x32_bf16(__builtin_bit_cast(bf16x8, __builtin_shufflevector(Bf[n], Bf[n], 4, 5, 6, 7)), __builtin_bit_cast(bf16x8, __builtin_shufflevector(Af[m], Af[m], 4, 5, 6, 7)), acc[ai][bj][m][n], 0, 0, 0); } } \
        __builtin_amdgcn_s_setprio(0); } while (0)
#define WAIT_V(n) asm volatile("s_waitcnt vmcnt(" #n ")" ::: "memory")
#define WAIT_L(n) asm volatile("s_waitcnt lgkmcnt(" #n ")" ::: "memory")
#define BAR __builtin_amdgcn_s_barrier()
#define SCHED __builtin_amdgcn_sched_barrier(0)
    asm volatile("" : "+s"(wv));
    int tx = tid_fresh(wv);
    constexpr unsigned ldsb = 0u;
    {
        const size_t a_ = (size_t)A_in, b_ = (size_t)Bt_in;
        A = (const bf16_t*)(((size_t)(unsigned)__builtin_amdgcn_readfirstlane((int)(a_ >> 32)) << 32) | (size_t)(unsigned)__builtin_amdgcn_readfirstlane((int)a_));
        Bt = (const bf16_t*)(((size_t)(unsigned)__builtin_amdgcn_readfirstlane((int)(b_ >> 32)) << 32) | (size_t)(unsigned)__builtin_amdgcn_readfirstlane((int)b_));
    }
    int lane = tx & 63, wr = wv >> 2, wc = wv & 3, fr = lane & 15, fq = lane >> 4;
    unsigned aoff[2][2], boff;
    {
        int r0, c0; stage_rc(tx * 16, r0, c0);
        boff = (unsigned)(r0 * ldb + c0) * 2u;
        if (RowOff::PLAIN) { aoff[0][0] = (rowoff(r0) + (unsigned)c0) * 2u; aoff[0][1] = aoff[0][0]; aoff[1][0] = aoff[0][0]; aoff[1][1] = aoff[0][0]; }
        else {
            aoff[0][0] = (rowoff(r0) + (unsigned)c0) * 2u; aoff[0][1] = (rowoff(r0 + 64) + (unsigned)c0) * 2u;
            aoff[1][0] = (rowoff(HALF + r0) + (unsigned)c0) * 2u; aoff[1][1] = (rowoff(HALF + r0 + 64) + (unsigned)c0) * 2u;
        }
    }
    const size_t a_h = RowOff::PLAIN ? (size_t)rowoff.ld * HALF * 2 : 0, a_i = RowOff::PLAIN ? (size_t)rowoff.ld * 64 * 2 : 0;
    f32x4 acc[2][2][4][2] = {};
    v8i At[4] = {}, B0[2] = {}, B1[2] = {};
    const int nt = K / BK;
    STAGE_B(SB(0, 0), 0, 0); STAGE_A(SA(0, 0), 0, 0);
    STAGE_B(SB(0, 1), 1, 0); STAGE_A(SA(0, 1), 1, 0);
    if (wr == 1) BAR;
    WAIT_V(4); BAR;
    STAGE_B(SB(1, 0), 0, 1); STAGE_A(SA(1, 0), 0, 1); STAGE_B(SB(1, 1), 1, 1);
    WAIT_V(6); BAR;
    for (int t = 0; t < nt - 2; t += 2) {
        LDB(B0, 0, 0); SCHED; LDA(At, 0, 0); STAGE_A(SA(1, 1), 1, t + 1);
        WAIT_L(8); BAR; WAIT_L(0); MMA(0, 0, At, B0); BAR; SCHED;
        LDB(B1, 0, 1); STAGE_B(SB(0, 0), 0, t + 2);
        BAR; WAIT_L(0); MMA(0, 1, At, B1); BAR;
        LDA(At, 0, 1); STAGE_A(SA(0, 0), 0, t + 2);
        BAR; WAIT_L(0); MMA(1, 0, At, B0); BAR; SCHED;
        STAGE_B(SB(0, 1), 1, t + 2);
        WAIT_V(6); BAR; MMA(1, 1, At, B1); BAR;
        LDB(B0, 1, 0); SCHED; LDA(At, 1, 0); STAGE_A(SA(0, 1), 1, t + 2);
        WAIT_L(8); BAR; WAIT_L(0); MMA(0, 0, At, B0); BAR; SCHED;
        LDB(B1, 1, 1); STAGE_B(SB(1, 0), 0, t + 3);
        BAR; WAIT_L(0); MMA(0, 1, At, B1); BAR;
        LDA(At, 1, 1); STAGE_A(SA(1, 0), 0, t + 3);
        BAR; WAIT_L(0); MMA(1, 0, At, B0); BAR; SCHED;
        STAGE_B(SB(1, 1), 1, t + 3);
        WAIT_V(6); BAR; MMA(1, 1, At, B1); BAR;
    }
    { LDB(B0, 0, 0); WAIT_V(0); LDA(At, 0, 0); STAGE_A(SA(1, 1), 1, nt - 1);
      BAR; WAIT_L(0); MMA(0, 0, At, B0); BAR;
      LDB(B1, 0, 1); BAR; WAIT_L(0); MMA(0, 1, At, B1); BAR;
      LDA(At, 0, 1); WAIT_V(4); BAR; WAIT_L(0); MMA(1, 0, At, B0); MMA(1, 1, At, B1); BAR; }
    { LDB(B0, 1, 0); LDA(At, 1, 0); WAIT_V(2); BAR; WAIT_L(0); MMA(0, 0, At, B0); BAR;
      LDB(B1, 1, 1); WAIT_V(0); BAR; WAIT_L(0); MMA(0, 1, At, B1); BAR;
      LDA(At, 1, 1); BAR; WAIT_L(0); MMA(1, 0, At, B0); MMA(1, 1, At, B1); BAR; }
    if (wr == 0) BAR;
    int tz = tid_fresh(wv); lane = tz & 63; fr = lane & 15; fq = lane >> 4;
    Epi epi2 = epi; epi2.launder();
    epi2(acc, wr, wc, fr, fq);
#undef SA
#undef SB
#undef STAGE_A
#undef GLDS
#undef STAGE_B
#undef LDA
#undef LDFRAG
#undef LDB
#undef MMA
#undef WAIT_V
#undef WAIT_L
#undef BAR
#undef SCHED
}

__device__ __forceinline__ int unit_index(int k) { return (gridDim.x == 256) ? ((k * 8 + (int)(blockIdx.x & 7)) * 32 + (int)(blockIdx.x >> 3)) : (k * (int)gridDim.x + (int)blockIdx.x); }
__device__ __forceinline__ void dense_tile(int i, int nN, int& pm, int& pn) { const int g = i / (8 * nN), rem = i - g * 8 * nN; pn = rem >> 3; pm = g * 8 + (rem & 7); }
__device__ __forceinline__ int lauv(int v) { v = __builtin_amdgcn_readfirstlane(v); asm volatile("" : "+s"(v)); return v; }
template <class T> __device__ __forceinline__ T* lauv(T* p) { const size_t a_ = (size_t)p; unsigned lo = (unsigned)__builtin_amdgcn_readfirstlane((int)a_), hi = (unsigned)__builtin_amdgcn_readfirstlane((int)(a_ >> 32)); asm volatile("" : "+s"(lo), "+s"(hi)); return (T*)(((size_t)hi << 32) | lo); }
struct RowPlain { static constexpr bool PLAIN = true; unsigned base; unsigned ld; __device__ __forceinline__ unsigned operator()(int r) const { return base + (unsigned)r * ld; } };

typedef f32x4 AccT[2][2][4][2];

__device__ __forceinline__ void st_bf16x4(bf16_t* p, f32x4 v) { u32x2 o; o.x = cvt_pk_bf16(v[0], v[1]); o.y = cvt_pk_bf16(v[2], v[3]); *(GAS u32x2*)p = o; }

typedef float f32x2_t __attribute__((ext_vector_type(2)));
struct EpiIn0 {
    unsigned char* proj; const float2* rot; int pm, pn; LAS bf16_t* tl  ; int wv; float sc  ;
    __device__ __forceinline__ void launder() { proj = lauv(proj); rot = lauv(rot); pm = lauv(pm); pn = lauv(pn); }
    __device__ __forceinline__ void tile_out(bf16_t* gbase  ) const {
        __syncthreads();
        const int tid = tid_fresh(wv);
#pragma unroll
        for (int it = 0; it < 16; ++it) {
            const int c = tid + it * NT, d = c >> 5, ch = c & 31;
            *(GAS u32x4*)(gbase + (size_t)((ch >> 3) * 256 + d) * 64 + (ch & 7) * 8) = *(const LAS u32x4*)(tl + d * 264 + ch * 8);
        }
        __syncthreads();
    }
    __device__ __forceinline__ void operator()(const AccT& acc, int wr, int wc, int fr, int fq) const {
        const int row0 = pm * BM + wr * 64 + fr;
        if (pn < 4) {
            bf16_t* O = (bf16_t*)(proj + PJ_AB);
#pragma unroll
            for (int ai = 0; ai < 2; ++ai)
#pragma unroll
                for (int m = 0; m < 4; ++m) { bf16_t* rp = O + (size_t)(row0 + ai * HALF + m * 16) * 1024 + pn * 256 + wc * 32 + fq * 4;
#pragma unroll
                    for (int bj = 0; bj < 2; ++bj)
#pragma unroll
                        for (int n = 0; n < 2; ++n) st_bf16x4(rp + bj * HALF + n * 16, acc[ai][bj][m][n] * sc); }
        } else if (pn < 12) {
            bf16_t* O = (bf16_t*)(proj + PJ_U);
#pragma unroll
            for (int ai = 0; ai < 2; ++ai)
#pragma unroll
                for (int m = 0; m < 4; ++m) { bf16_t* rp = O + (size_t)(row0 + ai * HALF + m * 16) * 1024 + (pn - 4) * 128 + wc * 32 + fq * 4;
#pragma unroll
                    for (int n = 0; n < 2; ++n) st_bf16x4(rp + n * 16, acc[ai][0][m][n] * acc[ai][1][m][n] * (sc * sc)); }
        } else if (pn < 20) {
            const bool isk = pn >= 16; const int hh = (pn - 12) & 3;
            const float lg2 = log2f(1.0f - exp2f(-5.0f - (float)hh));
            bf16_t* O = (bf16_t*)(proj + (isk ? PJ_K : PJ_Q));
#pragma unroll
            for (int ai = 0; ai < 2; ++ai)
#pragma unroll
                for (int m = 0; m < 4; ++m) {
                    const int t = row0 + ai * HALF + m * 16, pos = t & (NS - 1), bb = t >> 11;
                    const int pc = pos & 63;
                    const float dsc = (isk ? 0.0625f * exp2f(-lg2 * (float)pc) : exp2f(lg2 * (float)pc)) * sc;
                    bf16_t* rp = O + (size_t)t * 1024 + hh * 256 + wc * 32 + fq * 4;
#pragma unroll
                    for (int n = 0; n < 2; ++n) {
                        const int f0 = wc * 32 + n * 16 + fq * 4;
                        f32x4 o1, o2;
#pragma unroll
                        for (int j = 0; j < 4; ++j) {
                            const f32x2_t csv = *(const GAS f32x2_t*)(rot + pos * 128 + f0 + j); const float2 cs = make_float2(csv[0], csv[1]);
                            const float x1 = acc[ai][0][m][n][j], x2 = acc[ai][1][m][n][j];
                            o1[j] = (x1 * cs.x - x2 * cs.y) * dsc; o2[j] = (x1 * cs.y + x2 * cs.x) * dsc;
                        }
                        st_bf16x4(rp + n * 16, o1); st_bf16x4(rp + HALF + n * 16, o2);
                    }
                }
        } else if (pn < 24) {
            const int hh = pn - 20; bf16_t* OT = (bf16_t*)(proj + PJ_VT);
#pragma unroll
            for (int ai = 0; ai < 2; ++ai)
#pragma unroll
                for (int m = 0; m < 4; ++m) {
                    const int t = row0 + ai * HALF + m * 16;
#pragma unroll
                    for (int bj = 0; bj < 2; ++bj)
#pragma unroll
                        for (int n = 0; n < 2; ++n) {
                            LAS bf16_t* tp = tl + (bj * HALF + wc * 32 + n * 16 + fq * 4) * 264 + (t & 255);
#pragma unroll
                            for (int j = 0; j < 4; ++j) tp[j * 264] = f2bf(acc[ai][bj][m][n][j] * sc);
                        }
                }
            tile_out(OT + ((size_t)((((pm * BM) >> 11) * 4 + hh) * 32 + (((pm * BM) & (NS - 1)) >> 6)) * 256) * 64);
        } else {
            bf16_t* O = (bf16_t*)(proj + PJ_SG);
#pragma unroll
            for (int ai = 0; ai < 2; ++ai)
#pragma unroll
                for (int m = 0; m < 4; ++m) { bf16_t* rp = O + (size_t)(row0 + ai * HALF + m * 16) * 1024 + (pn - 24) * 256 + wc * 32 + fq * 4;
#pragma unroll
                    for (int bj = 0; bj < 2; ++bj)
#pragma unroll
                        for (int n = 0; n < 2; ++n) { f32x4 v = acc[ai][bj][m][n];
#pragma unroll
                            for (int j = 0; j < 4; ++j) v[j] = silu_f(v[j] * sc);
                            st_bf16x4(rp + bj * HALF + n * 16, v); } }
        }
    }
};

template <bool ADD_TMP, bool XIN_F32>
struct EpiRes {
    const void* xin; const bf16_t* tmp; bf16_t* xout; const float* gate  ; int pm, pn; float sc;
    __device__ __forceinline__ void launder() { xin = lauv(xin); tmp = lauv(tmp); xout = lauv(xout); gate = lauv(gate); pm = lauv(pm); pn = lauv(pn); }
    __device__ __forceinline__ void operator()(const AccT& acc, int wr, int wc, int fr, int fq) const {
        const int row0 = pm * BM + wr * 64 + fr, col0 = pn * BM + wc * 32 + fq * 4;
        const int bb = (pm * BM) >> 11;
        f32x4 gv[2][2];
#pragma unroll
        for (int bj = 0; bj < 2; ++bj)
#pragma unroll
            for (int n = 0; n < 2; ++n) gv[bj][n] = *(const GAS f32x4*)(gate + (size_t)bb * 6144 + col0 + bj * HALF + n * 16);
#pragma unroll
        for (int ai = 0; ai < 2; ++ai)
#pragma unroll
            for (int m = 0; m < 4; ++m) {
                const size_t ro = (size_t)(row0 + ai * HALF + m * 16) * ND + col0;
#pragma unroll
                for (int bj = 0; bj < 2; ++bj)
#pragma unroll
                    for (int n = 0; n < 2; ++n) {
                        f32x4 xv = XIN_F32 ? *(const GAS f32x4*)((const float*)xin + ro + bj * HALF + n * 16) : ld_bf16x4((const bf16_t*)xin + ro + bj * HALF + n * 16);
                        if (ADD_TMP) xv += ld_bf16x4(tmp + ro + bj * HALF + n * 16);
                        st_bf16x4(xout + ro + bj * HALF + n * 16, xv + gv[bj][n] * (acc[ai][bj][m][n] * sc));
                    }
            }
    }
};

typedef short s16x4_t __attribute__((ext_vector_type(4)));
__device__ __forceinline__ void retention_phase(int wv, unsigned char* proj, bf16_t* __restrict__ Og, unsigned char* lds) {
    const int tid = tid_fresh(wv);
    bf16_t* P_lds = (bf16_t*)lds;
    bf16_t* St_lds = (bf16_t*)(lds + 9216);
    bf16_t* Q_lds = (bf16_t*)(lds + 9216 + 33792);
    bf16_t* K_lds = (bf16_t*)(lds + 9216 + 2 * 33792);
    bf16_t* V_lds = (bf16_t*)(lds + 9216 + 3 * 33792);
    const bf16_t* Qg = (const bf16_t*)(proj + PJ_Q); const bf16_t* Kg = (const bf16_t*)(proj + PJ_K);
    const bf16_t* KTg = (const bf16_t*)(proj + PJ_KT); const bf16_t* VTg = (const bf16_t*)(proj + PJ_VT);
    const int ti = wv >> 1, hf = wv & 1;
    for (int u0 = blockIdx.x; u0 < 256; u0 += gridDim.x) {
        int tu = tid; asm volatile("" : "+v"(tu));
        const int srow = tu >> 5, sc16 = tu & 31;
        const int vrow = tu >> 3, vc8 = tu & 7;
        const int fr = tu & 15, fq = (tu >> 4) & 3, w = wv;
        int u = u0;
        if (gridDim.x == 256) { const int xcd = u0 & 7, j = u0 >> 3; u = (((j >> 2) * 8 + xcd) << 2) | (j & 3); }
        const int b = u >> 4, hh = (u >> 2) & 3, es = u & 3;
        const float gam = 1.0f - exp2f(-5.0f - (float)hh);
        const float g63 = exp2f(63.0f * log2f(gam));
        const size_t hrow = (size_t)(b * 4 + hh) * 256;
        const bf16_t* qsp = Qg + ((size_t)b * NS + srow) * 1024 + hh * 256 + sc16 * 8;
        const bf16_t* ksp = Kg + ((size_t)b * NS + srow) * 1024 + hh * 256 + sc16 * 8;
        const bf16_t* vsp = VTg + (hrow * 32 + es * 64 + vrow) * 64 + vc8 * 8;
        u32x4 qr[2][4], kr[2][4], vr[2];
#pragma unroll
        for (int i = 0; i < 4; ++i) { qr[0][i] = *(const u32x4*)(qsp + (size_t)(16 * i) * 1024); kr[0][i] = *(const u32x4*)(ksp + (size_t)(16 * i) * 1024); }
        vr[0] = *(const u32x4*)vsp; vr[1] = *(const u32x4*)(vsp + 256 * 64);
        __syncthreads();
        for (int i = tid; i < 64 * 264 / 2; i += NT) ((unsigned*)St_lds)[i] = 0u;
#pragma unroll
        for (int i = 0; i < 4; ++i) { *(u32x4*)(Q_lds + (srow + 16 * i) * 264 + sc16 * 8) = qr[0][i]; *(u32x4*)(K_lds + (srow + 16 * i) * 264 + sc16 * 8) = kr[0][i]; }
#pragma unroll
        for (int i = 0; i < 4; ++i) { qr[1][i] = *(const u32x4*)(qsp + (size_t)(64 + 16 * i) * 1024); kr[1][i] = *(const u32x4*)(ksp + (size_t)(64 + 16 * i) * 1024); }
        f32x4 S[2][4];
#pragma unroll
        for (int dl = 0; dl < 2; ++dl)
#pragma unroll
            for (int et = 0; et < 4; ++et) S[dl][et] = (f32x4){0.f, 0.f, 0.f, 0.f};
        __syncthreads();
        for (int c2 = 0; c2 < 32; c2 += 2) {
#pragma unroll
          for (int e = 0; e < 2; ++e) {
            const int c = c2 + e;
            int tl = tid; asm volatile("" : "+v"(tl));
            const int fr = tl & 15, fq = (tl >> 4) & 3, srow = tl >> 5, sc16 = tl & 31, vrow = tl >> 3, vc8 = tl & 7, w = wv;
            const bf16_t* qsp = Qg + ((size_t)b * NS + srow) * 1024 + hh * 256 + sc16 * 8;
            const bf16_t* ksp = Kg + ((size_t)b * NS + srow) * 1024 + hh * 256 + sc16 * 8;
            const bf16_t* vsp = VTg + (hrow * 32 + es * 64 + vrow) * 64 + vc8 * 8;
            const int j0 = c * 64;
            const size_t trow = (size_t)b * NS + j0;
            *(u32x4*)(V_lds + vrow * 72 + vc8 * 8) = vr[e];
            {
                const int cn = (c + 2 < 32) ? c + 2 : 31;
#pragma unroll
                for (int i = 0; i < 4; ++i) { qr[e][i] = *(const u32x4*)(qsp + (size_t)(cn * 64 + 16 * i) * 1024); kr[e][i] = *(const u32x4*)(ksp + (size_t)(cn * 64 + 16 * i) * 1024); }
                vr[e] = *(const u32x4*)(vsp + (size_t)cn * (256 * 64));
            }
            bf16x8 ktf[2][2];
#pragma unroll
            for (int dl = 0; dl < 2; ++dl)
#pragma unroll
                for (int ks = 0; ks < 2; ++ks) {
                    const bf16_t* kp = K_lds + (ks * 32 + fq * 8 + (fr >> 2)) * 264 + (2 * w + dl) * 16 + (fr & 3) * 4;
                    const s16x4_t t0 = __builtin_amdgcn_ds_read_tr16_b64_v4i16((__attribute__((address_space(3))) s16x4_t*)(kp));
                    const s16x4_t t1 = __builtin_amdgcn_ds_read_tr16_b64_v4i16((__attribute__((address_space(3))) s16x4_t*)(kp + 4 * 264));
                    ktf[dl][ks] = __builtin_bit_cast(bf16x8, __builtin_shufflevector(t0, t1, 0, 1, 2, 3, 4, 5, 6, 7));
                }
            f32x4 pacc[2], oacc[2];
            pacc[0] = pacc[1] = oacc[0] = oacc[1] = (f32x4){0.f, 0.f, 0.f, 0.f};
            bf16x8 opA[5], opB[5];
#define RET_SB __builtin_amdgcn_sched_barrier(0);
#define RET_RD(buf, ks) { buf[4] = *(const bf16x8*)(Q_lds + (ti * 16 + fr) * 264 + (ks) * 32 + fq * 8); \
                buf[0] = *(const bf16x8*)(K_lds + ((hf * 2 + 0) * 16 + fr) * 264 + (ks) * 32 + fq * 8); buf[1] = *(const bf16x8*)(K_lds + ((hf * 2 + 1) * 16 + fr) * 264 + (ks) * 32 + fq * 8); \
                buf[2] = *(const bf16x8*)(St_lds + ((hf * 2 + 0) * 16 + fr) * 264 + (ks) * 32 + fq * 8); buf[3] = *(const bf16x8*)(St_lds + ((hf * 2 + 1) * 16 + fr) * 264 + (ks) * 32 + fq * 8); }
#define RET_MM(buf, ks) { \
                pacc[0] = __builtin_amdgcn_mfma_f32_16x16x32_bf16(buf[0], buf[4], pacc[0], 0, 0, 0); pacc[1] = __builtin_amdgcn_mfma_f32_16x16x32_bf16(buf[1], buf[4], pacc[1], 0, 0, 0); \
                oacc[0] = __builtin_amdgcn_mfma_f32_16x16x32_bf16(buf[2], buf[4], oacc[0], 0, 0, 0); oacc[1] = __builtin_amdgcn_mfma_f32_16x16x32_bf16(buf[3], buf[4], oacc[1], 0, 0, 0); }
            RET_RD(opA, 0) RET_RD(opB, 1) RET_SB
            RET_MM(opA, 0) RET_SB RET_RD(opA, 2) RET_SB RET_MM(opB, 1) RET_SB RET_RD(opB, 3) RET_SB
            RET_MM(opA, 2) RET_SB RET_RD(opA, 4) RET_SB RET_MM(opB, 3) RET_SB RET_RD(opB, 5) RET_SB
            RET_MM(opA, 4) RET_SB RET_RD(opA, 6) RET_SB RET_MM(opB, 5) RET_SB RET_RD(opB, 7) RET_SB
            RET_MM(opA, 6) RET_SB RET_MM(opB, 7) RET_SB
#undef RET_RD
#undef RET_MM
#pragma unroll
            for (int tt = 0; tt < 2; ++tt) {
                const int tj = hf * 2 + tt;
                { const int i = ti * 16 + fr, jc = tj * 16 + fq * 4; f32x4 pv = pacc[tt];
#pragma unroll
                  for (int j = 0; j < 4; ++j) pv[j] = (jc + j <= i) ? pv[j] : 0.f;
                  u32x2 o; o.x = cvt_pk_bf16(pv[0], pv[1]); o.y = cvt_pk_bf16(pv[2], pv[3]); *(u32x2*)(P_lds + i * 72 + jc) = o; }
            }
            __syncthreads();
#pragma unroll
            for (int i = 0; i < 4; ++i) { *(u32x4*)(Q_lds + (srow + 16 * i) * 264 + sc16 * 8) = qr[e ^ 1][i]; *(u32x4*)(K_lds + (srow + 16 * i) * 264 + sc16 * 8) = kr[e ^ 1][i]; }
            bf16x8 pf[2], vfo[2][2], vf[4][2];
#pragma unroll
            for (int ks = 0; ks < 2; ++ks) {
                pf[ks] = *(const bf16x8*)(P_lds + (ti * 16 + fr) * 72 + ks * 32 + fq * 8);
#pragma unroll
                for (int tt = 0; tt < 2; ++tt) vfo[tt][ks] = *(const bf16x8*)(V_lds + ((hf * 2 + tt) * 16 + fr) * 72 + ks * 32 + fq * 8);
#pragma unroll
                for (int et = 0; et < 4; ++et) vf[et][ks] = *(const bf16x8*)(V_lds + (et * 16 + fr) * 72 + ks * 32 + fq * 8);
            }
            oacc[0] *= gam; oacc[1] *= gam;
#pragma unroll
            for (int dl = 0; dl < 2; ++dl)
#pragma unroll
                for (int et = 0; et < 4; ++et) S[dl][et] *= gam;
            RET_SB
#pragma unroll
            for (int ks = 0; ks < 2; ++ks) {
                oacc[0] = __builtin_amdgcn_mfma_f32_16x16x32_bf16(vfo[0][ks], pf[ks], oacc[0], 0, 0, 0);
                oacc[1] = __builtin_amdgcn_mfma_f32_16x16x32_bf16(vfo[1][ks], pf[ks], oacc[1], 0, 0, 0);
#pragma unroll
                for (int dl = 0; dl < 2; ++dl)
#pragma unroll
                    for (int et = 0; et < 4; ++et) S[dl][et] = __builtin_amdgcn_mfma_f32_16x16x32_bf16(ktf[dl][ks], vf[et][ks], S[dl][et], 0, 0, 0);
            }
            RET_SB
#pragma unroll
            for (int tt = 0; tt < 2; ++tt) {
                const int te = hf * 2 + tt;
                st_bf16x4(Og + (trow + ti * 16 + fr) * 1024 + hh * 256 + es * 64 + te * 16 + fq * 4, oacc[tt]);
            }
#pragma unroll
            for (int dl = 0; dl < 2; ++dl)
#pragma unroll
                for (int et = 0; et < 4; ++et) {
                    const f32x4 sv = S[dl][et] * g63; S[dl][et] = sv;
                    u32x2 o; o.x = cvt_pk_bf16(sv[0], sv[1]); o.y = cvt_pk_bf16(sv[2], sv[3]);
                    *(u32x2*)(St_lds + (et * 16 + fr) * 264 + (2 * w + dl) * 16 + fq * 4) = o;
                }
#undef RET_SB
            __syncthreads();
          }
        }
    }
}

__device__ __forceinline__ void ycat_phase(int wv, const unsigned char* proj, const bf16_t* __restrict__ Og, const float* __restrict__ conv_w, const float* __restrict__ conv_b, bf16_t* __restrict__ Y) {
    const int tid = tid_fresh(wv), lane = tid & 63, wave = tid >> 6;
    const bf16_t* AB = (const bf16_t*)(proj + PJ_AB); const bf16_t* U = (const bf16_t*)(proj + PJ_U); const bf16_t* SG = (const bf16_t*)(proj + PJ_SG);
    const int ch0 = lane * 16;
    float cw0[16], cw1[16], cw2[16], cb[16];
#pragma unroll
    for (int i = 0; i < 16; ++i) { cw0[i] = conv_w[ch0 + i]; cw1[i] = conv_w[1024 + ch0 + i]; cw2[i] = conv_w[2048 + ch0 + i]; cb[i] = conv_b[ch0 + i]; }
    const int rows_per_wave = NTOK / ((int)gridDim.x * 8);
    const int row0 = (blockIdx.x * 8 + wave) * rows_per_wave;
    float u1[16], u2[16];
    auto load16 = [&](const bf16_t* p, float* f) {
        const u32x4 a = *(const u32x4*)p; const u32x4 c = *(const u32x4*)(p + 8);
        f[0] = bflo(a.x); f[1] = bfhi(a.x); f[2] = bflo(a.y); f[3] = bfhi(a.y); f[4] = bflo(a.z); f[5] = bfhi(a.z); f[6] = bflo(a.w); f[7] = bfhi(a.w);
        f[8] = bflo(c.x); f[9] = bfhi(c.x); f[10] = bflo(c.y); f[11] = bfhi(c.y); f[12] = bflo(c.z); f[13] = bfhi(c.z); f[14] = bflo(c.w); f[15] = bfhi(c.w);
    };
    auto store16 = [&](bf16_t* p, const float* f) {
        u32x4 a, c;
        a.x = cvt_pk_bf16(f[0], f[1]); a.y = cvt_pk_bf16(f[2], f[3]); a.z = cvt_pk_bf16(f[4], f[5]); a.w = cvt_pk_bf16(f[6], f[7]);
        c.x = cvt_pk_bf16(f[8], f[9]); c.y = cvt_pk_bf16(f[10], f[11]); c.z = cvt_pk_bf16(f[12], f[13]); c.w = cvt_pk_bf16(f[14], f[15]);
        *(u32x4*)p = a; *(u32x4*)(p + 8) = c;
    };
    auto store16f8 = [&](unsigned char* p, const float* f) {
        u32x4 a;
        a.x = pack_fp8x4(f[0] * Y8_SCALE, f[1] * Y8_SCALE, f[2] * Y8_SCALE, f[3] * Y8_SCALE); a.y = pack_fp8x4(f[4] * Y8_SCALE, f[5] * Y8_SCALE, f[6] * Y8_SCALE, f[7] * Y8_SCALE);
        a.z = pack_fp8x4(f[8] * Y8_SCALE, f[9] * Y8_SCALE, f[10] * Y8_SCALE, f[11] * Y8_SCALE); a.w = pack_fp8x4(f[12] * Y8_SCALE, f[13] * Y8_SCALE, f[14] * Y8_SCALE, f[15] * Y8_SCALE);
        *(u32x4*)p = a;
    };
    {
        const int pos = row0 & (NS - 1);
#pragma unroll
        for (int i = 0; i < 16; ++i) { u1[i] = 0.f; u2[i] = 0.f; }
        if (pos >= 1) load16(U + (size_t)(row0 - 1) * 1024 + ch0, u1);
        if (pos >= 2) load16(U + (size_t)(row0 - 2) * 1024 + ch0, u2);
    }
    for (int r = 0; r < rows_per_wave; ++r) {
        const int t = row0 + r;
        float ab[16], u0[16], y[16];
        load16(AB + (size_t)t * 1024 + ch0, ab); load16(U + (size_t)t * 1024 + ch0, u0);
        if ((t & (NS - 1)) == 0) {
#pragma unroll
            for (int i = 0; i < 16; ++i) { u1[i] = 0.f; u2[i] = 0.f; }
        }
#pragma unroll
        for (int i = 0; i < 16; ++i) { y[i] = ab[i] * (cb[i] + cw0[i] * u2[i] + cw1[i] * u1[i] + cw2[i] * u0[i]); u2[i] = u1[i]; u1[i] = u0[i]; }
        if (F8_P5) store16f8((unsigned char*)Y + (size_t)t * ND + ch0, y); else store16(Y + (size_t)t * ND + ch0, y);
        float o[16], sg[16];
        load16(Og + (size_t)t * 1024 + ch0, o); load16(SG + (size_t)t * 1024 + ch0, sg);
        float ss = 0.f;
#pragma unroll
        for (int i = 0; i < 16; ++i) ss += o[i] * o[i];
        ss += shx(ss, 1, lane); ss += shx(ss, 2, lane); ss += shx(ss, 4, lane); ss += shx(ss, 8, lane);
        const float rs = rsqrtf(ss * (1.0f / 256.0f) + RMS_EPS);
#pragma unroll
        for (int i = 0; i < 16; ++i) y[i] = o[i] * rs * sg[i];
        if (F8_P5) store16f8((unsigned char*)Y + (size_t)t * ND + 1024 + ch0, y); else store16(Y + (size_t)t * ND + 1024 + ch0, y);
    }
}

constexpr int MOE_TAB_OFF = 64;
__device__ __forceinline__ int moe_build_table(int wv, const unsigned* cntp, unsigned char* lds) {
    volatile LAS int* tab = (volatile LAS int*)(lds + LDS_MISC + MOE_TAB_OFF);
    __syncthreads();
    if (wv == 0) {
        const int lane = tid_fresh(wv) & 63;
        if (lane == 0) {
            int mt = 0;
            for (int e = 0; e < 16; ++e) {
                const int c = (int)__hip_atomic_load(cntp + e * 64, __ATOMIC_RELAXED, __HIP_MEMORY_SCOPE_AGENT);
                for (int lt = 0; lt * 256 < c; ++lt) { tab[4 + mt * 4 + 0] = e; tab[4 + mt * 4 + 1] = lt * 256; tab[4 + mt * 4 + 2] = c; ++mt; }
            }
            tab[0] = mt;
        }
    }
    __syncthreads();
    return __builtin_amdgcn_readfirstlane(tab[0]);
}
struct RowGather {
    static constexpr bool PLAIN = false; static constexpr unsigned ld = 0;
    const int* idx; int nvalid;
    __device__ __forceinline__ unsigned operator()(int r) const {
        const __amdgpu_buffer_rsrc_t rs = __builtin_amdgcn_make_buffer_rsrc((void*)idx, 0, 256 * 4, 0x00020000);
        const int v = (r < nvalid) ? (int)__builtin_amdgcn_raw_buffer_load_b32(rs, r * 4, 0, 0) : 0;
        return (unsigned)(v >> 1) * (unsigned)(ND / 2);
    }
};
struct EpiGate {
    bf16_t* act; int row0g  , colbase;
    __device__ __forceinline__ void launder() { act = lauv(act); row0g = lauv(row0g); colbase = lauv(colbase); }
    __device__ __forceinline__ void operator()(const AccT& acc, int wr, int wc, int fr, int fq) const {
        const int lo = fr * DEXP + fq * 4;
        const __amdgpu_buffer_rsrc_t rs = __builtin_amdgcn_make_buffer_rsrc((void*)((unsigned char*)act + (size_t)(row0g + wr * 64) * DEXP + colbase + wc * 32), 0, 256 * DEXP, 0x00020000);
#pragma unroll
        for (int ai = 0; ai < 2; ++ai)
#pragma unroll
            for (int m = 0; m < 4; ++m) {
#pragma unroll
                for (int n = 0; n < 2; ++n) { f32x4 v;
#pragma unroll
                    for (int j = 0; j < 4; ++j) v[j] = silu_f(acc[ai][0][m][n][j] * (1.0f / W8_SCALE)) * acc[ai][1][m][n][j] * (A8_SCALE / W8_SCALE);
                    __builtin_amdgcn_raw_buffer_store_b32(pack_fp8x4(v[0], v[1], v[2], v[3]), rs, lo + n * 16, (ai * HALF + m * 16) * DEXP, 0); } }
    }
};
constexpr float T8_SCALE = 16.0f;
struct EpiMoeOut {
    const int* idx; const float* gts; int nvalid; bf16_t* tmp1; bf16_t* tmp; const float* gate  ; int col0t; int tmp8  ;
    __device__ __forceinline__ void launder() { idx = lauv(idx); gts = lauv(gts); tmp1 = lauv(tmp1); tmp = lauv(tmp); gate = lauv(gate); nvalid = lauv(nvalid); col0t = lauv(col0t); tmp8 = lauv(tmp8); }
    __device__ __forceinline__ void operator()(const AccT& acc, int wr, int wc, int fr, int fq) const {
        const int colb = col0t + wc * 32 + fq * 4;
#pragma unroll
        for (int ai = 0; ai < 2; ++ai)
#pragma unroll
            for (int m = 0; m < 4; ++m) {
                const int r = ai * HALF + wr * 64 + m * 16 + fr;
                if (r < nvalid) {
                    const int v = ((const GAS int*)idx)[r]; const float g = ((const GAS float*)gts)[r];
                    const int tok = v >> 1;
                    const size_t ro = (size_t)tok * ND + colb;
#pragma unroll
                    for (int bj = 0; bj < 2; ++bj)
#pragma unroll
                        for (int n = 0; n < 2; ++n) {
                            const f32x4 y = acc[ai][bj][m][n] * (g * (1.0f / (W8_SCALE * A8_SCALE)));
                            *(GAS unsigned*)((unsigned char*)tmp + (size_t)(v & 1) * (64 * MiB) + ro + bj * HALF + n * 16) = pack_fp8x4(y[0] * T8_SCALE, y[1] * T8_SCALE, y[2] * T8_SCALE, y[3] * T8_SCALE);
                        }
                }
            }
    }
};

struct EpiGateLazy {
    int mt, nt;
    __device__ __forceinline__ void launder() { mt = lauv(mt); nt = lauv(nt); }
    __device__ __forceinline__ void operator()(const AccT& acc, int wr, int wc, int fr, int fq) const {
        const KA a; unsigned char* ws = a.ws();
        EpiGate E{(bf16_t*)(ws + WS_PROJ + PJ_ACT), mt * 256, nt * 128};
        E(acc, wr, wc, fr, fq);
    }
};
struct EpiMoeOutLazy {
    int e, r0, nvalid, layer, nt;
    __device__ __forceinline__ void launder() { e = lauv(e); r0 = lauv(r0); nvalid = lauv(nvalid); layer = lauv(layer); nt = lauv(nt); }
    __device__ __forceinline__ void operator()(const AccT& acc, int wr, int wc, int fr, int fq) const {
        const KA a; unsigned char* ws = a.ws();
        EpiMoeOut E{(const int*)(ws + WS_IDX) + e * 32768 + r0, (const float*)(ws + WS_GT) + e * 32768 + r0, nvalid, (bf16_t*)(ws + WS_TMP1), (bf16_t*)(ws + WS_TMP),
                    (const float*)(ws + WS_MOD) + (size_t)(2 * layer + 1) * 16 * 6144 + 4096, nt * 256, layer};
        E(acc, wr, wc, fr, fq);
    }
};
__device__ __forceinline__ void moe_phase1(int wv, unsigned char* ws0, int layer, unsigned char* lds) {
    const int nmt = moe_build_table(wv, (const unsigned*)(ws0 + WS_CTL + CTL_CNT + layer * 4096), lds);
    for (int k = 0, u = unit_index(0); u < nmt * 8; u = unit_index(++k)) {
        const KA a; unsigned char* ws = a.ws();
        const LAS int* tab = (const LAS int*)(lds + LDS_MISC + MOE_TAB_OFF);
        const int mt = u >> 3, nt = u & 7;
        const int e = __builtin_amdgcn_readfirstlane(tab[4 + mt * 4 + 0]), r0 = __builtin_amdgcn_readfirstlane(tab[4 + mt * 4 + 1]), cnt_e = __builtin_amdgcn_readfirstlane(tab[4 + mt * 4 + 2]);
        RowGather ro{(const int*)(ws + WS_IDX) + e * 32768 + r0, cnt_e - r0};
        EpiGateLazy E{mt, nt};
        gemm_unit<true>(wv, (bf16_t*)lds, (const bf16_t*)(ws + WS_H), ro, (const bf16_t*)(ws + WS_W13 + ((size_t)(layer * 16 + e) * 2048 + (size_t)nt * 256) * ND), ND / 2, ND / 2, E);
    }
}
__device__ __forceinline__ void moe_phase2(int wv, unsigned char* ws0, int layer, unsigned char* lds) {
    const int nmt = moe_build_table(wv, (const unsigned*)(ws0 + WS_CTL + CTL_CNT + layer * 4096), lds);
    for (int k = 0, u = unit_index(0); u < nmt * 8; u = unit_index(++k)) {
        const KA a; unsigned char* ws = a.ws();
        const LAS int* tab = (const LAS int*)(lds + LDS_MISC + MOE_TAB_OFF);
        const int mt = u >> 3, nt = u & 7;
        const int e = __builtin_amdgcn_readfirstlane(tab[4 + mt * 4 + 0]), r0 = __builtin_amdgcn_readfirstlane(tab[4 + mt * 4 + 1]), cnt_e = __builtin_amdgcn_readfirstlane(tab[4 + mt * 4 + 2]);
        RowPlain ro{(unsigned)(mt * 256) * (DEXP / 2), (unsigned)(DEXP / 2)};
        EpiMoeOutLazy E{e, r0, cnt_e - r0, layer, nt};
        gemm_unit<true>(wv, (bf16_t*)lds, (const bf16_t*)(ws + WS_PROJ + PJ_ACT), ro, (const bf16_t*)(ws + WS_W2 + ((size_t)(layer * 16 + e) * 2048 + (size_t)nt * 256) * DEXP), DEXP / 2, DEXP / 2, E);
    }
}

constexpr float Q8_SCALE = 8.0f;
struct EpiIn1 {
    unsigned char* proj; int pm, pn; float sc;
    __device__ __forceinline__ void launder() { proj = lauv(proj); pm = lauv(pm); pn = lauv(pn); }
    __device__ __forceinline__ void operator()(const AccT& acc, int wr, int wc, int fr, int fq) const {
        const int row0 = pm * BM + wr * 64 + fr;
        if (pn < 8 || (pn >= 9 && pn < 13)) {
            const bool isq = pn < 8;
            bf16_t* O = (bf16_t*)(proj + (isq ? PJ_Q1 : PJ_QI)); const int ld = isq ? 2048 : 1024, cb = (isq ? pn : pn - 9) * 256;
#pragma unroll
            for (int ai = 0; ai < 2; ++ai)
#pragma unroll
                for (int m = 0; m < 4; ++m) { bf16_t* rp = O + (size_t)(row0 + ai * HALF + m * 16) * ld + cb + wc * 32 + fq * 4;
                    unsigned char* rp8 = (unsigned char*)O + (size_t)(row0 + ai * HALF + m * 16) * 2048 + cb + wc * 32 + fq * 4;
#pragma unroll
                    for (int bj = 0; bj < 2; ++bj)
#pragma unroll
                        for (int n = 0; n < 2; ++n) {
                            if (isq) { const f32x4 v = acc[ai][bj][m][n] * (sc * Q8_SCALE); *(GAS unsigned*)(rp8 + bj * HALF + n * 16) = pack_fp8x4(v[0], v[1], v[2], v[3]); }
                            else st_bf16x4(rp + bj * HALF + n * 16, acc[ai][bj][m][n] * sc);
                        } }
        } else if (pn == 8) {
            bf16_t* KR = (bf16_t*)(proj + PJ_KR); bf16_t* VT = (bf16_t*)(proj + PJ_VT1);
#pragma unroll
            for (int ai = 0; ai < 2; ++ai)
#pragma unroll
                for (int m = 0; m < 4; ++m) {
                    const int t = row0 + ai * HALF + m * 16, pos = t & (NS - 1), bb = t >> 11;
#pragma unroll
                    for (int n = 0; n < 2; ++n) {
                        st_bf16x4(KR + (size_t)t * 128 + wc * 32 + n * 16 + fq * 4, acc[ai][0][m][n] * sc);
                        st_bf16x4(VT + (size_t)t * 128 + wc * 32 + n * 16 + fq * 4, acc[ai][1][m][n] * sc);
                    }
                }
        } else {
            bf16_t* KI = (bf16_t*)(proj + PJ_KI); float* WI = (float*)(proj + PJ_WI);
#pragma unroll
            for (int ai = 0; ai < 2; ++ai)
#pragma unroll
                for (int m = 0; m < 4; ++m) {
                    const int t = row0 + ai * HALF + m * 16;
                    if (wc < 2) {
#pragma unroll
                        for (int n = 0; n < 2; ++n) st_bf16x4(KI + (size_t)t * 64 + wc * 32 + n * 16 + fq * 4, acc[ai][0][m][n] * sc);
                    } else if (wc == 2) {
                        *(GAS f32x4*)(WI + (size_t)t * 16 + fq * 4) = acc[ai][0][m][0] * sc;
                    }
                }
        }
    }
};

constexpr float ATT_KS = 16.0f, ATT_QS = 64.0f;
__device__ __forceinline__ void knorm_phase(int wv, const unsigned char* proj, const float* __restrict__ k_norm, bf16_t* __restrict__ Kn) {
    const int tid = tid_fresh(wv), lane = tid & 63;
    const bf16_t* KR = (const bf16_t*)(proj + PJ_KR);
    const int sub = tid & 15;
    float kw[8];
#pragma unroll
    for (int i = 0; i < 8; ++i) kw[i] = k_norm[sub * 8 + i];
    for (int t = (blockIdx.x * NT + tid) >> 4; t < NTOK; t += (gridDim.x * NT) >> 4) {
        const u32x4 v = *(const u32x4*)(KR + (size_t)t * 128 + sub * 8);
        float f[8] = {bflo(v.x), bfhi(v.x), bflo(v.y), bfhi(v.y), bflo(v.z), bfhi(v.z), bflo(v.w), bfhi(v.w)};
        float ss = 0.f;
#pragma unroll
        for (int i = 0; i < 8; ++i) ss += f[i] * f[i];
        ss += shx(ss, 1, lane); ss += shx(ss, 2, lane); ss += shx(ss, 4, lane); ss += shx(ss, 8, lane);
        const float rs = rsqrtf(ss * (1.0f / 128.0f) + RMS_EPS);
        u32x2 o; o.x = pack_fp8x4(f[0] * rs * kw[0] * ATT_KS, f[1] * rs * kw[1] * ATT_KS, f[2] * rs * kw[2] * ATT_KS, f[3] * rs * kw[3] * ATT_KS);
        o.y = pack_fp8x4(f[4] * rs * kw[4] * ATT_KS, f[5] * rs * kw[5] * ATT_KS, f[6] * rs * kw[6] * ATT_KS, f[7] * rs * kw[7] * ATT_KS);
        *(u32x2*)((unsigned char*)Kn + (size_t)t * 128 + sub * 8) = o;
    }
}

__device__ __forceinline__ unsigned f2sort(float f) { const unsigned u = __float_as_uint(f); return (u & 0x80000000u) ? ~u : (u | 0x80000000u); }
constexpr int IDX_SC_BYTES = 8 * 2 * 2048 * 4;
constexpr int IDX_KT_BYTES = 64 * 144;
#define WRLANE2(word, lo, hi, lane_idx) asm("s_nop 1\n\tv_writelane_b32 %0, %1, " #lane_idx "\n\tv_writelane_b32 %0, %2, " #lane_idx "+1" : "+v"(word) : "s"(lo), "s"(hi))
typedef short s16x2_t __attribute__((ext_vector_type(2)));
__device__ __forceinline__ unsigned relu_bf16x2(unsigned v) { const s16x2_t z = {0, 0}; return __builtin_bit_cast(unsigned, __builtin_elementwise_max(__builtin_bit_cast(s16x2_t, v), z)); }
__device__ __forceinline__ void indexer_phase(int wv, const unsigned char* proj, unsigned* __restrict__ MASK, unsigned char* lds) {
    const int tid = tid_fresh(wv), lane = tid & 63, fr = lane & 15, fq = lane >> 4;
    const bf16_t* QI = (const bf16_t*)(proj + PJ_QI); const bf16_t* KI = (const bf16_t*)(proj + PJ_KI); const float* WI = (const float*)(proj + PJ_WI);
    float* scl = (float*)lds + (size_t)wv * 2 * 2048;
    unsigned char* ktl = lds + IDX_SC_BYTES;
    const int nunits = NB * 128;
    for (int uu = blockIdx.x; uu < nunits; uu += gridDim.x) {
        int b, q16;
        if (gridDim.x == 256) { b = blockIdx.x >> 4; const int r = blockIdx.x & 15, k = (uu - blockIdx.x) / 256; q16 = (k & 1) ? (k >> 1) * 32 + 31 - r : (k >> 1) * 32 + r; }
        else { b = uu >> 7; q16 = uu & 127; }
        const int p0 = q16 * 16, pw = p0 + 2 * wv;
        const size_t t0 = (size_t)b * NS + pw;
        bf16x8 qa[2][2], wa;
#pragma unroll
        for (int tk = 0; tk < 2; ++tk)
#pragma unroll
            for (int ks = 0; ks < 2; ++ks) qa[tk][ks] = *(const bf16x8*)(QI + (t0 + tk) * 1024 + fr * 64 + ks * 32 + fq * 8);
        {
            const f32x4 w0 = *(const f32x4*)(WI + (t0 + 0) * 16 + fq * 4), w1 = *(const f32x4*)(WI + (t0 + 1) * 16 + fq * 4);
            u32x4 wp = (u32x4){0u, 0u, 0u, 0u};
            if (fr == 0) { wp.x = cvt_pk_bf16(w0[0], w0[1]); wp.y = cvt_pk_bf16(w0[2], w0[3]); }
            if (fr == 1) { wp.z = cvt_pk_bf16(w1[0], w1[1]); wp.w = cvt_pk_bf16(w1[2], w1[3]); }
            wa = __builtin_bit_cast(bf16x8, wp);
        }
        const int nkt = (p0 >> 6) + 1;
        const int krow = tid >> 3, kch = tid & 7;
        const bf16_t* kgp = KI + ((size_t)b * NS + krow) * 64 + kch * 8;
        const int klast = nkt - 1;
#define IDX_LD(x) (*(const u32x4*)(kgp + (size_t)((x) < klast ? (x) : klast) * (64 * 64)))
        u32x4 kr0 = IDX_LD(0), kr1 = IDX_LD(1), kr2 = IDX_LD(2), kr3 = IDX_LD(3);
        __syncthreads();
        *(u32x4*)(ktl + krow * 144 + kch * 16) = kr0;
        kr0 = IDX_LD(4);
        __syncthreads();
#define IDX_SB __builtin_amdgcn_sched_barrier(0);
#define IDX_TILE(KT, KRN) { \
            const int kt_ = (KT); \
            const unsigned char* kc = ktl + (kt_ & 1) * IDX_KT_BYTES; \
            bf16x8 kf[4][2]; \
            _Pragma("unroll") \
            for (int st = 0; st < 4; ++st) { kf[st][0] = *(const bf16x8*)(kc + (st * 16 + fr) * 144 + fq * 16); kf[st][1] = *(const bf16x8*)(kc + (st * 16 + fr) * 144 + 64 + fq * 16); } \
            f32x4 dd[4][2]; \
            IDX_SB \
            _Pragma("unroll") \
            for (int st = 0; st < 4; ++st) { \
                _Pragma("unroll") \
                for (int tk = 0; tk < 2; ++tk) dd[st][tk] = __builtin_amdgcn_mfma_f32_16x16x32_bf16(qa[tk][0], kf[st][0], (f32x4){0.f, 0.f, 0.f, 0.f}, 0, 0, 0); } \
            IDX_SB \
            _Pragma("unroll") \
            for (int st = 0; st < 4; ++st) { \
                _Pragma("unroll") \
                for (int tk = 0; tk < 2; ++tk) dd[st][tk] = __builtin_amdgcn_mfma_f32_16x16x32_bf16(qa[tk][1], kf[st][1], dd[st][tk], 0, 0, 0); } \
            IDX_SB \
            u32x4 rb[4]; \
            _Pragma("unroll") \
            for (int st = 0; st < 4; ++st) { \
                rb[st].x = relu_bf16x2(cvt_pk_bf16(dd[st][0][0], dd[st][0][1])); rb[st].y = relu_bf16x2(cvt_pk_bf16(dd[st][0][2], dd[st][0][3])); \
                rb[st].z = relu_bf16x2(cvt_pk_bf16(dd[st][1][0], dd[st][1][1])); rb[st].w = relu_bf16x2(cvt_pk_bf16(dd[st][1][2], dd[st][1][3])); } \
            IDX_SB \
            f32x4 sc[4]; \
            _Pragma("unroll") \
            for (int st = 0; st < 4; ++st) sc[st] = __builtin_amdgcn_mfma_f32_16x16x32_bf16(wa, __builtin_bit_cast(bf16x8, rb[st]), (f32x4){0.f, 0.f, 0.f, 0.f}, 0, 0, 0); \
            IDX_SB \
            if (kt_ == klast) { \
                _Pragma("unroll") \
                for (int st = 0; st < 4; ++st) { \
                    const int s = kt_ * 64 + st * 16 + fr; \
                    float v0 = sc[st][0], v1 = sc[st][1]; \
                    if (s > pw) v0 = -__builtin_inff(); \
                    if (s > pw + 1) v1 = -__builtin_inff(); \
                    if (fq == 0) { scl[s] = v0; scl[2048 + s] = v1; } \
                } \
            } else { \
                _Pragma("unroll") \
                for (int st = 0; st < 4; ++st) if (fq == 0) { scl[kt_ * 64 + st * 16 + fr] = sc[st][0]; scl[2048 + kt_ * 64 + st * 16 + fr] = sc[st][1]; } \
            } \
            if (kt_ + 1 < nkt) *(u32x4*)(ktl + ((kt_ + 1) & 1) * IDX_KT_BYTES + krow * 144 + kch * 16) = KRN; \
            KRN = IDX_LD(kt_ + 5); \
            __syncthreads(); }
        for (int kt = 0; kt < nkt; kt += 4) {
            IDX_TILE(kt, kr1)
            if (kt + 1 >= nkt) break;
            IDX_TILE(kt + 1, kr2)
            if (kt + 2 >= nkt) break;
            IDX_TILE(kt + 2, kr3)
            if (kt + 3 >= nkt) break;
            IDX_TILE(kt + 3, kr0)
        }
#undef IDX_TILE
#undef IDX_LD
        const int kbmax = klast;
#pragma unroll
        for (int tk = 0; tk < 2; ++tk) {
            const int p = pw + tk;
            unsigned u[32];
#pragma unroll
            for (int kb = 0; kb < 32; ++kb) u[kb] = (kb <= kbmax) ? f2sort(scl[tk * 2048 + kb * 64 + lane]) : 0u;
            unsigned thr = 0x00800000u;
            if (p + 1 > 256) {
                unsigned t = 0u;
                for (int bit = 31; bit >= 0; --bit) {
                    const unsigned cand = t | (1u << bit);
                    int n = 0;
#pragma unroll
                    for (int g8 = 0; g8 < 4; ++g8) {
                        if (g8 * 8 <= kbmax) {
#pragma unroll
                            for (int h4 = 0; h4 < 2; ++h4) {
                                unsigned long long m[4];
#pragma unroll
                                for (int kk = 0; kk < 4; ++kk) m[kk] = __ballot(u[g8 * 8 + h4 * 4 + kk] >= cand);
                                IDX_SB
#pragma unroll
                                for (int kk = 0; kk < 4; ++kk) n += __builtin_popcountll(m[kk]);
                                IDX_SB
                            }
                        }
                    }
                    if (n >= 256) t = cand;
                    if (n == 256) break;
                }
                thr = t;
            }
            int word = 0;
#define IDX_W(kb) { const unsigned long long bm = __ballot(u[kb] >= thr); const int lo_ = (int)(unsigned)bm, hi_ = (int)(unsigned)(bm >> 32); WRLANE2(word, lo_, hi_, (kb) * 2); }
            IDX_W(0) IDX_W(1) IDX_W(2) IDX_W(3) IDX_W(4) IDX_W(5) IDX_W(6) IDX_W(7) IDX_W(8) IDX_W(9) IDX_W(10) IDX_W(11) IDX_W(12) IDX_W(13) IDX_W(14) IDX_W(15)
            IDX_W(16) IDX_W(17) IDX_W(18) IDX_W(19) IDX_W(20) IDX_W(21) IDX_W(22) IDX_W(23) IDX_W(24) IDX_W(25) IDX_W(26) IDX_W(27) IDX_W(28) IDX_W(29) IDX_W(30) IDX_W(31)
#undef IDX_W
            MASK[(t0 + tk) * 64 + lane] = (unsigned)word;
        }
#undef IDX_SB
    }
    __syncthreads();
}

__device__ __forceinline__ void attn_phase(int wv, const unsigned char* proj, const unsigned* __restrict__ MASK, const float* __restrict__ q_norm, const float* __restrict__ k_norm, const float* __restrict__ rel_bias,
                           bf16_t* __restrict__ AO, unsigned char* lds) {
    const int tid = tid_fresh(wv), lane = tid & 63, w = wv  , fr = lane & 15, fq = lane >> 4;
    int vz = 0; asm volatile("" : "+v"(vz));
    const bf16_t* Q1 = (const bf16_t*)(proj + PJ_Q1); const bf16_t* Kn = (const bf16_t*)(proj + PJ_KN); const bf16_t* VT = (const bf16_t*)(proj + PJ_VT1);
    constexpr int ATT_BUF = 17408 + 18432;
    bf16_t* K_lds = (bf16_t*)lds;
    bf16_t* V_lds = (bf16_t*)(lds + 17408);
    float* bt = (float*)(lds + 2 * ATT_BUF);
    const float LOG2E = 1.4426950408889634f;
    float mq = 0.f, mk = 0.f;
    for (int i = 0; i < 128; ++i) { mq = fmaxf(mq, fabsf(q_norm[i])); mk = fmaxf(mk, fabsf(k_norm[i])); }
    const float Mb2 = 11.313708499f * mq * mk * LOG2E;
    __syncthreads();
    for (int i = tid; i < 128 * 16; i += NT) {
        const int d = i >> 4, h = i & 15;
        int bk = d;
        if (d >= 16) { bk = 16 + (int)(logf((float)d / 16.0f) / 2.0794415416798357f * 16.0f); bk = bk > 31 ? 31 : bk; }
        bt[i] = (rel_bias[bk * 16 + h] - rel_bias[31 * 16 + h]) * LOG2E;
    }
    __syncthreads();
    const int nunits = NB * 128;
    for (int uu = blockIdx.x; uu < nunits; uu += gridDim.x) {
        int b, q16;
        if (gridDim.x == 256) { b = blockIdx.x >> 4; const int r = blockIdx.x & 15, k = (uu - blockIdx.x) / 256; q16 = (k & 1) ? (k >> 1) * 32 + 31 - r : (k >> 1) * 32 + r; }
        else { b = uu >> 7; q16 = uu & 127; }
        const int p0 = q16 * 16;
        const size_t tb = (size_t)b * NS;
        v8i qf[2];
#pragma unroll
        for (int tk = 0; tk < 2; ++tk) {
            const size_t t = tb + p0 + 2 * w + tk;
            float f[32]; float ss = 0.f;
#pragma unroll
            for (int i = 0; i < 2; ++i) {
                const u32x4 v = *(const u32x4*)((const unsigned char*)Q1 + t * 2048 + fr * 128 + fq * 32 + i * 16);
                const int wds[4] = {(int)v.x, (int)v.y, (int)v.z, (int)v.w};
#pragma unroll
                for (int q4 = 0; q4 < 4; ++q4) {
                    f[i * 16 + q4 * 4 + 0] = __builtin_amdgcn_cvt_f32_fp8(wds[q4], 0); f[i * 16 + q4 * 4 + 1] = __builtin_amdgcn_cvt_f32_fp8(wds[q4], 1);
                    f[i * 16 + q4 * 4 + 2] = __builtin_amdgcn_cvt_f32_fp8(wds[q4], 2); f[i * 16 + q4 * 4 + 3] = __builtin_amdgcn_cvt_f32_fp8(wds[q4], 3);
                }
            }
#pragma unroll
            for (int i = 0; i < 32; ++i) ss += f[i] * f[i];
            ss += shx(ss, 16, lane); ss += shx(ss, 32, lane);
            const float rs = rsqrtf(ss * (1.0f / (128.0f * Q8_SCALE * Q8_SCALE)) + RMS_EPS) * (0.08838834764831845f * LOG2E * ATT_QS / Q8_SCALE);
            const float* qn = q_norm + fq * 32;
#pragma unroll
            for (int i = 0; i < 8; ++i) qf[tk][i] = (int)pack_fp8x4(f[i * 4 + 0] * rs * qn[i * 4 + 0], f[i * 4 + 1] * rs * qn[i * 4 + 1], f[i * 4 + 2] * rs * qn[i * 4 + 2], f[i * 4 + 3] * rs * qn[i * 4 + 3]);
        }
        f32x4 oacc[2][8];
#pragma unroll
        for (int tk = 0; tk < 2; ++tk)
#pragma unroll
            for (int dt = 0; dt < 8; ++dt) oacc[tk][dt] = (f32x4){0.f, 0.f, 0.f, 0.f};
        float lsum[2] = {0.f, 0.f};
        const int nkt = (p0 >> 6) + 1;
        const int kr0 = tid >> 3, kc0 = tid & 7, vr0 = tid >> 4, vc0 = tid & 15;
        const unsigned char* kgp = (const unsigned char*)Kn + (tb + kr0) * 128 + kc0 * 16;
        const bf16_t* vgp = VT + (tb + vr0) * 128 + vc0 * 8;
        const unsigned* mp0 = MASK + (tb + p0 + 2 * w) * 64 + vz;
        u32x4 kreg, vreg[2]; unsigned mreg[2][2];
        kreg = *(const u32x4*)(kgp);
        vreg[0] = *(const u32x4*)(vgp); vreg[1] = *(const u32x4*)(vgp + 32 * 128);
        mreg[0][0] = mp0[0]; mreg[0][1] = mp0[1]; mreg[1][0] = mp0[64]; mreg[1][1] = mp0[65];
        __syncthreads();
        *(u32x4*)((unsigned char*)K_lds + kr0 * 144 + kc0 * 16) = kreg;
        *(u32x4*)(V_lds + vr0 * 144 + vc0 * 8) = vreg[0]; *(u32x4*)(V_lds + (vr0 + 32) * 144 + vc0 * 8) = vreg[1];
        __syncthreads();
        for (int kt = 0; kt < nkt; ++kt) {
            const int s0 = kt * 64;
            const bf16_t* Kc = K_lds + (kt & 1) * (ATT_BUF / 2); const bf16_t* Vc = V_lds + (kt & 1) * (ATT_BUF / 2);
            const unsigned m00 = mreg[0][0], m01 = mreg[0][1], m10 = mreg[1][0], m11 = mreg[1][1];
            if (kt + 1 < nkt) {
                kreg = *(const u32x4*)(kgp + (size_t)(s0 + 64) * 128);
                vreg[0] = *(const u32x4*)(vgp + (size_t)(s0 + 64) * 128); vreg[1] = *(const u32x4*)(vgp + (size_t)(s0 + 64 + 32) * 128);
                mreg[0][0] = mp0[2 * kt + 2]; mreg[0][1] = mp0[2 * kt + 3]; mreg[1][0] = mp0[64 + 2 * kt + 2]; mreg[1][1] = mp0[64 + 2 * kt + 3];
            }
            const bool use_bias = (s0 + 63 + 128 > p0);
            f32x4 dA[2], dB[2]; unsigned pk[4][2][2];
            auto s_sub = [&](int sub, f32x4 (&d)[2]) {
                const unsigned char* kp = (const unsigned char*)Kc + (sub * 16 + fr) * 144 + fq * 32;
                const i32x4 klo = *(const i32x4*)kp, khi = *(const i32x4*)(kp + 16);
                const v8i kf = __builtin_shufflevector(klo, khi, 0, 1, 2, 3, 4, 5, 6, 7);
#pragma unroll
                for (int tk = 0; tk < 2; ++tk) {
                    d[tk] = (f32x4){-Mb2 * (ATT_QS * ATT_KS), -Mb2 * (ATT_QS * ATT_KS), -Mb2 * (ATT_QS * ATT_KS), -Mb2 * (ATT_QS * ATT_KS)};
                    d[tk] = __builtin_amdgcn_mfma_scale_f32_16x16x128_f8f6f4(kf, qf[tk], d[tk], 0, 0, 0, 0, 0, 0);
                }
            };
            auto soft = [&](int sub, const f32x4 (&d)[2]) {
#pragma unroll
                for (int tk = 0; tk < 2; ++tk) {
                    const int p = p0 + 2 * w + tk;
                    const unsigned mw = (sub < 2) ? (tk ? m10 : m00) : (tk ? m11 : m01);
                    const unsigned nib = (mw >> ((sub & 1) * 16 + fq * 4)) & 15u;
                    float pv[4];
                    f32x4 xx = d[tk] * (1.0f / (ATT_QS * ATT_KS));
                    if (use_bias) {
#pragma unroll
                        for (int j = 0; j < 4; ++j) { const int dd = p - (s0 + sub * 16 + fq * 4 + j); if (dd >= 0 && dd < 128) xx[j] += bt[dd * 16 + fr]; }
                    }
#pragma unroll
                    for (int j = 0; j < 4; ++j) {
                        const float x = xx[j];
                        float e = __builtin_amdgcn_exp2f(x);
                        e = ((nib >> j) & 1u) ? e : 0.f;
                        lsum[tk] += e; pv[j] = e;
                    }
                    pk[sub][tk][0] = cvt_pk_bf16(pv[0], pv[1]); pk[sub][tk][1] = cvt_pk_bf16(pv[2], pv[3]);
                }
            };
            auto pv_pair = [&](int kk) {
                bf16x8 pfr[2];
#pragma unroll
                for (int tk = 0; tk < 2; ++tk) { u32x4 a0; a0.x = pk[2 * kk][tk][0]; a0.y = pk[2 * kk][tk][1]; a0.z = pk[2 * kk + 1][tk][0]; a0.w = pk[2 * kk + 1][tk][1]; pfr[tk] = __builtin_bit_cast(bf16x8, a0); }
#pragma unroll
                for (int dt = 0; dt < 8; ++dt) {
                    const bf16_t* vp = Vc + ((2 * kk) * 16 + fq * 4 + (fr >> 2)) * 144 + dt * 16 + (fr & 3) * 4;
                    const s16x4_t va = __builtin_amdgcn_ds_read_tr16_b64_v4i16((__attribute__((address_space(3))) s16x4_t*)(vp));
                    const s16x4_t vb = __builtin_amdgcn_ds_read_tr16_b64_v4i16((__attribute__((address_space(3))) s16x4_t*)(vp + 16 * 144));
                    const bf16x8 vf = __builtin_bit_cast(bf16x8, __builtin_shufflevector(va, vb, 0, 1, 2, 3, 4, 5, 6, 7));
#pragma unroll
                    for (int tk = 0; tk < 2; ++tk) oacc[tk][dt] = __builtin_amdgcn_mfma_f32_16x16x32_bf16(vf, pfr[tk], oacc[tk][dt], 0, 0, 0);
                }
            };
            s_sub(0, dA);
            __builtin_amdgcn_sched_barrier(0);
            s_sub(1, dB); soft(0, dA);
            __builtin_amdgcn_sched_barrier(0);
            s_sub(2, dA); soft(1, dB); pv_pair(0);
            __builtin_amdgcn_sched_barrier(0);
            s_sub(3, dB); soft(2, dA);
            __builtin_amdgcn_sched_barrier(0);
            soft(3, dB); pv_pair(1);
            __builtin_amdgcn_sched_barrier(0);
            if (kt + 1 < nkt) {
                bf16_t* Kn_ = K_lds + ((kt + 1) & 1) * (ATT_BUF / 2); bf16_t* Vn_ = V_lds + ((kt + 1) & 1) * (ATT_BUF / 2);
                *(u32x4*)((unsigned char*)Kn_ + kr0 * 144 + kc0 * 16) = kreg;
                *(u32x4*)(Vn_ + vr0 * 144 + vc0 * 8) = vreg[0]; *(u32x4*)(Vn_ + (vr0 + 32) * 144 + vc0 * 8) = vreg[1];
            }
            __syncthreads();
        }
#pragma unroll
        for (int tk = 0; tk < 2; ++tk) {
            float l = lsum[tk];
            l += shx(l, 16, lane); l += shx(l, 32, lane);
            const float il = 1.0f / l;
            const size_t ob = (tb + p0 + 2 * w + tk) * 2048 + fr * 128 + fq * 4;
#pragma unroll
            for (int dt = 0; dt < 8; ++dt) {
                const f32x4 o = oacc[tk][dt] * il;
                if (F8_L1) *(unsigned*)((unsigned char*)AO + ob + dt * 16) = pack_fp8x4(o[0] * Y8_SCALE, o[1] * Y8_SCALE, o[2] * Y8_SCALE, o[3] * Y8_SCALE);
                else st_bf16x4(AO + ob + dt * 16, o);
            }
        }
    }
    __syncthreads();
}

#ifndef DUPMASK
#define DUPMASK 0
#endif
#define REPS(k) (((DUPMASK >> (k)) & 1) ? 2 : 1)

__device__ __forceinline__ unsigned char* opq(unsigned char* p) { asm volatile("" : "+s"(p)); return p; }

__global__ void __launch_bounds__(NT, 2) fwd(Args a_unused) {
    extern __shared__ __attribute__((aligned(16))) unsigned char lds[];
    volatile LAS unsigned* misc = (volatile LAS unsigned*)(lds + LDS_MISC);
    const int wv = __builtin_amdgcn_readfirstlane((int)(threadIdx.x >> 6));
    { const int t0 = tid_fresh(wv); if (t0 < 4) misc[t0] = 0u; }
    __syncthreads();
    XcdBarrier bar = xcd_barrier_post((unsigned*)(KA().ws() + WS_CTL), misc, wv);
    const int G = gridDim.x, bx = blockIdx.x;

    for (int rep = 0; rep < REPS(0); ++rep) { p0_prologue(wv, lds); xcd_barrier(bar); }

    for (int rep = 0; rep < REPS(1); ++rep) {
        const KA a; unsigned char* ws = a.ws();
        norm_phase<false, false, F8_P2, false, F8_P2_MIX>(wv, a.in(I_X), nullptr, a.in(I_NORM_MIX), (const float*)(ws + WS_MOD) + 0 * 16 * 6144, (bf16_t*)(ws + WS_H), lds, nullptr, nullptr, nullptr, nullptr, nullptr);
        xcd_barrier(bar);
    }
    for (int rep = 0; rep < REPS(2); ++rep) {
        const KA a; unsigned char* ws = a.ws();
        const int nM = NTOK / BM, nN = N_IN0 / BM;
        for (int k = 0, u = unit_index(0); u < nM * nN; u = unit_index(++k)) {
            int pm, pn; dense_tile(u, nN, pm, pn);
            RowPlain ro{(unsigned)(pm * BM) * ND, (unsigned)ND};
            const bool t8 = F8_P2 || (((unsigned)F8_P2_TILES >> pn) & 1u) != 0u;
            EpiIn0 E{ws + WS_PROJ, (const float2*)(ws + WS_ROT), pm, pn, (LAS bf16_t*)lds, wv, t8 ? 1.0f / W8_SCALE : 1.0f};
            if (t8) { RowPlain r8{(unsigned)(pm * BM) * (ND / 2), (unsigned)(ND / 2)};
                      gemm_unit<true>(wv, (bf16_t*)lds, (const bf16_t*)(F8_P2 ? ws + WS_H : ws + WS_H8), r8, (const bf16_t*)(ws + WS_WIN0F8 + (size_t)pn * BM * ND), ND / 2, ND / 2, E); }
            else gemm_unit<false>(wv, (bf16_t*)lds, (const bf16_t*)(ws + WS_H), ro, (const bf16_t*)(ws + WS_WIN0) + (size_t)pn * BM * ND, ND, ND, E);
        }
        xcd_barrier(bar);
    }
    for (int rep = 0; rep < REPS(3); ++rep) { const KA a; unsigned char* ws = a.ws(); retention_phase(wv, ws + WS_PROJ, (bf16_t*)(ws + WS_O), lds); xcd_barrier(bar); }
    for (int rep = 0; rep < REPS(4); ++rep) { const KA a; unsigned char* ws = a.ws(); ycat_phase(wv, ws + WS_PROJ, (const bf16_t*)(ws + WS_O), a.in(I_CONVW), a.in(I_CONVB), (bf16_t*)(ws + WS_H)); xcd_barrier(bar); }
    for (int rep = 0; rep < REPS(5); ++rep) {
        const KA a; unsigned char* ws = a.ws();
        const int nM = NTOK / BM, nN = ND / BM;
        for (int k = 0, u = unit_index(0); u < nM * nN; u = unit_index(++k)) {
            int pm, pn; dense_tile(u, nN, pm, pn);
            RowPlain ro{(unsigned)(pm * BM) * ND, (unsigned)ND};
            EpiRes<false, true> E{a.in(I_X), nullptr, (bf16_t*)(ws + WS_XB), (const float*)(ws + WS_MOD) + 0 * 16 * 6144 + 4096, pm, pn, F8_P5 ? 1.0f / (W8_SCALE * Y8_SCALE) : 1.0f};
            if (F8_P5) { RowPlain r8{(unsigned)(pm * BM) * (ND / 2), (unsigned)(ND / 2)}; gemm_unit<true>(wv, (bf16_t*)lds, (const bf16_t*)(ws + WS_H), r8, (const bf16_t*)(ws + WS_WOUT0 + (size_t)pn * BM * ND), ND / 2, ND / 2, E); }
            else gemm_unit<false>(wv, (bf16_t*)lds, (const bf16_t*)(ws + WS_H), ro, (const bf16_t*)(ws + WS_WOUT0) + (size_t)pn * BM * ND, ND, ND, E);
        }
        xcd_barrier(bar);
    }
    {
        const KA a; unsigned char* ws = a.ws();
        route_phase(wv, (const bf16_t*)(ws + WS_XB), a.in(I_NORM_FFN), (const float*)(ws + WS_MOD) + 1 * 16 * 6144, ws + WS_H, lds, a.in(I_WR), a.in(I_BR), (unsigned*)(ws + WS_CTL + CTL_CNT + 0 * 4096), (int*)(ws + WS_IDX), (float*)(ws + WS_GT));
        xcd_barrier(bar);
    }
    for (int rep = 0; rep < REPS(7); ++rep) { moe_phase1(wv, KA().ws(), 0, lds); xcd_barrier(bar); }
    { moe_phase2(wv, KA().ws(), 0, lds); xcd_barrier(bar); }

    for (int rep = 0; rep < REPS(9); ++rep) {
        const KA a; unsigned char* ws = a.ws();
        norm_phase<true, false, F8_L1 != 0, true, false, true>(wv, ws + WS_XB, (const bf16_t*)(ws + WS_TMP), a.in(I_NORM_MIX) + ND, (const float*)(ws + WS_MOD) + 2 * 16 * 6144, (bf16_t*)(ws + WS_H), lds, nullptr, nullptr, nullptr, nullptr, nullptr, (const bf16_t*)(ws + WS_TMP + 64 * MiB), (const float*)(ws + WS_MOD) + 1 * 16 * 6144 + 4096);
        xcd_barrier(bar);
    }
    for (int rep = 0; rep < REPS(10); ++rep) {
        const int nM = NTOK / BM, nN = N_IN1P / BM;
        for (int k = 0, u = unit_index(0); u < nM * nN; u = unit_index(++k)) {
            const KA a; unsigned char* ws = a.ws();
            int pm, pn; dense_tile(u, nN, pm, pn);
            RowPlain ro{(unsigned)(pm * BM) * ND, (unsigned)ND};
            EpiIn1 E{ws + WS_PROJ, pm, pn, F8_L1 ? 1.0f / W8_SCALE : 1.0f};
            if (F8_L1) { RowPlain r8{(unsigned)(pm * BM) * (ND / 2), (unsigned)(ND / 2)}; gemm_unit<true>(wv, (bf16_t*)lds, (const bf16_t*)(ws + WS_H), r8, (const bf16_t*)(ws + WS_WIN1 + (size_t)pn * BM * ND), ND / 2, ND / 2, E); }
            else gemm_unit<false>(wv, (bf16_t*)lds, (const bf16_t*)(ws + WS_H), ro, (const bf16_t*)(ws + WS_WIN1) + (size_t)pn * BM * ND, ND, ND, E);
        }
        xcd_barrier(bar);
    }
    for (int rep = 0; rep < REPS(11); ++rep) {
        const KA a; unsigned char* ws = a.ws();
        knorm_phase(wv, ws + WS_PROJ, a.in(I_KN), (bf16_t*)(ws + WS_PROJ + PJ_KN));
        indexer_phase(wv, ws + WS_PROJ, (unsigned*)(ws + WS_MASK), lds);
        xcd_barrier(bar);
    }
    for (int rep = 0; rep < REPS(12); ++rep) { const KA a; unsigned char* ws = a.ws(); attn_phase(wv, ws + WS_PROJ, (const unsigned*)(ws + WS_MASK), a.in(I_QN), a.in(I_KN), a.in(I_RELB), (bf16_t*)(ws + WS_H), lds); xcd_barrier(bar); }
    {
        const KA a; unsigned char* ws = a.ws();
        const int nM = NTOK / BM, nN = ND / BM;
        for (int k = 0, u = unit_index(0); u < nM * nN; u = unit_index(++k)) {
            int pm, pn; dense_tile(u, nN, pm, pn);
            RowPlain ro{(unsigned)(pm * BM) * ND, (unsigned)ND};
            EpiRes<false, false> E{ws + WS_XB, nullptr, (bf16_t*)(ws + WS_XB), (const float*)(ws + WS_MOD) + 2 * 16 * 6144 + 4096, pm, pn, F8_L1 ? 1.0f / (W8_SCALE * Y8_SCALE) : 1.0f};
            if (F8_L1) { RowPlain r8{(unsigned)(pm * BM) * (ND / 2), (unsigned)(ND / 2)}; gemm_unit<true>(wv, (bf16_t*)lds, (const bf16_t*)(ws + WS_H), r8, (const bf16_t*)(ws + WS_WOUT1 + (size_t)pn * BM * ND), ND / 2, ND / 2, E); }
            else gemm_unit<false>(wv, (bf16_t*)lds, (const bf16_t*)(ws + WS_H), ro, (const bf16_t*)(ws + WS_WOUT1) + (size_t)pn * BM * ND, ND, ND, E);
        }
        xcd_barrier(bar);
    }
    {
        const KA a; unsigned char* ws = a.ws();
        route_phase(wv, (const bf16_t*)(ws + WS_XB), a.in(I_NORM_FFN) + ND, (const float*)(ws + WS_MOD) + 3 * 16 * 6144, ws + WS_H, lds, a.in(I_WR), a.in(I_BR), (unsigned*)(ws + WS_CTL + CTL_CNT + 1 * 4096), (int*)(ws + WS_IDX), (float*)(ws + WS_GT));
        xcd_barrier(bar);
    }
    { moe_phase1(wv, KA().ws(), 1, lds); xcd_barrier(bar); }
    { moe_phase2(wv, KA().ws(), 1, lds); xcd_barrier(bar); }
    {
        const KA a; unsigned char* ws = a.ws();
        const bf16_t* tp = (const bf16_t*)(ws + WS_TMP); const bf16_t* xp = (const bf16_t*)(ws + WS_XB); f32x4* op = (f32x4*)a.out();
        const unsigned char* tp8 = (const unsigned char*)tp;
        for (size_t i = (size_t)bx * NT + tid_fresh(wv); i < (size_t)NTOK * ND / 8; i += (size_t)G * NT) {
            const u32x4 xv = *(const u32x4*)(xp + i * 8); const u32x2 tv = *(const u32x2*)(tp8 + i * 8), tw = *(const u32x2*)(tp8 + 64 * MiB + i * 8);
            const float* gp = (const float*)(ws + WS_MOD) + 3 * 16 * 6144 + 4096 + (size_t)((i * 8) >> 22) * 6144 + ((i * 8) & 2047);
            const f32x4 g0 = *(const f32x4*)gp * (1.0f / T8_SCALE), g1 = *(const f32x4*)(gp + 4) * (1.0f / T8_SCALE);
            f32x4 a0, a1;
            a0[0] = bflo(xv.x) + (__builtin_amdgcn_cvt_f32_fp8((int)tv.x, 0) + __builtin_amdgcn_cvt_f32_fp8((int)tw.x, 0)) * g0[0]; a0[1] = bfhi(xv.x) + (__builtin_amdgcn_cvt_f32_fp8((int)tv.x, 1) + __builtin_amdgcn_cvt_f32_fp8((int)tw.x, 1)) * g0[1];
            a0[2] = bflo(xv.y) + (__builtin_amdgcn_cvt_f32_fp8((int)tv.x, 2) + __builtin_amdgcn_cvt_f32_fp8((int)tw.x, 2)) * g0[2]; a0[3] = bfhi(xv.y) + (__builtin_amdgcn_cvt_f32_fp8((int)tv.x, 3) + __builtin_amdgcn_cvt_f32_fp8((int)tw.x, 3)) * g0[3];
            a1[0] = bflo(xv.z) + (__builtin_amdgcn_cvt_f32_fp8((int)tv.y, 0) + __builtin_amdgcn_cvt_f32_fp8((int)tw.y, 0)) * g1[0]; a1[1] = bfhi(xv.z) + (__builtin_amdgcn_cvt_f32_fp8((int)tv.y, 1) + __builtin_amdgcn_cvt_f32_fp8((int)tw.y, 1)) * g1[1];
            a1[2] = bflo(xv.w) + (__builtin_amdgcn_cvt_f32_fp8((int)tv.y, 2) + __builtin_amdgcn_cvt_f32_fp8((int)tw.y, 2)) * g1[2]; a1[3] = bfhi(xv.w) + (__builtin_amdgcn_cvt_f32_fp8((int)tv.y, 3) + __builtin_amdgcn_cvt_f32_fp8((int)tw.y, 3)) * g1[3];
            op[i * 2] = a0; op[i * 2 + 1] = a1;
        }
    }
}

extern "C" void kernel_launch(void* const* d_in, const int* in_sizes, int n_in, void* d_out, int out_size, void* d_ws, size_t ws_size, hipStream_t stream) {
    static int grid = 0;
    if (grid == 0) {
        int dev = 0, cus = 0, per_cu = 0;
        if (n_in != 22 || ws_size < WS_END) { fprintf(stderr, "kernel_launch: unexpected n_in %d / ws_size %zu (need %zu)\n", n_in, ws_size, (size_t)WS_END); grid = -1; return; }
        (void)hipGetDevice(&dev);
        (void)hipDeviceGetAttribute(&cus, hipDeviceAttributeMultiprocessorCount, dev);
        if (hipFuncSetAttribute((const void*)fwd, hipFuncAttributeMaxDynamicSharedMemorySize, LDS_BYTES) != hipSuccess) { fprintf(stderr, "kernel_launch: hipFuncSetAttribute failed\n"); grid = -1; return; }
        (void)hipOccupancyMaxActiveBlocksPerMultiprocessor(&per_cu, (const void*)fwd, NT, LDS_BYTES);
        (void)hipGetLastError();
        if (per_cu < 1) fprintf(stderr, "kernel_launch: occupancy query reports %d\n", per_cu);
        grid = cus;
    }
    if (grid < 0) return;
    (void)hipMemsetAsync((char*)d_ws + WS_CTL, 0, 65536 + 4 * 16 * 6144 * 4, stream);
    Args a{};
    for (int i = 0; i < 22; ++i) a.in[i] = (const float*)d_in[i];
    a.out = (float*)d_out; a.ws = (unsigned char*)d_ws;
    hipLaunchKernelGGL(fwd, dim3(grid), dim3(NT), LDS_BYTES, stream, a);
}
```

```cpp
#include <hip/hip_runtime.h>
#include <stdint.h>
#include <stdio.h>

#define XB_TMO      128
#define XB_XCNT(j)  (256  + 64 * (j))
#define XB_XSUB(j)  (1280 + 64 * (j))
#define XB_XGEN(j)  (2304 + 64 * (j))
#define XB_TOP      3328
#define XB_TOPGEN   3392
#define XCD_BAR_WORDS 3456
#define XB_SPIN_CAP (1u << 18)
#define LAS __attribute__((address_space(3)))
#define GAS __attribute__((address_space(1)))

__device__ __forceinline__ unsigned xb_ld(unsigned* p)              { return __hip_atomic_load(p, __ATOMIC_RELAXED, __HIP_MEMORY_SCOPE_AGENT); }
__device__ __forceinline__ unsigned xb_add(unsigned* p, unsigned v) { return __hip_atomic_fetch_add(p, v, __ATOMIC_RELAXED, __HIP_MEMORY_SCOPE_AGENT); }
__device__ __forceinline__ unsigned xb_xcc_id() { return (unsigned)__builtin_amdgcn_s_getreg((3 << 11) | 20) & 0xFu; }
#define XB_SPIN(cond, bar) do { unsigned _sp = 0; while (cond) { __builtin_amdgcn_s_sleep(1); \
    if ((++_sp & 255u) == 0u) { if (xb_ld(&(bar)[XB_TMO])) break; if (_sp > XB_SPIN_CAP) { atomicAdd(&(bar)[XB_TMO], 1u); break; } } } } while (0)

struct XcdBarrier { unsigned* bar; unsigned x; volatile LAS unsigned* st; int wv; };
__device__ __forceinline__ bool xb_thread0(int wv) { int l; asm volatile("v_mbcnt_lo_u32_b32 %0, -1, 0\n\tv_mbcnt_hi_u32_b32 %0, -1, %0" : "=v"(l)); return wv == 0 && l == 0; }

__device__ __forceinline__ XcdBarrier xcd_barrier_post(unsigned* bar, volatile LAS unsigned* st, int wv) {
    XcdBarrier b; b.bar = bar; b.x = xb_xcc_id(); b.st = st; b.wv = wv;
    if (xb_thread0(wv)) (void)xb_add(&bar[XB_XCNT(b.x)], 1u);
    return b;
}
__device__ __forceinline__ void xcd_barrier_complete(unsigned* bar, unsigned x, unsigned& nloc, unsigned& nx) {
    const unsigned G = gridDim.x * gridDim.y * gridDim.z;
    unsigned sum, cnt, mine, sp = 0u;
    for (;;) {
        sum = 0u; cnt = 0u; mine = 0u;
#pragma unroll
        for (unsigned j = 0; j < 16; ++j) { const unsigned c = xb_ld(&bar[XB_XCNT(j)]); sum += c; cnt += (c > 0u) ? 1u : 0u; mine = (j == x) ? c : mine; }
        if (sum == G) break;
        __builtin_amdgcn_s_sleep(1);
        if ((++sp & 255u) == 0u) { if (xb_ld(&bar[XB_TMO])) break; if (sp > XB_SPIN_CAP) { atomicAdd(&bar[XB_TMO], 1u); break; } }
    }
    nloc = mine > 0u ? mine : 1u; nx = cnt > 0u ? cnt : 1u;
}
__device__ __forceinline__ void xcd_barrier(const XcdBarrier& b) {
    asm volatile("s_waitcnt vmcnt(0)" ::: "memory");
    __syncthreads();
    if (xb_thread0(b.wv)) {
        unsigned* bar = b.bar; asm volatile("" : "+s"(bar));
        __builtin_amdgcn_s_waitcnt(0);
        unsigned nloc = b.st[0], nx = b.st[1];
        if (nloc == 0u) { xcd_barrier_complete(bar, b.x, nloc, nx); b.st[0] = nloc; b.st[1] = nx; }
        const unsigned old = xb_add(&bar[XB_XSUB(b.x)], 1u);
        const unsigned gen = old / nloc;
        if (old + 1u == (gen + 1u) * nloc) {
            __builtin_amdgcn_fence(__ATOMIC_RELEASE, "agent");
            asm volatile("s_waitcnt vmcnt(0)" ::: "memory");
            const unsigned og = xb_add(&bar[XB_TOP], 1u);
            const unsigned tg = og / nx;
            if (og + 1u == (tg + 1u) * nx) xb_add(&bar[XB_TOPGEN], 1u);
            else XB_SPIN(xb_ld(&bar[XB_TOPGEN]) == tg, bar);
            __builtin_amdgcn_fence(__ATOMIC_ACQUIRE, "agent");
            xb_add(&bar[XB_XGEN(b.x)], 1u);
            asm volatile("s_waitcnt vmcnt(0)" ::: "memory");
        } else {
            XB_SPIN(xb_ld(&bar[XB_XGEN(b.x)]) == gen, bar);
            __builtin_amdgcn_fence(__ATOMIC_ACQUIRE, "agent");
            asm volatile("s_waitcnt vmcnt(0)" ::: "memory");
        }
    }
    __syncthreads();
}

typedef unsigned short bf16_t;
typedef short bf16x8 __attribute__((ext_vector_type(8)));
typedef float f32x4 __attribute__((ext_vector_type(4)));
typedef unsigned u32x4 __attribute__((ext_vector_type(4)));
typedef unsigned u32x2 __attribute__((ext_vector_type(2)));

constexpr int NT = 512;
constexpr int NB = 16, NS = 2048, ND = 2048, NTOK = NB * NS;
constexpr int NE = 16, DEXP = 1024;
constexpr int N_IN0 = 7168, N_IN1 = 3408, N_IN1P = 3584;
constexpr float RMS_EPS = 1e-6f;
constexpr int LDS_MISC = 131072 + 2 * 64 * 144;
constexpr int LDS_BYTES = LDS_MISC + 8192;

constexpr size_t MiB = 1024ull * 1024ull;
constexpr size_t WS_CTL   = 0;
constexpr size_t CTL_CNT  = 16384;
constexpr size_t WS_MOD   = 64 * 1024;
constexpr size_t WS_ROT   = WS_MOD + 4ull * 16 * 6144 * 4;
constexpr size_t WS_IDX   = WS_ROT + 2048ull * 128 * 8;
constexpr size_t WS_GT    = WS_IDX + 16ull * 32768 * 4;
constexpr size_t WS_MASK  = WS_GT + 16ull * 32768 * 4;
constexpr size_t WS_WIN0  = 16 * MiB;
constexpr size_t WS_WOUT0 = WS_WIN0 + 28 * MiB;
constexpr size_t WS_WIN1  = WS_WOUT0 + 8 * MiB;
constexpr size_t WS_WOUT1 = WS_WIN1 + 14 * MiB;
constexpr size_t WS_W13   = WS_WOUT1 + 8 * MiB;
constexpr size_t WS_XB    = WS_W13 + 128 * MiB;
constexpr size_t WS_W2    = WS_W13 + 256 * MiB;
constexpr size_t WS_H     = WS_W2 + 128 * MiB;
constexpr size_t WS_O     = WS_H + 128 * MiB;
constexpr size_t WS_TMP   = WS_O + 64 * MiB;
constexpr size_t WS_PROJ  = WS_TMP + 128 * MiB;
constexpr size_t WS_END   = WS_PROJ + 448 * MiB;
constexpr size_t WS_TMP1  = WS_PROJ + 128 * MiB;
constexpr size_t WS_SSP   = WS_PROJ + 440 * MiB;
constexpr size_t WS_H8    = WS_O;
constexpr size_t WS_WIN0F8 = WS_W2 + 64 * MiB;
constexpr size_t PJ_AB = 0, PJ_U = 64 * MiB, PJ_Q = 128 * MiB, PJ_K = 192 * MiB, PJ_KT = 256 * MiB, PJ_VT = 320 * MiB, PJ_SG = 384 * MiB;
constexpr size_t PJ_Q1 = 0, PJ_QI = 128 * MiB, PJ_KR = 192 * MiB, PJ_VT1 = 200 * MiB, PJ_KI = 208 * MiB, PJ_WI = 212 * MiB, PJ_KN = 216 * MiB;
constexpr size_t PJ_ACT = 0;

struct Args { const float* in[22]; float* out; unsigned char* ws; };
#define CAS __attribute__((address_space(4)))
struct KA {
    const CAS unsigned char* kp;
    __device__ __forceinline__ KA() { kp = (const CAS unsigned char*)__builtin_amdgcn_kernarg_segment_ptr(); asm volatile("" : "+s"(kp)); }
    __device__ __forceinline__ const float* in(int i) const { return *(const float* const CAS*)(kp + 8 * i); }
    __device__ __forceinline__ float* out() const { return *(float* const CAS*)(kp + 8 * 22); }
    __device__ __forceinline__ unsigned char* ws() const { return *(unsigned char* const CAS*)(kp + 8 * 23); }
};
enum { I_X = 0, I_C, I_RELB, I_WR, I_BR, I_NORM_MIX, I_ADAW_MIX, I_ADAB_MIX, I_NORM_FFN, I_ADAW_FFN, I_ADAB_FFN, I_AB_WIN, I_CONVW, I_CONVB, I_AB_WOUT,
       I_C_WIN, I_QN, I_KN, I_C_WOUT, I_W1, I_W3, I_W2 };

typedef __bf16 bf16x2_t __attribute__((ext_vector_type(2)));
__device__ __forceinline__ unsigned cvt_pk_bf16(float lo, float hi) { bf16x2_t v = {(__bf16)lo, (__bf16)hi}; return __builtin_bit_cast(unsigned, v); }
__device__ __forceinline__ float bflo(unsigned u) { return __uint_as_float(u << 16); }
__device__ __forceinline__ float bfhi(unsigned u) { return __uint_as_float(u & 0xffff0000u); }
__device__ __forceinline__ f32x4 ld_bf16x4(const bf16_t* p) { const u32x2 t = *(const GAS u32x2*)p; return (f32x4){bflo(t.x), bfhi(t.x), bflo(t.y), bfhi(t.y)}; }
__device__ __forceinline__ float bf2f(bf16_t h) { return __uint_as_float((unsigned)h << 16); }
__device__ __forceinline__ bf16_t f2bf(float f) { return (bf16_t)(cvt_pk_bf16(f, 0.f) & 0xffffu); }
__device__ __forceinline__ float silu_f(float v) { return v * __builtin_amdgcn_rcpf(1.f + __builtin_amdgcn_exp2f(-1.4426950408889634f * v)); }
__device__ __forceinline__ int tid_fresh(int wv) {
    int l; asm volatile("v_mbcnt_lo_u32_b32 %0, -1, 0\n\tv_mbcnt_hi_u32_b32 %0, -1, %0" : "=v"(l));
    return wv * 64 + l;
}
__device__ __forceinline__ float shx(float v, int o, int lane) { return __int_as_float(__builtin_amdgcn_ds_bpermute((lane ^ o) << 2, __float_as_int(v))); }
__device__ __forceinline__ float shi(float v, int src) { return __int_as_float(__builtin_amdgcn_ds_bpermute(src << 2, __float_as_int(v))); }
__device__ __forceinline__ float wave_sum(float v, int lane) {
#pragma unroll
    for (int o = 32; o >= 1; o >>= 1) v += shx(v, o, lane);
    return v;
}

#ifndef F8_L1
#define F8_L1 1
#endif
#ifndef F8_P2_TILES
#define F8_P2_TILES 0xFFFFFFFu
#endif
#define F8_P2 ((F8_P2_TILES) == 0xFFFFFFFu)
#define F8_P2_MIX ((F8_P2_TILES) != 0u && (F8_P2_TILES) != 0xFFFFFFFu)

#ifndef F8_P5
#define F8_P5 0
#endif
constexpr float Y8_SCALE = 4.0f;
constexpr float W8_SCALE = 64.0f, A8_SCALE = 8.0f;
__device__ __forceinline__ float clamp8(float v) { return fminf(fmaxf(v, -448.0f), 448.0f); }
__device__ __forceinline__ unsigned pack_fp8x4(float a, float b, float c, float d) { int w; asm volatile("" : "=v"(w));     w = __builtin_amdgcn_cvt_pk_fp8_f32(clamp8(a), clamp8(b), w, false); w = __builtin_amdgcn_cvt_pk_fp8_f32(clamp8(c), clamp8(d), w, true); return (unsigned)w; }
template <bool FP8OUT>
__device__ __forceinline__ void tr_tile(int wv, const float* __restrict__ src, int ldn, int N, int k0, int n0, float* tile, bf16_t* dstbase, int ldk, int rowmap_kind) {
    const int tid = tid_fresh(wv);
#pragma unroll
    for (int it = 0; it < 2; ++it) {
        const int i = tid + it * NT, k = i >> 4, q = i & 15, n = n0 + q * 4;
        float4 v = make_float4(0.f, 0.f, 0.f, 0.f);
        if (n < N) v = *(const float4*)(src + (size_t)(k0 + k) * ldn + n);
        float* tp = tile + k * 65 + q * 4;
        tp[0] = v.x; tp[1] = v.y; tp[2] = v.z; tp[3] = v.w;
    }
    __syncthreads();
    {
        const int nl = tid >> 3, kc = tid & 7, n = n0 + nl;
        if (n < N) {
            float f[8];
#pragma unroll
            for (int j = 0; j < 8; ++j) f[j] = tile[(kc * 8 + j) * 65 + nl];
            int row = n;
            if (rowmap_kind == 1) {
                const int s = n >> 10, c = n & 1023;
                if (s == 1) row = 1024 + (c >> 7) * 256 + (c & 127);
                else if (s == 2) row = 1024 + (c >> 7) * 256 + 128 + (c & 127);
            } else if (rowmap_kind == 2) {
                row = (n >> 7) * 256 + (n & 127);
            } else if (rowmap_kind == 3) {
                row = (n >> 7) * 256 + 128 + (n & 127);
            }
            if (FP8OUT) {
                u32x2 o; o.x = pack_fp8x4(f[0] * W8_SCALE, f[1] * W8_SCALE, f[2] * W8_SCALE, f[3] * W8_SCALE); o.y = pack_fp8x4(f[4] * W8_SCALE, f[5] * W8_SCALE, f[6] * W8_SCALE, f[7] * W8_SCALE);
                *(u32x2*)((unsigned char*)dstbase + (size_t)row * ldk + k0 + kc * 8) = o;
            } else {
                u32x4 o; o.x = cvt_pk_bf16(f[0], f[1]); o.y = cvt_pk_bf16(f[2], f[3]); o.z = cvt_pk_bf16(f[4], f[5]); o.w = cvt_pk_bf16(f[6], f[7]);
                *(u32x4*)(dstbase + (size_t)row * ldk + k0 + kc * 8) = o;
            }
        }
    }
    __syncthreads();
}

__device__ __forceinline__ void p0_prologue(int wv, unsigned char* lds) {
    const int tid = tid_fresh(wv), G = gridDim.x, bx = blockIdx.x;
    const KA a; unsigned char* ws = a.ws();
    {
        float2* rot = (float2*)(ws + WS_ROT);
        for (int i = bx * NT + tid; i < 2048 * 128; i += G * NT) {
            const int pos = i >> 7, j = i & 127;
            const float inv = 1.0f / powf(10000.0f, (float)j / 127.0f);
            const float ang = (float)pos * inv;
            float s, c; sincosf(ang, &s, &c);
            rot[i] = make_float2(c, s);
        }
    }
    {
        constexpr int esz = F8_L1 ? 1 : 2;
        u32x4* z = (u32x4*)(ws + WS_WIN1 + (size_t)N_IN1 * 2048 * esz);
        const int n16 = (N_IN1P - N_IN1) * 2048 * esz / 16;
        for (int i = bx * NT + tid; i < n16; i += G * NT) z[i] = (u32x4){0u, 0u, 0u, 0u};
    }
    {
        float* sc = (float*)lds;
        float* red = (float*)(lds + 65536);
        float* mod = (float*)(ws + WS_MOD);
        const int lane = tid & 63, wave = tid >> 6;
        const int q = lane & 15, kg = (lane >> 4) + wave * 4;
        int cur_half = -1;
        for (int item = bx; item < 2 * 4 * 96; item += G) {
            const int half = item / (4 * 96), it2 = item % (4 * 96);
            const int w = it2 / 96, col0 = (it2 % 96) * 64;
            const float* adaw = (w & 1) ? a.in(I_ADAW_FFN) : a.in(I_ADAW_MIX);
            const float* adab = (w & 1) ? a.in(I_ADAB_FFN) : a.in(I_ADAB_MIX);
            const int layer = w >> 1;
            adaw += (size_t)layer * 2048 * 6144; adab += (size_t)layer * 6144;
            if (half != cur_half) {
                __syncthreads();
                for (int i = tid; i < 1024 * 16; i += NT) { const int k = i >> 4, b = i & 15; sc[i] = silu_f(a.in(I_C)[b * 2048 + half * 1024 + k]); }
                cur_half = half;
                __syncthreads();
            }
            float acc[16][4];
#pragma unroll
            for (int b = 0; b < 16; ++b) { acc[b][0] = 0.f; acc[b][1] = 0.f; acc[b][2] = 0.f; acc[b][3] = 0.f; }
            const float* wp = adaw + (size_t)(half * 1024 + kg * 32) * 6144 + col0 + q * 4;
            for (int kk0 = 0; kk0 < 32; kk0 += 4) {
                float4 wv8[4];
#pragma unroll
                for (int j = 0; j < 4; ++j) wv8[j] = *(const float4*)(wp + (size_t)(kk0 + j) * 6144);
#pragma unroll
                for (int j = 0; j < 4; ++j) {
                    const float4* sp = (const float4*)(sc + (kg * 32 + kk0 + j) * 16);
#pragma unroll
                    for (int b4 = 0; b4 < 4; ++b4) {
                        const float4 s4 = sp[b4];
                        const float sv[4] = {s4.x, s4.y, s4.z, s4.w};
#pragma unroll
                        for (int bb = 0; bb < 4; ++bb) {
                            acc[b4 * 4 + bb][0] += sv[bb] * wv8[j].x; acc[b4 * 4 + bb][1] += sv[bb] * wv8[j].y;
                            acc[b4 * 4 + bb][2] += sv[bb] * wv8[j].z; acc[b4 * 4 + bb][3] += sv[bb] * wv8[j].w;
                        }
                    }
                }
            }
#pragma unroll
            for (int b = 0; b < 16; ++b)
#pragma unroll
                for (int j = 0; j < 4; ++j) { float v = acc[b][j]; v += shx(v, 16, lane); v += shx(v, 32, lane); acc[b][j] = v; }
            __syncthreads();
            if (lane < 16) {
#pragma unroll
                for (int b = 0; b < 16; ++b) *(float4*)(red + (wave * 16 + b) * 64 + q * 4) = make_float4(acc[b][0], acc[b][1], acc[b][2], acc[b][3]);
            }
            __syncthreads();
            for (int i = tid; i < 1024; i += NT) {
                const int b = i >> 6, cidx = i & 63;
                float sm = (half == 0) ? adab[col0 + cidx] : 0.f;
#pragma unroll
                for (int wvi = 0; wvi < 8; ++wvi) sm += red[(wvi * 16 + b) * 64 + cidx];
                atomicAdd(mod + ((size_t)w * 16 + b) * 6144 + col0 + cidx, sm);
            }
        }
        __syncthreads();
    }
    {
        constexpr int T0 = 16 * 56, T1 = T0 + 256, T2 = T1 + 16 * 27, T3 = T2 + 256, T4 = T3 + 4096, T5 = T4 + 4096, T6 = T5 + 4096;
        struct TD { const float* src; unsigned char* dst; int ldn, N, k0, n0, ldk, kind, f8; };
        auto decode = [&](int t) {
            TD d;
            if (t < T0) { const int kt = t / 56, nt = t % 56;
                const int n = nt * 128, sct = n >> 10, c = n & 1023; const int row = (sct == 0) ? c : (sct == 1) ? 1024 + (c >> 7) * 256 + (c & 127) : (sct == 2) ? 1024 + (c >> 7) * 256 + 128 + (c & 127) : n;
                const int f8 = (int)(((unsigned)F8_P2_TILES >> (row >> 8)) & 1u);
                d = TD{a.in(I_AB_WIN), f8 ? ws + WS_WIN0F8 : ws + WS_WIN0, 7168, 7168, kt * 128, nt * 128, 2048, 1, f8}; }
            else if (t < T1) { const int u = t - T0, kt = u / 16, nt = u % 16; d = TD{a.in(I_AB_WOUT), ws + WS_WOUT0, 2048, 2048, kt * 128, nt * 128, 2048, 0, F8_P5}; }
            else if (t < T2) { const int u = t - T1, kt = u / 27, nt = u % 27; d = TD{a.in(I_C_WIN), ws + WS_WIN1, N_IN1, N_IN1, kt * 128, nt * 128, 2048, 0, F8_L1}; }
            else if (t < T3) { const int u = t - T2, kt = u / 16, nt = u % 16; d = TD{a.in(I_C_WOUT), ws + WS_WOUT1, 2048, 2048, kt * 128, nt * 128, 2048, 0, F8_L1}; }
            else if (t < T5) { const bool is3 = t >= T4; const int u = t - (is3 ? T4 : T3), mat = u / 128, v = u % 128, kt = v / 8, nt = v % 8;
                d = TD{(is3 ? a.in(I_W3) : a.in(I_W1)) + (size_t)mat * 2048 * 1024, ws + WS_W13 + (size_t)mat * 2048 * 2048, 1024, 1024, kt * 128, nt * 128, 2048, is3 ? 3 : 2, 1}; }
            else { const int u = t - T5, mat = u / 128, v = u % 128, kt = v / 16, nt = v % 16;
                d = TD{a.in(I_W2) + (size_t)mat * 1024 * 2048, ws + WS_W2 + (size_t)mat * 2048 * 1024, 2048, 2048, kt * 128, nt * 128, 1024, 0, 1}; }
            return d;
        };
        auto load8 = [&](const TD& d, float4 (&v)[8]) {
#pragma unroll
            for (int it = 0; it < 8; ++it) {
                const int i = tid + it * NT, k = i >> 5, q = i & 31, n = d.n0 + q * 4;
                v[it] = (n < d.N) ? *(const float4*)(d.src + (size_t)(d.k0 + k) * d.ldn + n) : make_float4(0.f, 0.f, 0.f, 0.f);
            }
        };
        float4 cur[8], nx1[8], nx2[8];
        int t = bx, buf = 0;
        TD d = decode(t < T6 ? t : 0), d1 = decode(t + G < T6 ? t + G : 0);
        if (t < T6) load8(d, cur);
        if (t + G < T6) load8(d1, nx1);
        __syncthreads();
        for (; t < T6; t += G) {
            float* tile = (float*)lds + buf * (128 * 129);
#pragma unroll
            for (int it = 0; it < 8; ++it) {
                const int i = tid + it * NT, k = i >> 5, q = i & 31;
                float* tp = tile + k * 129 + q * 4;
                tp[0] = cur[it].x; tp[1] = cur[it].y; tp[2] = cur[it].z; tp[3] = cur[it].w;
            }
            const TD d2 = decode(t + 2 * G < T6 ? t + 2 * G : t);
            if (t + 2 * G < T6) load8(d2, nx2);
            __syncthreads();
#pragma unroll
            for (int rep = 0; rep < 2; ++rep) {
                const int item = tid + rep * NT, nl = item >> 3, kc = item & 7, n = d.n0 + nl;
                if (n < d.N) {
                    float f[16];
#pragma unroll
                    for (int j = 0; j < 16; ++j) f[j] = tile[(kc * 16 + j) * 129 + nl];
                    int row = n;
                    if (d.kind == 1) { const int sct = n >> 10, c = n & 1023; if (sct == 1) row = 1024 + (c >> 7) * 256 + (c & 127); else if (sct == 2) row = 1024 + (c >> 7) * 256 + 128 + (c & 127); }
                    else if (d.kind == 2) row = (n >> 7) * 256 + (n & 127);
                    else if (d.kind == 3) row = (n >> 7) * 256 + 128 + (n & 127);
                    if (d.f8) {
                        u32x4 o;
                        o.x = pack_fp8x4(f[0] * W8_SCALE, f[1] * W8_SCALE, f[2] * W8_SCALE, f[3] * W8_SCALE); o.y = pack_fp8x4(f[4] * W8_SCALE, f[5] * W8_SCALE, f[6] * W8_SCALE, f[7] * W8_SCALE);
                        o.z = pack_fp8x4(f[8] * W8_SCALE, f[9] * W8_SCALE, f[10] * W8_SCALE, f[11] * W8_SCALE); o.w = pack_fp8x4(f[12] * W8_SCALE, f[13] * W8_SCALE, f[14] * W8_SCALE, f[15] * W8_SCALE);
                        *(u32x4*)(d.dst + (size_t)row * d.ldk + d.k0 + kc * 16) = o;
                    } else {
                        u32x4 o0, o1;
                        o0.x = cvt_pk_bf16(f[0], f[1]); o0.y = cvt_pk_bf16(f[2], f[3]); o0.z = cvt_pk_bf16(f[4], f[5]); o0.w = cvt_pk_bf16(f[6], f[7]);
                        o1.x = cvt_pk_bf16(f[8], f[9]); o1.y = cvt_pk_bf16(f[10], f[11]); o1.z = cvt_pk_bf16(f[12], f[13]); o1.w = cvt_pk_bf16(f[14], f[15]);
                        u32x4* op = (u32x4*)(d.dst + ((size_t)row * d.ldk + d.k0 + kc * 16) * 2);
                        op[0] = o0; op[1] = o1;
                    }
                }
            }
            d = d1; d1 = d2;
#pragma unroll
            for (int it = 0; it < 8; ++it) { cur[it] = nx1[it]; nx1[it] = nx2[it]; }
            buf ^= 1;
        }
        __syncthreads();
    }
}

template <bool ADD_TMP, bool ROUTE, bool OUT8, bool XBF, bool DUAL = false, bool WB = false>
__device__ __forceinline__ void norm_phase(int wv, const void* xsrc_, const bf16_t* __restrict__ tmp, const float* __restrict__ normw, const float* __restrict__ mod  ,
                           bf16_t* __restrict__ H, unsigned char* lds, const float* __restrict__ w_router, const float* __restrict__ b_router,
                           unsigned* __restrict__ cnt  , int* __restrict__ idx, float* __restrict__ gts, const bf16_t* __restrict__ tmp2 = nullptr, const float* __restrict__ gatev = nullptr  ) {
    const int tid = tid_fresh(wv), lane = tid & 63, wave = tid >> 6;
    float* wr_lds = (float*)lds;
    int* rt_e = (int*)(lds + 131072 + 64);
    (void)rt_e;
    if (ROUTE) {
        for (int i = tid; i < 2048 * 16; i += NT) { const int k = i >> 4, e = i & 15; wr_lds[e * 2048 + k] = w_router[i]; }
        __syncthreads();
    }
    float br[16];
    if (ROUTE) {
#pragma unroll
        for (int e = 0; e < 16; ++e) br[e] = b_router[e];
    }
    const int rows_per_block = NTOK / (int)gridDim.x;
    const int rows_per_wave = rows_per_block / 8;
    const int row0 = blockIdx.x * rows_per_block + wave * rows_per_wave;
    const int b = row0 / NS;
    float g[32], sh[32];
#pragma unroll
    for (int i = 0; i < 8; ++i) {
        const int c = i * 256 + lane * 4;
        const float4 nw = *(const float4*)(normw + c);
        const float4 s4 = *(const float4*)(mod + (size_t)b * 6144 + c);
        const float4 c4 = *(const float4*)(mod + (size_t)b * 6144 + 2048 + c);
        g[i * 4 + 0] = nw.x * (1.f + c4.x); g[i * 4 + 1] = nw.y * (1.f + c4.y); g[i * 4 + 2] = nw.z * (1.f + c4.z); g[i * 4 + 3] = nw.w * (1.f + c4.w);
        sh[i * 4 + 0] = s4.x; sh[i * 4 + 1] = s4.y; sh[i * 4 + 2] = s4.z; sh[i * 4 + 3] = s4.w;
    }
    float gt[32];
    if (WB) {
#pragma unroll
        for (int i = 0; i < 8; ++i) { const float4 g4 = *(const float4*)(gatev + (size_t)b * 6144 + i * 256 + lane * 4); gt[i * 4 + 0] = g4.x * (1.0f / 16.0f); gt[i * 4 + 1] = g4.y * (1.0f / 16.0f); gt[i * 4 + 2] = g4.z * (1.0f / 16.0f); gt[i * 4 + 3] = g4.w * (1.0f / 16.0f); }
    }
    for (int r = 0; r < rows_per_wave; ++r) {
        const int t = row0 + r;
        float v[32];
        float ss = 0.f;
#pragma unroll
        for (int i = 0; i < 8; ++i) {
            const int c = i * 256 + lane * 4;
            float4 x4;
            if (XBF) { const f32x4 xb = ld_bf16x4((const bf16_t*)xsrc_ + (size_t)t * ND + c); x4 = make_float4(xb[0], xb[1], xb[2], xb[3]); }
            else x4 = *(const float4*)((const float*)xsrc_ + (size_t)t * ND + c);
            if (ADD_TMP && !WB) {
                const u32x2 tv = *(const u32x2*)(tmp + (size_t)t * ND + c);
                x4.x += bflo(tv.x); x4.y += bfhi(tv.x); x4.z += bflo(tv.y); x4.w += bfhi(tv.y);
            }
            if (WB) {
                const int tv = *(const int*)((const unsigned char*)tmp + (size_t)t * ND + c), tw = *(const int*)((const unsigned char*)tmp2 + (size_t)t * ND + c);
                x4.x += (__builtin_amdgcn_cvt_f32_fp8(tv, 0) + __builtin_amdgcn_cvt_f32_fp8(tw, 0)) * gt[i * 4 + 0]; x4.y += (__builtin_amdgcn_cvt_f32_fp8(tv, 1) + __builtin_amdgcn_cvt_f32_fp8(tw, 1)) * gt[i * 4 + 1];
                x4.z += (__builtin_amdgcn_cvt_f32_fp8(tv, 2) + __builtin_amdgcn_cvt_f32_fp8(tw, 2)) * gt[i * 4 + 2]; x4.w += (__builtin_amdgcn_cvt_f32_fp8(tv, 3) + __builtin_amdgcn_cvt_f32_fp8(tw, 3)) * gt[i * 4 + 3];
                u32x2 o; o.x = cvt_pk_bf16(x4.x, x4.y); o.y = cvt_pk_bf16(x4.z, x4.w);
                *(u32x2*)((bf16_t*)xsrc_ + (size_t)t * ND + c) = o;
            }
            v[i * 4 + 0] = x4.x; v[i * 4 + 1] = x4.y; v[i * 4 + 2] = x4.z; v[i * 4 + 3] = x4.w;
            ss += x4.x * x4.x + x4.y * x4.y + x4.z * x4.z + x4.w * x4.w;
        }
        ss = wave_sum(ss, lane);
        const float rs = rsqrtf(ss * (1.0f / ND) + RMS_EPS);
#pragma unroll
        for (int i = 0; i < 32; ++i) v[i] = v[i] * rs * g[i] + sh[i];
#pragma unroll
        for (int i = 0; i < 8; ++i) {
            const int c = i * 256 + lane * 4;
            if (DUAL) *(unsigned*)((unsigned char*)H + (size_t)(WS_H8 - WS_H) + (size_t)t * ND + c) = pack_fp8x4(v[i * 4 + 0], v[i * 4 + 1], v[i * 4 + 2], v[i * 4 + 3]);
            if (OUT8) {
                *(unsigned*)((unsigned char*)H + (size_t)t * ND + c) = pack_fp8x4(v[i * 4 + 0], v[i * 4 + 1], v[i * 4 + 2], v[i * 4 + 3]);
            } else {
                u32x2 o; o.x = cvt_pk_bf16(v[i * 4 + 0], v[i * 4 + 1]); o.y = cvt_pk_bf16(v[i * 4 + 2], v[i * 4 + 3]);
                *(u32x2*)(H + (size_t)t * ND + c) = o;
            }
        }
        if (ROUTE) {
            float lg[16];
            int lo = lane * 4; asm volatile("" : "+v"(lo));
#pragma unroll
            for (int e = 0; e < 16; ++e) {
                float s = 0.f;
#pragma unroll
                for (int i = 0; i < 8; ++i) {
                    const float4 w4 = *(const float4*)(wr_lds + e * 2048 + i * 256 + lo);
                    s += v[i * 4 + 0] * w4.x + v[i * 4 + 1] * w4.y + v[i * 4 + 2] * w4.z + v[i * 4 + 3] * w4.w;
                }
                lg[e] = wave_sum(s, lane);
            }
            float mx = lg[0];
#pragma unroll
            for (int e = 1; e < 16; ++e) mx = fmaxf(mx, lg[e]);
            float p[16], sum = 0.f;
#pragma unroll
            for (int e = 0; e < 16; ++e) { p[e] = __expf(lg[e] - mx); sum += p[e]; }
            const float isum = 1.f / sum;
            float sel[16];
#pragma unroll
            for (int e = 0; e < 16; ++e) { p[e] *= isum; sel[e] = p[e] + br[e]; }
            int grp = 0; float best = -1e30f;
#pragma unroll
            for (int gI = 0; gI < 4; ++gI) {
                float m1 = -1e30f, m2 = -1e30f;
#pragma unroll
                for (int j = 0; j < 4; ++j) { const float s = sel[gI * 4 + j]; if (s > m1) { m2 = m1; m1 = s; } else if (s > m2) { m2 = s; } }
                const float gs = m1 + m2;
                if (gs > best) { best = gs; grp = gI; }
            }
            float s4[4], p4[4];
#pragma unroll
            for (int j = 0; j < 4; ++j) { s4[j] = 0.f; p4[j] = 0.f; }
#pragma unroll
            for (int gI = 0; gI < 4; ++gI)
#pragma unroll
                for (int j = 0; j < 4; ++j) if (grp == gI) { s4[j] = sel[gI * 4 + j]; p4[j] = p[gI * 4 + j]; }
            int i1 = 0; float v1 = s4[0];
#pragma unroll
            for (int j = 1; j < 4; ++j) if (s4[j] > v1) { v1 = s4[j]; i1 = j; }
            int i2 = -1; float v2 = -1e30f;
#pragma unroll
            for (int j = 0; j < 4; ++j) if (j != i1 && s4[j] > v2) { v2 = s4[j]; i2 = j; }
            float pa = 0.f, pb = 0.f;
#pragma unroll
            for (int j = 0; j < 4; ++j) { if (j == i1) pa = p4[j]; if (j == i2) pb = p4[j]; }
            const float inv = 1.f / (pa + pb);
            if (lane == 0) {
                const int e0 = grp * 4 + i1, e1 = grp * 4 + i2;
                const unsigned p0 = atomicAdd(cnt + e0 * 64, 1u);
                const unsigned p1 = atomicAdd(cnt + e1 * 64, 1u);
                idx[e0 * 32768 + p0] = t * 2 + 0; gts[e0 * 32768 + p0] = pa * inv;
                idx[e1 * 32768 + p1] = t * 2 + 1; gts[e1 * 32768 + p1] = pb * inv;
            }
        }
    }
    __syncthreads();
}

#define DPP_ADD(v, CTRL) ((v) + __int_as_float(__builtin_amdgcn_update_dpp(0, __float_as_int(v), (CTRL), 0xf, 0xf, false)))
#define DPP_GET(v, CTRL) __int_as_float(__builtin_amdgcn_update_dpp(0, __float_as_int(v), (CTRL), 0xf, 0xf, false))
__device__ __forceinline__ float swap32_sum(float a, float b) {
    const auto r = __builtin_amdgcn_permlane32_swap(__float_as_uint(a), __float_as_uint(b), false, false);
    return __uint_as_float(r[0]) + __uint_as_float(r[1]);
}
__device__ __forceinline__ float swap16_sum(float a, float b) {
    const auto r = __builtin_amdgcn_permlane16_swap(__float_as_uint(a), __float_as_uint(b), false, false);
    return __uint_as_float(r[0]) + __uint_as_float(r[1]);
}
__device__ __forceinline__ float bfly16(const float (&pl)[16], int lane) {
    float a8[8], a4[4], a2[2], a1;
#pragma unroll
    for (int i = 0; i < 8; ++i) a8[i] = swap32_sum(pl[i], pl[8 + i]);
#pragma unroll
    for (int i = 0; i < 4; ++i) a4[i] = swap16_sum(a8[i], a8[4 + i]);
    { const bool hi = (lane & 2) != 0;
#pragma unroll
      for (int i = 0; i < 2; ++i) { const float keep = hi ? a4[2 + i] : a4[i], send = hi ? a4[i] : a4[2 + i]; a2[i] = keep + DPP_GET(send, 0x4e  ); } }
    { const bool hi = (lane & 1) != 0; const float keep = hi ? a2[1] : a2[0], send = hi ? a2[0] : a2[1]; a1 = keep + DPP_GET(send, 0xb1  ); }
    return a1 + DPP_GET(a1, 0x124) + DPP_GET(a1, 0x128) + DPP_GET(a1, 0x12c);
}
__device__ __forceinline__ int bfly16_slot(int lane) { return ((lane >> 5) & 1) * 8 + ((lane >> 4) & 1) * 4 + (lane & 3); }
__device__ __forceinline__ float wave_total(float v) {
    v = swap32_sum(v, v); v = swap16_sum(v, v);
    v = v + DPP_GET(v, 0x124) + DPP_GET(v, 0x128) + DPP_GET(v, 0x12c);
    v = DPP_ADD(v, 0x4e); v = DPP_ADD(v, 0xb1);
    return v;
}
__device__ __forceinline__ void route_phase(int wv, const bf16_t* __restrict__ XB, const float* __restrict__ normw, const float* __restrict__ mod, unsigned char* __restrict__ H8, unsigned char* lds,
                                            const float* __restrict__ w_router, const float* __restrict__ b_router, unsigned* __restrict__ cnt, int* __restrict__ idx, float* __restrict__ gts, const float* __restrict__ ssp  ) {
    const int tid = tid_fresh(wv), lane = tid & 63, w = tid >> 6, fr = lane & 15, fq = lane >> 4;
    constexpr int RB = 128;
    constexpr int GWP = 2048 + 8;
    bf16_t* gwh = (bf16_t*)lds;
    bf16_t* gwl = gwh + 16 * GWP;
    float* part = (float*)(gwl + 16 * GWP);
    float* part_c = part + RB * 16;
    float* rs_lds = part_c + 128;
    unsigned* lcnt = (unsigned*)(rs_lds + RB);
    bf16_t* g_bf = (bf16_t*)(lcnt + 32);
    bf16_t* s_bf = g_bf + 2048;
    const int row0 = blockIdx.x * RB;
    const int b = row0 / NS;
    __syncthreads();
    {
        const int k0 = tid * 4;
        const float4 nw = *(const float4*)(normw + k0);
        const float4 s4 = *(const float4*)(mod + (size_t)b * 6144 + k0);
        const float4 c4 = *(const float4*)(mod + (size_t)b * 6144 + 2048 + k0);
        const float gk[4] = {nw.x * (1.f + c4.x), nw.y * (1.f + c4.y), nw.z * (1.f + c4.z), nw.w * (1.f + c4.w)};
        const float sk[4] = {s4.x, s4.y, s4.z, s4.w};
        float ce[16];
#pragma unroll
        for (int e = 0; e < 16; ++e) ce[e] = 0.f;
        float wk[4][16];
#pragma unroll
        for (int j = 0; j < 4; ++j)
#pragma unroll
            for (int e4 = 0; e4 < 4; ++e4) {
                const float4 wr = *(const float4*)(w_router + (size_t)(k0 + j) * 16 + e4 * 4);
                wk[j][e4 * 4 + 0] = wr.x; wk[j][e4 * 4 + 1] = wr.y; wk[j][e4 * 4 + 2] = wr.z; wk[j][e4 * 4 + 3] = wr.w;
            }
#pragma unroll
        for (int e = 0; e < 16; ++e) {
            float hi[4], lo[4];
#pragma unroll
            for (int j = 0; j < 4; ++j) { const float v = gk[j] * wk[j][e]; ce[e] += sk[j] * wk[j][e]; hi[j] = bf2f(f2bf(v)); lo[j] = v - hi[j]; }
            u32x2 oh, ol; oh.x = cvt_pk_bf16(hi[0], hi[1]); oh.y = cvt_pk_bf16(hi[2], hi[3]); ol.x = cvt_pk_bf16(lo[0], lo[1]); ol.y = cvt_pk_bf16(lo[2], lo[3]);
            *(u32x2*)(gwh + e * GWP + k0) = oh; *(u32x2*)(gwl + e * GWP + k0) = ol;
        }
        { u32x2 og, os; og.x = cvt_pk_bf16(gk[0], gk[1]); og.y = cvt_pk_bf16(gk[2], gk[3]); os.x = cvt_pk_bf16(sk[0], sk[1]); os.y = cvt_pk_bf16(sk[2], sk[3]);
          *(u32x2*)(g_bf + k0) = og; *(u32x2*)(s_bf + k0) = os; }
        const float ct = bfly16(ce, lane);
        if ((lane & 12) == 0) part_c[w * 16 + bfly16_slot(lane)] = ct;
        if (tid < 16) lcnt[tid] = 0u;
    }
    __syncthreads();
    {
        const int trow = row0 + w * 16 + fr;
        const bf16_t* xp = XB + (size_t)trow * ND + fq * 8;
        unsigned char* h8p = H8 + (size_t)trow * ND + fq * 8;
        const bf16_t* hp = gwh + fr * GWP + fq * 8;
        const bf16_t* lp = gwl + fr * GWP + fq * 8;
        float rsl;
        { const f32x4 s0 = *(const f32x4*)(ssp + (size_t)trow * 8), s1 = *(const f32x4*)(ssp + (size_t)trow * 8 + 4);
          rsl = rsqrtf((((s0[0] + s0[1]) + (s0[2] + s0[3])) + ((s1[0] + s1[1]) + (s1[2] + s1[3]))) * (1.0f / ND) + RMS_EPS); }
        f32x4 ah[2], al[2];
        ah[0] = ah[1] = al[0] = al[1] = (f32x4){0.f, 0.f, 0.f, 0.f};
        bf16x8 xa[8], xn[8];
#pragma unroll
        for (int i = 0; i < 8; ++i) xa[i] = *(const bf16x8*)(xp + i * 32);
        for (int kb = 0; kb < 64; kb += 8) {
            const int kn = (kb + 8 < 64) ? kb + 8 : kb;
#pragma unroll
            for (int i = 0; i < 8; ++i) xn[i] = *(const bf16x8*)(xp + (kn + i) * 32);
#pragma unroll
            for (int i = 0; i < 8; ++i) {
                const bf16x8 bh = *(const bf16x8*)(hp + (kb + i) * 32), bl = *(const bf16x8*)(lp + (kb + i) * 32);
                ah[i & 1] = __builtin_amdgcn_mfma_f32_16x16x32_bf16(xa[i], bh, ah[i & 1], 0, 0, 0);
                al[i & 1] = __builtin_amdgcn_mfma_f32_16x16x32_bf16(xa[i], bl, al[i & 1], 0, 0, 0);
                const u32x4 xv = __builtin_bit_cast(u32x4, xa[i]);
                const u32x4 gq = *(const u32x4*)(g_bf + (kb + i) * 32 + fq * 8), sq4 = *(const u32x4*)(s_bf + (kb + i) * 32 + fq * 8);
                u32x2 o;
                o.x = pack_fp8x4(bflo(xv.x) * rsl * bflo(gq.x) + bflo(sq4.x), bfhi(xv.x) * rsl * bfhi(gq.x) + bfhi(sq4.x), bflo(xv.y) * rsl * bflo(gq.y) + bflo(sq4.y), bfhi(xv.y) * rsl * bfhi(gq.y) + bfhi(sq4.y));
                o.y = pack_fp8x4(bflo(xv.z) * rsl * bflo(gq.z) + bflo(sq4.z), bfhi(xv.z) * rsl * bfhi(gq.z) + bfhi(sq4.z), bflo(xv.w) * rsl * bflo(gq.w) + bflo(sq4.w), bfhi(xv.w) * rsl * bfhi(gq.w) + bfhi(sq4.w));
                *(u32x2*)(h8p + (kb + i) * 32) = o;
            }
#pragma unroll
            for (int i = 0; i < 8; ++i) xa[i] = xn[i];
        }
#pragma unroll
        for (int j = 0; j < 4; ++j) part[(size_t)(w * 16 + fq * 4 + j) * 16 + fr] = (ah[0][j] + ah[1][j]) + (al[0][j] + al[1][j]);
    }
    __syncthreads();
    int re0 = 0, re1 = 0; unsigned rp0 = 0, rp1 = 0; float rg0 = 0.f, rg1 = 0.f;
    if (tid < RB) {
        float lg[16], ss = 0.f;
#pragma unroll
        for (int e = 0; e < 16; ++e) lg[e] = 0.f;
        {
            const float* pr = part + (size_t)tid * 16;
#pragma unroll
            for (int e = 0; e < 16; ++e) lg[e] += pr[e];
            const f32x4 s0 = *(const f32x4*)(ssp + (size_t)(row0 + tid) * 8), s1 = *(const f32x4*)(ssp + (size_t)(row0 + tid) * 8 + 4);
            ss = ((s0[0] + s0[1]) + (s0[2] + s0[3])) + ((s1[0] + s1[1]) + (s1[2] + s1[3]));
        }
        const float rs = rsqrtf(ss * (1.0f / ND) + RMS_EPS);
        rs_lds[tid] = rs;
#pragma unroll
        for (int e = 0; e < 16; ++e) {
            float c = 0.f;
#pragma unroll
            for (int ww = 0; ww < 8; ++ww) c += part_c[ww * 16 + e];
            lg[e] = lg[e] * rs + c;
        }
        float mx = lg[0];
#pragma unroll
        for (int e = 1; e < 16; ++e) mx = fmaxf(mx, lg[e]);
        float p[16], sum = 0.f;
#pragma unroll
        for (int e = 0; e < 16; ++e) { p[e] = __expf(lg[e] - mx); sum += p[e]; }
        const float isum = 1.f / sum;
        float sel[16];
#pragma unroll
        for (int e = 0; e < 16; ++e) { p[e] *= isum; sel[e] = p[e] + b_router[e]; }
        int grp = 0; float best = -1e30f;
#pragma unroll
        for (int gI = 0; gI < 4; ++gI) {
            float m1 = -1e30f, m2 = -1e30f;
#pragma unroll
            for (int j = 0; j < 4; ++j) { const float sv = sel[gI * 4 + j]; if (sv > m1) { m2 = m1; m1 = sv; } else if (sv > m2) { m2 = sv; } }
            const float gs = m1 + m2;
            if (gs > best) { best = gs; grp = gI; }
        }
        float s4[4], p4[4];
#pragma unroll
        for (int j = 0; j < 4; ++j) { s4[j] = 0.f; p4[j] = 0.f; }
#pragma unroll
        for (int gI = 0; gI < 4; ++gI)
#pragma unroll
            for (int j = 0; j < 4; ++j) if (grp == gI) { s4[j] = sel[gI * 4 + j]; p4[j] = p[gI * 4 + j]; }
        int i1 = 0; float v1 = s4[0];
#pragma unroll
        for (int j = 1; j < 4; ++j) if (s4[j] > v1) { v1 = s4[j]; i1 = j; }
        int i2 = -1; float v2 = -1e30f;
#pragma unroll
        for (int j = 0; j < 4; ++j) if (j != i1 && s4[j] > v2) { v2 = s4[j]; i2 = j; }
        float pa = 0.f, pb = 0.f;
#pragma unroll
        for (int j = 0; j < 4; ++j) { if (j == i1) pa = p4[j]; if (j == i2) pb = p4[j]; }
        const float inv = 1.f / (pa + pb);
        re0 = grp * 4 + i1; re1 = grp * 4 + i2; rg0 = pa * inv; rg1 = pb * inv;
        rp0 = atomicAdd(&lcnt[re0], 1u);
        rp1 = atomicAdd(&lcnt[re1], 1u);
    }
    __syncthreads();
    if (tid < 16) lcnt[16 + tid] = atomicAdd(cnt + tid * 64, lcnt[tid]);
    __syncthreads();
    if (tid < RB) {
        const int t = row0 + tid;
        const unsigned p0 = lcnt[16 + re0] + rp0, p1 = lcnt[16 + re1] + rp1;
        idx[re0 * 32768 + p0] = t * 2 + 0; gts[re0 * 32768 + p0] = rg0;
        idx[re1 * 32768 + p1] = t * 2 + 1; gts[re1 * 32768 + p1] = rg1;
    }
    __syncthreads();
}

constexpr int BM = 256, BK = 64, HALF = 128, HT = HALF * BK;
__device__ __forceinline__ int lds_byte(int r, int c) {
    const int st = (r >> 4) * 2 + (c >> 5), rr = r & 15, cc = c & 31, ob = rr * 64 + cc * 2;
    return st * 1024 + (ob ^ (((ob >> 9) & 1) << 5));
}
__device__ __forceinline__ void stage_rc(int b, int& R, int& C) {
    const int st = b / 1024, sb = b % 1024, swz = sb ^ (((sb >> 9) & 1) << 5);
    R = (st >> 1) * 16 + swz / 64; C = (st & 1) * 32 + (swz % 64) / 2;
}

typedef int v8i __attribute__((ext_vector_type(8)));
typedef int i32x4 __attribute__((ext_vector_type(4)));
template <bool F8, class RowOff, class Epi>
__device__ __forceinline__ void gemm_unit(int wv, bf16_t* shm, const bf16_t* __restrict__ A_in, const RowOff& rowoff, const bf16_t* __restrict__ Bt_in, int ldb, int K, const Epi& epi) {
    const bf16_t* A; const bf16_t* Bt;
#define SA(b, h) (shm + ((b) * 2 + (h)) * HT)
#define SB(b, h) (shm + (4 + (b) * 2 + (h)) * HT)
#define GLDS(sbase, voff, m0v) do { unsigned _keep; asm volatile("s_mov_b32 %0, m0\n\ts_mov_b32 m0, %3\n\ts_nop 0\n\tglobal_load_lds_dwordx4 %1, %2\n\ts_mov_b32 m0, %0" \
        : "=&s"(_keep) : "v"(voff), "s"(sbase), "s"(m0v) : "memory"); } while (0)
#define STAGE_A(P, h, kt) do { const char* _ab = (const char*)A + (size_t)(kt) * (BK * 2) + (h) * a_h; const unsigned _m0 = ldsb + (unsigned)((char*)(P) - (char*)shm) + (unsigned)wv * 1024u; \
        GLDS(_ab, aoff[h][0], _m0); GLDS(_ab + a_i, aoff[h][1], _m0 + 8192u); } while (0)
#define STAGE_B(P, h, kt) do { const char* _bb = (const char*)Bt + ((size_t)((h) * HALF) * ldb + (size_t)(kt) * BK) * 2; const unsigned _m0 = ldsb + (unsigned)((char*)(P) - (char*)shm) + (unsigned)wv * 1024u; \
        GLDS(_bb, boff, _m0); GLDS(_bb + (size_t)64 * ldb * 2, boff, _m0 + 8192u); } while (0)
#define LDFRAG(dst, base, row) do { const i32x4 _lo = *reinterpret_cast<const i32x4*>((char*)(base) + lds_byte((row), fq * 8)); \
        const i32x4 _hi = *reinterpret_cast<const i32x4*>((char*)(base) + lds_byte((row), 32 + fq * 8)); \
        dst = __builtin_shufflevector(_lo, _hi, 0, 1, 2, 3, 4, 5, 6, 7); } while (0)
#define LDA(dst, b, h) _Pragma("unroll") for (int m = 0; m < 4; ++m) LDFRAG(dst[m], SA(b, h), wr * 64 + m * 16 + fr)
#define LDB(dst, b, h) _Pragma("unroll") for (int n = 0; n < 2; ++n) LDFRAG(dst[n], SB(b, h), wc * 32 + n * 16 + fr)
#define MMA(ai, bj, Af, Bf) do { __builtin_amdgcn_s_setprio(1); \
        _Pragma("unroll") for (int m = 0; m < 4; ++m) _Pragma("unroll") for (int n = 0; n < 2; ++n) { \
            if (F8) acc[ai][bj][m][n] = __builtin_amdgcn_mfma_scale_f32_16x16x128_f8f6f4(Bf[n], Af[m], acc[ai][bj][m][n], 0, 0, 0, 0, 0, 0);     \
            else { acc[ai][bj][m][n] = __builtin_amdgcn_mfma_f32_16x16x32_bf16(__builtin_bit_cast(bf16x8, __builtin_shufflevector(Bf[n], Bf[n], 0, 1, 2, 3)), __builtin_bit_cast(bf16x8, __builtin_shufflevector(Af[m], Af[m], 0, 1, 2, 3)), acc[ai][bj][m][n], 0, 0, 0); \
                   acc[ai][bj][m][n] = __builtin_amdgcn_mfma_f32_16x16x32_bf16(__builtin_bit_cast(bf16x8, __builtin_shufflevector(Bf[n], Bf[n], 4, 5, 6, 7)), __builtin_bit_cast(bf16x8, __builtin_shufflevector(Af[m], Af[m], 4, 5, 6, 7)), acc[ai][bj][m][n], 0, 0, 0); } } \
        __builtin_amdgcn_s_setprio(0); } while (0)
#define WAIT_V(n) asm volatile("s_waitcnt vmcnt(" #n ")" ::: "memory")
#define WAIT_L(n) asm volatile("s_waitcnt lgkmcnt(" #n ")" ::: "memory")
#define BAR __builtin_amdgcn_s_barrier()
#define SCHED __builtin_amdgcn_sched_barrier(0)
    asm volatile("" : "+s"(wv));
    int tx = tid_fresh(wv);
    constexpr unsigned ldsb = 0u;
    {
        const size_t a_ = (size_t)A_in, b_ = (size_t)Bt_in;
        A = (const bf16_t*)(((size_t)(unsigned)__builtin_amdgcn_readfirstlane((int)(a_ >> 32)) << 32) | (size_t)(unsigned)__builtin_amdgcn_readfirstlane((int)a_));
        Bt = (const bf16_t*)(((size_t)(unsigned)__builtin_amdgcn_readfirstlane((int)(b_ >> 32)) << 32) | (size_t)(unsigned)__builtin_amdgcn_readfirstlane((int)b_));
    }
    int lane = tx & 63, wr = wv >> 2, wc = wv & 3, fr = lane & 15, fq = lane >> 4;
    unsigned aoff[2][2], boff;
    {
        int r0, c0; stage_rc(tx * 16, r0, c0);
        boff = (unsigned)(r0 * ldb + c0) * 2u;
        if (RowOff::PLAIN) { aoff[0][0] = (rowoff(r0) + (unsigned)c0) * 2u; aoff[0][1] = aoff[0][0]; aoff[1][0] = aoff[0][0]; aoff[1][1] = aoff[0][0]; }
        else {
            aoff[0][0] = (rowoff(r0) + (unsigned)c0) * 2u; aoff[0][1] = (rowoff(r0 + 64) + (unsigned)c0) * 2u;
            aoff[1][0] = (rowoff(HALF + r0) + (unsigned)c0) * 2u; aoff[1][1] = (rowoff(HALF + r0 + 64) + (unsigned)c0) * 2u;
        }
    }
    const size_t a_h = RowOff::PLAIN ? (size_t)rowoff.ld * HALF * 2 : 0, a_i = RowOff::PLAIN ? (size_t)rowoff.ld * 64 * 2 : 0;
    f32x4 acc[2][2][4][2] = {};
    v8i At[4] = {}, B0[2] = {}, B1[2] = {};
    const int nt = K / BK;
    STAGE_B(SB(0, 0), 0, 0); STAGE_A(SA(0, 0), 0, 0);
    STAGE_B(SB(0, 1), 1, 0); STAGE_A(SA(0, 1), 1, 0);
    if (wr == 1) BAR;
    WAIT_V(4); BAR;
    STAGE_B(SB(1, 0), 0, 1); STAGE_A(SA(1, 0), 0, 1); STAGE_B(SB(1, 1), 1, 1);
    WAIT_V(6); BAR;
    for (int t = 0; t < nt - 2; t += 2) {
        LDB(B0, 0, 0); SCHED; LDA(At, 0, 0); STAGE_A(SA(1, 1), 1, t + 1);
        WAIT_L(8); BAR; WAIT_L(0); MMA(0, 0, At, B0); BAR; SCHED;
        LDB(B1, 0, 1); STAGE_B(SB(0, 0), 0, t + 2);
        BAR; WAIT_L(0); MMA(0, 1, At, B1); BAR;
        LDA(At, 0, 1); STAGE_A(SA(0, 0), 0, t + 2);
        BAR; WAIT_L(0); MMA(1, 0, At, B0); BAR; SCHED;
        STAGE_B(SB(0, 1), 1, t + 2);
        WAIT_V(6); BAR; MMA(1, 1, At, B1); BAR;
        LDB(B0, 1, 0); SCHED; LDA(At, 1, 0); STAGE_A(SA(0, 1), 1, t + 2);
        WAIT_L(8); BAR; WAIT_L(0); MMA(0, 0, At, B0); BAR; SCHED;
        LDB(B1, 1, 1); STAGE_B(SB(1, 0), 0, t + 3);
        BAR; WAIT_L(0); MMA(0, 1, At, B1); BAR;
        LDA(At, 1, 1); STAGE_A(SA(1, 0), 0, t + 3);
        BAR; WAIT_L(0); MMA(1, 0, At, B0); BAR; SCHED;
        STAGE_B(SB(1, 1), 1, t + 3);
        WAIT_V(6); BAR; MMA(1, 1, At, B1); BAR;
    }
    { LDB(B0, 0, 0); WAIT_V(0); LDA(At, 0, 0); STAGE_A(SA(1, 1), 1, nt - 1);
      BAR; WAIT_L(0); MMA(0, 0, At, B0); BAR;
      LDB(B1, 0, 1); BAR; WAIT_L(0); MMA(0, 1, At, B1); BAR;
      LDA(At, 0, 1); WAIT_V(4); BAR; WAIT_L(0); MMA(1, 0, At, B0); MMA(1, 1, At, B1); BAR; }
    { LDB(B0, 1, 0); LDA(At, 1, 0); WAIT_V(2); BAR; WAIT_L(0); MMA(0, 0, At, B0); BAR;
      LDB(B1, 1, 1); WAIT_V(0); BAR; WAIT_L(0); MMA(0, 1, At, B1); BAR;
      LDA(At, 1, 1); BAR; WAIT_L(0); MMA(1, 0, At, B0); MMA(1, 1, At, B1); BAR; }
    if (wr == 0) BAR;
    int tz = tid_fresh(wv); lane = tz & 63; fr = lane & 15; fq = lane >> 4;
    Epi epi2 = epi; epi2.launder();
    epi2(acc, wr, wc, fr, fq);
#undef SA
#undef SB
#undef STAGE_A
#undef GLDS
#undef STAGE_B
#undef LDA
#undef LDFRAG
#undef LDB
#undef MMA
#undef WAIT_V
#undef WAIT_L
#undef BAR
#undef SCHED
}

__device__ __forceinline__ int unit_index(int k) { return (gridDim.x == 256) ? ((k * 8 + (int)(blockIdx.x & 7)) * 32 + (int)(blockIdx.x >> 3)) : (k * (int)gridDim.x + (int)blockIdx.x); }
__device__ __forceinline__ void dense_tile(int i, int nN, int& pm, int& pn) { const int g = i / (8 * nN), rem = i - g * 8 * nN; pn = rem >> 3; pm = g * 8 + (rem & 7); }
__device__ __forceinline__ int lauv(int v) { v = __builtin_amdgcn_readfirstlane(v); asm volatile("" : "+s"(v)); return v; }
template <class T> __device__ __forceinline__ T* lauv(T* p) { const size_t a_ = (size_t)p; unsigned lo = (unsigned)__builtin_amdgcn_readfirstlane((int)a_), hi = (unsigned)__builtin_amdgcn_readfirstlane((int)(a_ >> 32)); asm volatile("" : "+s"(lo), "+s"(hi)); return (T*)(((size_t)hi << 32) | lo); }
struct RowPlain { static constexpr bool PLAIN = true; unsigned base; unsigned ld; __device__ __forceinline__ unsigned operator()(int r) const { return base + (unsigned)r * ld; } };

typedef f32x4 AccT[2][2][4][2];

__device__ __forceinline__ void st_bf16x4(bf16_t* p, f32x4 v) { u32x2 o; o.x = cvt_pk_bf16(v[0], v[1]); o.y = cvt_pk_bf16(v[2], v[3]); *(GAS u32x2*)p = o; }

typedef float f32x2_t __attribute__((ext_vector_type(2)));
struct EpiIn0 {
    unsigned char* proj; const float2* rot; int pm, pn; LAS bf16_t* tl  ; int wv; float sc  ;
    __device__ __forceinline__ void launder() { proj = lauv(proj); rot = lauv(rot); pm = lauv(pm); pn = lauv(pn); }
    __device__ __forceinline__ void tile_out(bf16_t* gbase  ) const {
        __syncthreads();
        const int tid = tid_fresh(wv);
#pragma unroll
        for (int it = 0; it < 16; ++it) {
            const int c = tid + it * NT, d = c >> 5, ch = c & 31;
            *(GAS u32x4*)(gbase + (size_t)((ch >> 3) * 256 + d) * 64 + (ch & 7) * 8) = *(const LAS u32x4*)(tl + d * 264 + ch * 8);
        }
        __syncthreads();
    }
    __device__ __forceinline__ void operator()(const AccT& acc, int wr, int wc, int fr, int fq) const {
        const int row0 = pm * BM + wr * 64 + fr;
        if (pn < 4) {
            bf16_t* O = (bf16_t*)(proj + PJ_AB);
#pragma unroll
            for (int ai = 0; ai < 2; ++ai)
#pragma unroll
                for (int m = 0; m < 4; ++m) { bf16_t* rp = O + (size_t)(row0 + ai * HALF + m * 16) * 1024 + pn * 256 + wc * 32 + fq * 4;
#pragma unroll
                    for (int bj = 0; bj < 2; ++bj)
#pragma unroll
                        for (int n = 0; n < 2; ++n) st_bf16x4(rp + bj * HALF + n * 16, acc[ai][bj][m][n] * sc); }
        } else if (pn < 12) {
            bf16_t* O = (bf16_t*)(proj + PJ_U);
#pragma unroll
            for (int ai = 0; ai < 2; ++ai)
#pragma unroll
                for (int m = 0; m < 4; ++m) { bf16_t* rp = O + (size_t)(row0 + ai * HALF + m * 16) * 1024 + (pn - 4) * 128 + wc * 32 + fq * 4;
#pragma unroll
                    for (int n = 0; n < 2; ++n) st_bf16x4(rp + n * 16, acc[ai][0][m][n] * acc[ai][1][m][n] * (sc * sc)); }
        } else if (pn < 20) {
            const bool isk = pn >= 16; const int hh = (pn - 12) & 3;
            const float lg2 = log2f(1.0f - exp2f(-5.0f - (float)hh));
            bf16_t* O = (bf16_t*)(proj + (isk ? PJ_K : PJ_Q));
#pragma unroll
            for (int ai = 0; ai < 2; ++ai)
#pragma unroll
                for (int m = 0; m < 4; ++m) {
                    const int t = row0 + ai * HALF + m * 16, pos = t & (NS - 1), bb = t >> 11;
                    const int pc = pos & 63;
                    const float dsc = (isk ? 0.0625f * exp2f(-lg2 * (float)pc) : exp2f(lg2 * (float)pc)) * sc;
                    bf16_t* rp = O + (size_t)t * 1024 + hh * 256 + wc * 32 + fq * 4;
#pragma unroll
                    for (int n = 0; n < 2; ++n) {
                        const int f0 = wc * 32 + n * 16 + fq * 4;
                        f32x4 o1, o2;
#pragma unroll
                        for (int j = 0; j < 4; ++j) {
                            const f32x2_t csv = *(const GAS f32x2_t*)(rot + pos * 128 + f0 + j); const float2 cs = make_float2(csv[0], csv[1]);
                            const float x1 = acc[ai][0][m][n][j], x2 = acc[ai][1][m][n][j];
                            o1[j] = (x1 * cs.x - x2 * cs.y) * dsc; o2[j] = (x1 * cs.y + x2 * cs.x) * dsc;
                        }
                        st_bf16x4(rp + n * 16, o1); st_bf16x4(rp + HALF + n * 16, o2);
                    }
                }
        } else if (pn < 24) {
            const int hh = pn - 20; bf16_t* OT = (bf16_t*)(proj + PJ_VT);
#pragma unroll
            for (int ai = 0; ai < 2; ++ai)
#pragma unroll
                for (int m = 0; m < 4; ++m) {
                    const int t = row0 + ai * HALF + m * 16;
#pragma unroll
                    for (int bj = 0; bj < 2; ++bj)
#pragma unroll
                        for (int n = 0; n < 2; ++n) {
                            LAS bf16_t* tp = tl + (bj * HALF + wc * 32 + n * 16 + fq * 4) * 264 + (t & 255);
#pragma unroll
                            for (int j = 0; j < 4; ++j) tp[j * 264] = f2bf(acc[ai][bj][m][n][j] * sc);
                        }
                }
            tile_out(OT + ((size_t)((((pm * BM) >> 11) * 4 + hh) * 32 + (((pm * BM) & (NS - 1)) >> 6)) * 256) * 64);
        } else {
            bf16_t* O = (bf16_t*)(proj + PJ_SG);
#pragma unroll
            for (int ai = 0; ai < 2; ++ai)
#pragma unroll
                for (int m = 0; m < 4; ++m) { bf16_t* rp = O + (size_t)(row0 + ai * HALF + m * 16) * 1024 + (pn - 24) * 256 + wc * 32 + fq * 4;
#pragma unroll
                    for (int bj = 0; bj < 2; ++bj)
#pragma unroll
                        for (int n = 0; n < 2; ++n) { f32x4 v = acc[ai][bj][m][n];
#pragma unroll
                            for (int j = 0; j < 4; ++j) v[j] = silu_f(v[j] * sc);
                            st_bf16x4(rp + bj * HALF + n * 16, v); } }
        }
    }
};

template <bool ADD_TMP, bool XIN_F32>
struct EpiRes {
    const void* xin; const bf16_t* tmp; bf16_t* xout; const float* gate  ; int pm, pn; LAS float* red  ; float* ssp  ; int wv; float sc;
    __device__ __forceinline__ void launder() { xin = lauv(xin); tmp = lauv(tmp); xout = lauv(xout); gate = lauv(gate); pm = lauv(pm); pn = lauv(pn); ssp = lauv(ssp); }
    __device__ __forceinline__ void operator()(const AccT& acc, int wr, int wc, int fr, int fq) const {
        const int row0 = pm * BM + wr * 64 + fr, col0 = pn * BM + wc * 32 + fq * 4;
        const int bb = (pm * BM) >> 11;
        f32x4 gv[2][2];
#pragma unroll
        for (int bj = 0; bj < 2; ++bj)
#pragma unroll
            for (int n = 0; n < 2; ++n) gv[bj][n] = *(const GAS f32x4*)(gate + (size_t)bb * 6144 + col0 + bj * HALF + n * 16);
        const int lane = fq * 16 + fr;
#pragma unroll
        for (int ai = 0; ai < 2; ++ai)
#pragma unroll
            for (int m = 0; m < 4; ++m) {
                const size_t ro = (size_t)(row0 + ai * HALF + m * 16) * ND + col0;
                float ss = 0.f;
#pragma unroll
                for (int bj = 0; bj < 2; ++bj)
#pragma unroll
                    for (int n = 0; n < 2; ++n) {
                        f32x4 xv = XIN_F32 ? *(const GAS f32x4*)((const float*)xin + ro + bj * HALF + n * 16) : ld_bf16x4((const bf16_t*)xin + ro + bj * HALF + n * 16);
                        if (ADD_TMP) xv += ld_bf16x4(tmp + ro + bj * HALF + n * 16);
                        const f32x4 ov = xv + gv[bj][n] * (acc[ai][bj][m][n] * sc);
                        u32x2 o; o.x = cvt_pk_bf16(ov[0], ov[1]); o.y = cvt_pk_bf16(ov[2], ov[3]);
                        *(GAS u32x2*)(xout + ro + bj * HALF + n * 16) = o;
                        const float r0 = bflo(o.x), r1 = bfhi(o.x), r2 = bflo(o.y), r3 = bfhi(o.y);
                        ss += r0 * r0 + r1 * r1 + r2 * r2 + r3 * r3;
                    }
                ss += shx(ss, 16, lane); ss += shx(ss, 32, lane);
                if (fq == 0) red[(ai * HALF + wr * 64 + m * 16 + fr) * 4 + wc] = ss;
            }
        __syncthreads();
        {
            const int tid = tid_fresh(wv);
            if (tid < 256) { const LAS float* rp = red + tid * 4; ((GAS float*)ssp)[(size_t)(pm * BM + tid) * 8 + pn] = (rp[0] + rp[1]) + (rp[2] + rp[3]); }
        }
        __syncthreads();
    }
};

typedef short s16x4_t __attribute__((ext_vector_type(4)));
__device__ __forceinline__ void retention_phase(int wv, unsigned char* proj, bf16_t* __restrict__ Og, unsigned char* lds) {
    const int tid = tid_fresh(wv);
    bf16_t* P_lds = (bf16_t*)lds;
    bf16_t* St_lds = (bf16_t*)(lds + 9216);
    bf16_t* Q_lds = (bf16_t*)(lds + 9216 + 33792);
    bf16_t* K_lds = (bf16_t*)(lds + 9216 + 2 * 33792);
    bf16_t* V_lds = (bf16_t*)(lds + 9216 + 3 * 33792);
    const bf16_t* Qg = (const bf16_t*)(proj + PJ_Q); const bf16_t* Kg = (const bf16_t*)(proj + PJ_K);
    const bf16_t* KTg = (const bf16_t*)(proj + PJ_KT); const bf16_t* VTg = (const bf16_t*)(proj + PJ_VT);
    const int ti = wv >> 1, hf = wv & 1;
    for (int u0 = blockIdx.x; u0 < 256; u0 += gridDim.x) {
        int tu = tid; asm volatile("" : "+v"(tu));
        const int srow = tu >> 5, sc16 = tu & 31;
        const int vrow = tu >> 3, vc8 = tu & 7;
        const int fr = tu & 15, fq = (tu >> 4) & 3, w = wv;
        int u = u0;
        if (gridDim.x == 256) { const int xcd = u0 & 7, j = u0 >> 3; u = (((j >> 2) * 8 + xcd) << 2) | (j & 3); }
        const int b = u >> 4, hh = (u >> 2) & 3, es = u & 3;
        const float gam = 1.0f - exp2f(-5.0f - (float)hh);
        const float g63 = exp2f(63.0f * log2f(gam));
        const size_t hrow = (size_t)(b * 4 + hh) * 256;
        const bf16_t* qsp = Qg + ((size_t)b * NS + srow) * 1024 + hh * 256 + sc16 * 8;
        const bf16_t* ksp = Kg + ((size_t)b * NS + srow) * 1024 + hh * 256 + sc16 * 8;
        const bf16_t* vsp = VTg + (hrow * 32 + es * 64 + vrow) * 64 + vc8 * 8;
        u32x4 qr[2][4], kr[2][4], vr[2];
#pragma unroll
        for (int i = 0; i < 4; ++i) { qr[0][i] = *(const u32x4*)(qsp + (size_t)(16 * i) * 1024); kr[0][i] = *(const u32x4*)(ksp + (size_t)(16 * i) * 1024); }
        vr[0] = *(const u32x4*)vsp; vr[1] = *(const u32x4*)(vsp + 256 * 64);
        __syncthreads();
        for (int i = tid; i < 64 * 264 / 2; i += NT) ((unsigned*)St_lds)[i] = 0u;
#pragma unroll
        for (int i = 0; i < 4; ++i) { *(u32x4*)(Q_lds + (srow + 16 * i) * 264 + sc16 * 8) = qr[0][i]; *(u32x4*)(K_lds + (srow + 16 * i) * 264 + sc16 * 8) = kr[0][i]; }
#pragma unroll
        for (int i = 0; i < 4; ++i) { qr[1][i] = *(const u32x4*)(qsp + (size_t)(64 + 16 * i) * 1024); kr[1][i] = *(const u32x4*)(ksp + (size_t)(64 + 16 * i) * 1024); }
        f32x4 S[2][4];
#pragma unroll
        for (int dl = 0; dl < 2; ++dl)
#pragma unroll
            for (int et = 0; et < 4; ++et) S[dl][et] = (f32x4){0.f, 0.f, 0.f, 0.f};
        __syncthreads();
        for (int c2 = 0; c2 < 32; c2 += 2) {
#pragma unroll
          for (int e = 0; e < 2; ++e) {
            const int c = c2 + e;
            int tl = tid; asm volatile("" : "+v"(tl));
            const int fr = tl & 15, fq = (tl >> 4) & 3, srow = tl >> 5, sc16 = tl & 31, vrow = tl >> 3, vc8 = tl & 7, w = wv;
            const bf16_t* qsp = Qg + ((size_t)b * NS + srow) * 1024 + hh * 256 + sc16 * 8;
            const bf16_t* ksp = Kg + ((size_t)b * NS + srow) * 1024 + hh * 256 + sc16 * 8;
            const bf16_t* vsp = VTg + (hrow * 32 + es * 64 + vrow) * 64 + vc8 * 8;
            const int j0 = c * 64;
            const size_t trow = (size_t)b * NS + j0;
            *(u32x4*)(V_lds + vrow * 72 + vc8 * 8) = vr[e];
            {
                const int cn = (c + 2 < 32) ? c + 2 : 31;
#pragma unroll
                for (int i = 0; i < 4; ++i) { qr[e][i] = *(const u32x4*)(qsp + (size_t)(cn * 64 + 16 * i) * 1024); kr[e][i] = *(const u32x4*)(ksp + (size_t)(cn * 64 + 16 * i) * 1024); }
                vr[e] = *(const u32x4*)(vsp + (size_t)cn * (256 * 64));
            }
            bf16x8 ktf[2][2];
#pragma unroll
            for (int dl = 0; dl < 2; ++dl)
#pragma unroll
                for (int ks = 0; ks < 2; ++ks) {
                    const bf16_t* kp = K_lds + (ks * 32 + fq * 8 + (fr >> 2)) * 264 + (2 * w + dl) * 16 + (fr & 3) * 4;
                    const s16x4_t t0 = __builtin_amdgcn_ds_read_tr16_b64_v4i16((__attribute__((address_space(3))) s16x4_t*)(kp));
                    const s16x4_t t1 = __builtin_amdgcn_ds_read_tr16_b64_v4i16((__attribute__((address_space(3))) s16x4_t*)(kp + 4 * 264));
                    ktf[dl][ks] = __builtin_bit_cast(bf16x8, __builtin_shufflevector(t0, t1, 0, 1, 2, 3, 4, 5, 6, 7));
                }
            f32x4 pacc[2], oacc[2];
            pacc[0] = pacc[1] = oacc[0] = oacc[1] = (f32x4){0.f, 0.f, 0.f, 0.f};
            bf16x8 opA[5], opB[5];
#define RET_SB __builtin_amdgcn_sched_barrier(0);
#define RET_RD(buf, ks) { buf[4] = *(const bf16x8*)(Q_lds + (ti * 16 + fr) * 264 + (ks) * 32 + fq * 8); \
                buf[0] = *(const bf16x8*)(K_lds + ((hf * 2 + 0) * 16 + fr) * 264 + (ks) * 32 + fq * 8); buf[1] = *(const bf16x8*)(K_lds + ((hf * 2 + 1) * 16 + fr) * 264 + (ks) * 32 + fq * 8); \
                buf[2] = *(const bf16x8*)(St_lds + ((hf * 2 + 0) * 16 + fr) * 264 + (ks) * 32 + fq * 8); buf[3] = *(const bf16x8*)(St_lds + ((hf * 2 + 1) * 16 + fr) * 264 + (ks) * 32 + fq * 8); }
#define RET_MM(buf, ks) { \
                pacc[0] = __builtin_amdgcn_mfma_f32_16x16x32_bf16(buf[0], buf[4], pacc[0], 0, 0, 0); pacc[1] = __builtin_amdgcn_mfma_f32_16x16x32_bf16(buf[1], buf[4], pacc[1], 0, 0, 0); \
                oacc[0] = __builtin_amdgcn_mfma_f32_16x16x32_bf16(buf[2], buf[4], oacc[0], 0, 0, 0); oacc[1] = __builtin_amdgcn_mfma_f32_16x16x32_bf16(buf[3], buf[4], oacc[1], 0, 0, 0); }
            RET_RD(opA, 0) RET_RD(opB, 1) RET_SB
            RET_MM(opA, 0) RET_SB RET_RD(opA, 2) RET_SB RET_MM(opB, 1) RET_SB RET_RD(opB, 3) RET_SB
            RET_MM(opA, 2) RET_SB RET_RD(opA, 4) RET_SB RET_MM(opB, 3) RET_SB RET_RD(opB, 5) RET_SB
            RET_MM(opA, 4) RET_SB RET_RD(opA, 6) RET_SB RET_MM(opB, 5) RET_SB RET_RD(opB, 7) RET_SB
            RET_MM(opA, 6) RET_SB RET_MM(opB, 7) RET_SB
#undef RET_RD
#undef RET_MM
#pragma unroll
            for (int tt = 0; tt < 2; ++tt) {
                const int tj = hf * 2 + tt;
                { const int i = ti * 16 + fr, jc = tj * 16 + fq * 4; f32x4 pv = pacc[tt];
#pragma unroll
                  for (int j = 0; j < 4; ++j) pv[j] = (jc + j <= i) ? pv[j] : 0.f;
                  u32x2 o; o.x = cvt_pk_bf16(pv[0], pv[1]); o.y = cvt_pk_bf16(pv[2], pv[3]); *(u32x2*)(P_lds + i * 72 + jc) = o; }
            }
            __syncthreads();
#pragma unroll
            for (int i = 0; i < 4; ++i) { *(u32x4*)(Q_lds + (srow + 16 * i) * 264 + sc16 * 8) = qr[e ^ 1][i]; *(u32x4*)(K_lds + (srow + 16 * i) * 264 + sc16 * 8) = kr[e ^ 1][i]; }
            bf16x8 pf[2], vfo[2][2], vf[4][2];
#pragma unroll
            for (int ks = 0; ks < 2; ++ks) {
                pf[ks] = *(const bf16x8*)(P_lds + (ti * 16 + fr) * 72 + ks * 32 + fq * 8);
#pragma unroll
                for (int tt = 0; tt < 2; ++tt) vfo[tt][ks] = *(const bf16x8*)(V_lds + ((hf * 2 + tt) * 16 + fr) * 72 + ks * 32 + fq * 8);
#pragma unroll
                for (int et = 0; et < 4; ++et) vf[et][ks] = *(const bf16x8*)(V_lds + (et * 16 + fr) * 72 + ks * 32 + fq * 8);
            }
            oacc[0] *= gam; oacc[1] *= gam;
#pragma unroll
            for (int dl = 0; dl < 2; ++dl)
#pragma unroll
                for (int et = 0; et < 4; ++et) S[dl][et] *= gam;
            RET_SB
#pragma unroll
            for (int ks = 0; ks < 2; ++ks) {
                oacc[0] = __builtin_amdgcn_mfma_f32_16x16x32_bf16(vfo[0][ks], pf[ks], oacc[0], 0, 0, 0);
                oacc[1] = __builtin_amdgcn_mfma_f32_16x16x32_bf16(vfo[1][ks], pf[ks], oacc[1], 0, 0, 0);
#pragma unroll
                for (int dl = 0; dl < 2; ++dl)
#pragma unroll
                    for (int et = 0; et < 4; ++et) S[dl][et] = __builtin_amdgcn_mfma_f32_16x16x32_bf16(ktf[dl][ks], vf[et][ks], S[dl][et], 0, 0, 0);
            }
            RET_SB
#pragma unroll
            for (int tt = 0; tt < 2; ++tt) {
                const int te = hf * 2 + tt;
                st_bf16x4(Og + (trow + ti * 16 + fr) * 1024 + hh * 256 + es * 64 + te * 16 + fq * 4, oacc[tt]);
            }
#pragma unroll
            for (int dl = 0; dl < 2; ++dl)
#pragma unroll
                for (int et = 0; et < 4; ++et) {
                    const f32x4 sv = S[dl][et] * g63; S[dl][et] = sv;
                    u32x2 o; o.x = cvt_pk_bf16(sv[0], sv[1]); o.y = cvt_pk_bf16(sv[2], sv[3]);
                    *(u32x2*)(St_lds + (et * 16 + fr) * 264 + (2 * w + dl) * 16 + fq * 4) = o;
                }
#undef RET_SB
            __syncthreads();
          }
        }
    }
}

__device__ __forceinline__ void ycat_phase(int wv, const unsigned char* proj, const bf16_t* __restrict__ Og, const float* __restrict__ conv_w, const float* __restrict__ conv_b, bf16_t* __restrict__ Y) {
    const int tid = tid_fresh(wv), lane = tid & 63, wave = tid >> 6;
    const bf16_t* AB = (const bf16_t*)(proj + PJ_AB); const bf16_t* U = (const bf16_t*)(proj + PJ_U); const bf16_t* SG = (const bf16_t*)(proj + PJ_SG);
    const int ch0 = lane * 16;
    float cw0[16], cw1[16], cw2[16], cb[16];
#pragma unroll
    for (int i = 0; i < 16; ++i) { cw0[i] = conv_w[ch0 + i]; cw1[i] = conv_w[1024 + ch0 + i]; cw2[i] = conv_w[2048 + ch0 + i]; cb[i] = conv_b[ch0 + i]; }
    const int rows_per_wave = NTOK / ((int)gridDim.x * 8);
    const int row0 = (blockIdx.x * 8 + wave) * rows_per_wave;
    float u1[16], u2[16];
    auto load16 = [&](const bf16_t* p, float* f) {
        const u32x4 a = *(const u32x4*)p; const u32x4 c = *(const u32x4*)(p + 8);
        f[0] = bflo(a.x); f[1] = bfhi(a.x); f[2] = bflo(a.y); f[3] = bfhi(a.y); f[4] = bflo(a.z); f[5] = bfhi(a.z); f[6] = bflo(a.w); f[7] = bfhi(a.w);
        f[8] = bflo(c.x); f[9] = bfhi(c.x); f[10] = bflo(c.y); f[11] = bfhi(c.y); f[12] = bflo(c.z); f[13] = bfhi(c.z); f[14] = bflo(c.w); f[15] = bfhi(c.w);
    };
    auto store16 = [&](bf16_t* p, const float* f) {
        u32x4 a, c;
        a.x = cvt_pk_bf16(f[0], f[1]); a.y = cvt_pk_bf16(f[2], f[3]); a.z = cvt_pk_bf16(f[4], f[5]); a.w = cvt_pk_bf16(f[6], f[7]);
        c.x = cvt_pk_bf16(f[8], f[9]); c.y = cvt_pk_bf16(f[10], f[11]); c.z = cvt_pk_bf16(f[12], f[13]); c.w = cvt_pk_bf16(f[14], f[15]);
        *(u32x4*)p = a; *(u32x4*)(p + 8) = c;
    };
    auto store16f8 = [&](unsigned char* p, const float* f) {
        u32x4 a;
        a.x = pack_fp8x4(f[0] * Y8_SCALE, f[1] * Y8_SCALE, f[2] * Y8_SCALE, f[3] * Y8_SCALE); a.y = pack_fp8x4(f[4] * Y8_SCALE, f[5] * Y8_SCALE, f[6] * Y8_SCALE, f[7] * Y8_SCALE);
        a.z = pack_fp8x4(f[8] * Y8_SCALE, f[9] * Y8_SCALE, f[10] * Y8_SCALE, f[11] * Y8_SCALE); a.w = pack_fp8x4(f[12] * Y8_SCALE, f[13] * Y8_SCALE, f[14] * Y8_SCALE, f[15] * Y8_SCALE);
        *(u32x4*)p = a;
    };
    {
        const int pos = row0 & (NS - 1);
#pragma unroll
        for (int i = 0; i < 16; ++i) { u1[i] = 0.f; u2[i] = 0.f; }
        if (pos >= 1) load16(U + (size_t)(row0 - 1) * 1024 + ch0, u1);
        if (pos >= 2) load16(U + (size_t)(row0 - 2) * 1024 + ch0, u2);
    }
    for (int r = 0; r < rows_per_wave; ++r) {
        const int t = row0 + r;
        float ab[16], u0[16], y[16];
        load16(AB + (size_t)t * 1024 + ch0, ab); load16(U + (size_t)t * 1024 + ch0, u0);
        if ((t & (NS - 1)) == 0) {
#pragma unroll
            for (int i = 0; i < 16; ++i) { u1[i] = 0.f; u2[i] = 0.f; }
        }
#pragma unroll
        for (int i = 0; i < 16; ++i) { y[i] = ab[i] * (cb[i] + cw0[i] * u2[i] + cw1[i] * u1[i] + cw2[i] * u0[i]); u2[i] = u1[i]; u1[i] = u0[i]; }
        if (F8_P5) store16f8((unsigned char*)Y + (size_t)t * ND + ch0, y); else store16(Y + (size_t)t * ND + ch0, y);
        float o[16], sg[16];
        load16(Og + (size_t)t * 1024 + ch0, o); load16(SG + (size_t)t * 1024 + ch0, sg);
        float ss = 0.f;
#pragma unroll
        for (int i = 0; i < 16; ++i) ss += o[i] * o[i];
        ss += shx(ss, 1, lane); ss += shx(ss, 2, lane); ss += shx(ss, 4, lane); ss += shx(ss, 8, lane);
        const float rs = rsqrtf(ss * (1.0f / 256.0f) + RMS_EPS);
#pragma unroll
        for (int i = 0; i < 16; ++i) y[i] = o[i] * rs * sg[i];
        if (F8_P5) store16f8((unsigned char*)Y + (size_t)t * ND + 1024 + ch0, y); else store16(Y + (size_t)t * ND + 1024 + ch0, y);
    }
}

constexpr int MOE_TAB_OFF = 64;
__device__ __forceinline__ int moe_build_table(int wv, const unsigned* cntp, unsigned char* lds) {
    volatile LAS int* tab = (volatile LAS int*)(lds + LDS_MISC + MOE_TAB_OFF);
    __syncthreads();
    if (wv == 0) {
        const int lane = tid_fresh(wv) & 63;
        if (lane == 0) {
            int mt = 0;
            for (int e = 0; e < 16; ++e) {
                const int c = (int)__hip_atomic_load(cntp + e * 64, __ATOMIC_RELAXED, __HIP_MEMORY_SCOPE_AGENT);
                for (int lt = 0; lt * 256 < c; ++lt) { tab[4 + mt * 4 + 0] = e; tab[4 + mt * 4 + 1] = lt * 256; tab[4 + mt * 4 + 2] = c; ++mt; }
            }
            tab[0] = mt;
        }
    }
    __syncthreads();
    return __builtin_amdgcn_readfirstlane(tab[0]);
}
struct RowGather {
    static constexpr bool PLAIN = false; static constexpr unsigned ld = 0;
    const int* idx; int nvalid;
    __device__ __forceinline__ unsigned operator()(int r) const {
        const __amdgpu_buffer_rsrc_t rs = __builtin_amdgcn_make_buffer_rsrc((void*)idx, 0, 256 * 4, 0x00020000);
        const int v = (r < nvalid) ? (int)__builtin_amdgcn_raw_buffer_load_b32(rs, r * 4, 0, 0) : 0;
        return (unsigned)(v >> 1) * (unsigned)(ND / 2);
    }
};
struct EpiGate {
    bf16_t* act; int row0g  , colbase;
    __device__ __forceinline__ void launder() { act = lauv(act); row0g = lauv(row0g); colbase = lauv(colbase); }
    __device__ __forceinline__ void operator()(const AccT& acc, int wr, int wc, int fr, int fq) const {
        const int lo = fr * DEXP + fq * 4;
        const __amdgpu_buffer_rsrc_t rs = __builtin_amdgcn_make_buffer_rsrc((void*)((unsigned char*)act + (size_t)(row0g + wr * 64) * DEXP + colbase + wc * 32), 0, 256 * DEXP, 0x00020000);
#pragma unroll
        for (int ai = 0; ai < 2; ++ai)
#pragma unroll
            for (int m = 0; m < 4; ++m) {
#pragma unroll
                for (int n = 0; n < 2; ++n) { f32x4 v;
#pragma unroll
                    for (int j = 0; j < 4; ++j) v[j] = silu_f(acc[ai][0][m][n][j] * (1.0f / W8_SCALE)) * acc[ai][1][m][n][j] * (A8_SCALE / W8_SCALE);
                    __builtin_amdgcn_raw_buffer_store_b32(pack_fp8x4(v[0], v[1], v[2], v[3]), rs, lo + n * 16, (ai * HALF + m * 16) * DEXP, 0); } }
    }
};
constexpr float T8_SCALE = 16.0f;
struct EpiMoeOut {
    const int* idx; const float* gts; int nvalid; bf16_t* tmp1; bf16_t* tmp; const float* gate  ; int col0t; int tmp8  ;
    __device__ __forceinline__ void launder() { idx = lauv(idx); gts = lauv(gts); tmp1 = lauv(tmp1); tmp = lauv(tmp); gate = lauv(gate); nvalid = lauv(nvalid); col0t = lauv(col0t); tmp8 = lauv(tmp8); }
    __device__ __forceinline__ void operator()(const AccT& acc, int wr, int wc, int fr, int fq) const {
        const int colb = col0t + wc * 32 + fq * 4;
#pragma unroll
        for (int ai = 0; ai < 2; ++ai)
#pragma unroll
            for (int m = 0; m < 4; ++m) {
                const int r = ai * HALF + wr * 64 + m * 16 + fr;
                if (r < nvalid) {
                    const int v = ((const GAS int*)idx)[r]; const float g = ((const GAS float*)gts)[r];
                    const int tok = v >> 1;
                    const size_t ro = (size_t)tok * ND + colb;
#pragma unroll
                    for (int bj = 0; bj < 2; ++bj)
#pragma unroll
                        for (int n = 0; n < 2; ++n) {
                            const f32x4 y = acc[ai][bj][m][n] * (g * (1.0f / (W8_SCALE * A8_SCALE)));
                            *(GAS unsigned*)((unsigned char*)tmp + (size_t)(v & 1) * (64 * MiB) + ro + bj * HALF + n * 16) = pack_fp8x4(y[0] * T8_SCALE, y[1] * T8_SCALE, y[2] * T8_SCALE, y[3] * T8_SCALE);
                        }
                }
            }
    }
};

struct EpiGateLazy {
    int mt, nt;
    __device__ __forceinline__ void launder() { mt = lauv(mt); nt = lauv(nt); }
    __device__ __forceinline__ void operator()(const AccT& acc, int wr, int wc, int fr, int fq) const {
        const KA a; unsigned char* ws = a.ws();
        EpiGate E{(bf16_t*)(ws + WS_PROJ + PJ_ACT), mt * 256, nt * 128};
        E(acc, wr, wc, fr, fq);
    }
};
struct EpiMoeOutLazy {
    int e, r0, nvalid, layer, nt;
    __device__ __forceinline__ void launder() { e = lauv(e); r0 = lauv(r0); nvalid = lauv(nvalid); layer = lauv(layer); nt = lauv(nt); }
    __device__ __forceinline__ void operator()(const AccT& acc, int wr, int wc, int fr, int fq) const {
        const KA a; unsigned char* ws = a.ws();
        EpiMoeOut E{(const int*)(ws + WS_IDX) + e * 32768 + r0, (const float*)(ws + WS_GT) + e * 32768 + r0, nvalid, (bf16_t*)(ws + WS_TMP1), (bf16_t*)(ws + WS_TMP),
                    (const float*)(ws + WS_MOD) + (size_t)(2 * layer + 1) * 16 * 6144 + 4096, nt * 256, layer};
        E(acc, wr, wc, fr, fq);
    }
};
__device__ __forceinline__ void moe_phase1(int wv, unsigned char* ws0, int layer, unsigned char* lds) {
    const int nmt = moe_build_table(wv, (const unsigned*)(ws0 + WS_CTL + CTL_CNT + layer * 4096), lds);
    for (int k = 0, u = unit_index(0); u < nmt * 8; u = unit_index(++k)) {
        const KA a; unsigned char* ws = a.ws();
        const LAS int* tab = (const LAS int*)(lds + LDS_MISC + MOE_TAB_OFF);
        const int mt = u >> 3, nt = u & 7;
        const int e = __builtin_amdgcn_readfirstlane(tab[4 + mt * 4 + 0]), r0 = __builtin_amdgcn_readfirstlane(tab[4 + mt * 4 + 1]), cnt_e = __builtin_amdgcn_readfirstlane(tab[4 + mt * 4 + 2]);
        RowGather ro{(const int*)(ws + WS_IDX) + e * 32768 + r0, cnt_e - r0};
        EpiGateLazy E{mt, nt};
        gemm_unit<true>(wv, (bf16_t*)lds, (const bf16_t*)(ws + WS_H), ro, (const bf16_t*)(ws + WS_W13 + ((size_t)(layer * 16 + e) * 2048 + (size_t)nt * 256) * ND), ND / 2, ND / 2, E);
    }
}
__device__ __forceinline__ void moe_phase2(int wv, unsigned char* ws0, int layer, unsigned char* lds) {
    const int nmt = moe_build_table(wv, (const unsigned*)(ws0 + WS_CTL + CTL_CNT + layer * 4096), lds);
    for (int k = 0, u = unit_index(0); u < nmt * 8; u = unit_index(++k)) {
        const KA a; unsigned char* ws = a.ws();
        const LAS int* tab = (const LAS int*)(lds + LDS_MISC + MOE_TAB_OFF);
        const int mt = u >> 3, nt = u & 7;
        const int e = __builtin_amdgcn_readfirstlane(tab[4 + mt * 4 + 0]), r0 = __builtin_amdgcn_readfirstlane(tab[4 + mt * 4 + 1]), cnt_e = __builtin_amdgcn_readfirstlane(tab[4 + mt * 4 + 2]);
        RowPlain ro{(unsigned)(mt * 256) * (DEXP / 2), (unsigned)(DEXP / 2)};
        EpiMoeOutLazy E{e, r0, cnt_e - r0, layer, nt};
        gemm_unit<true>(wv, (bf16_t*)lds, (const bf16_t*)(ws + WS_PROJ + PJ_ACT), ro, (const bf16_t*)(ws + WS_W2 + ((size_t)(layer * 16 + e) * 2048 + (size_t)nt * 256) * DEXP), DEXP / 2, DEXP / 2, E);
    }
}

constexpr float Q8_SCALE = 8.0f;
struct EpiIn1 {
    unsigned char* proj; int pm, pn; float sc;
    __device__ __forceinline__ void launder() { proj = lauv(proj); pm = lauv(pm); pn = lauv(pn); }
    __device__ __forceinline__ void operator()(const AccT& acc, int wr, int wc, int fr, int fq) const {
        const int row0 = pm * BM + wr * 64 + fr;
        if (pn < 8 || (pn >= 9 && pn < 13)) {
            const bool isq = pn < 8;
            bf16_t* O = (bf16_t*)(proj + (isq ? PJ_Q1 : PJ_QI)); const int ld = isq ? 2048 : 1024, cb = (isq ? pn : pn - 9) * 256;
#pragma unroll
            for (int ai = 0; ai < 2; ++ai)
#pragma unroll
                for (int m = 0; m < 4; ++m) { bf16_t* rp = O + (size_t)(row0 + ai * HALF + m * 16) * ld + cb + wc * 32 + fq * 4;
                    unsigned char* rp8 = (unsigned char*)O + (size_t)(row0 + ai * HALF + m * 16) * 2048 + cb + wc * 32 + fq * 4;
#pragma unroll
                    for (int bj = 0; bj < 2; ++bj)
#pragma unroll
                        for (int n = 0; n < 2; ++n) {
                            if (isq) { const f32x4 v = acc[ai][bj][m][n] * (sc * Q8_SCALE); *(GAS unsigned*)(rp8 + bj * HALF + n * 16) = pack_fp8x4(v[0], v[1], v[2], v[3]); }
                            else st_bf16x4(rp + bj * HALF + n * 16, acc[ai][bj][m][n] * sc);
                        } }
        } else if (pn == 8) {
            bf16_t* KR = (bf16_t*)(proj + PJ_KR); bf16_t* VT = (bf16_t*)(proj + PJ_VT1);
#pragma unroll
            for (int ai = 0; ai < 2; ++ai)
#pragma unroll
                for (int m = 0; m < 4; ++m) {
                    const int t = row0 + ai * HALF + m * 16, pos = t & (NS - 1), bb = t >> 11;
#pragma unroll
                    for (int n = 0; n < 2; ++n) {
                        st_bf16x4(KR + (size_t)t * 128 + wc * 32 + n * 16 + fq * 4, acc[ai][0][m][n] * sc);
                        st_bf16x4(VT + (size_t)t * 128 + wc * 32 + n * 16 + fq * 4, acc[ai][1][m][n] * sc);
                    }
                }
        } else {
            bf16_t* KI = (bf16_t*)(proj + PJ_KI); float* WI = (float*)(proj + PJ_WI);
#pragma unroll
            for (int ai = 0; ai < 2; ++ai)
#pragma unroll
                for (int m = 0; m < 4; ++m) {
                    const int t = row0 + ai * HALF + m * 16;
                    if (wc < 2) {
#pragma unroll
                        for (int n = 0; n < 2; ++n) st_bf16x4(KI + (size_t)t * 64 + wc * 32 + n * 16 + fq * 4, acc[ai][0][m][n] * sc);
                    } else if (wc == 2) {
                        *(GAS f32x4*)(WI + (size_t)t * 16 + fq * 4) = acc[ai][0][m][0] * sc;
                    }
                }
        }
    }
};

constexpr float ATT_KS = 16.0f, ATT_QS = 64.0f;
__device__ __forceinline__ void knorm_phase(int wv, const unsigned char* proj, const float* __restrict__ k_norm, bf16_t* __restrict__ Kn) {
    const int tid = tid_fresh(wv), lane = tid & 63;
    const bf16_t* KR = (const bf16_t*)(proj + PJ_KR);
    const int sub = tid & 15;
    float kw[8];
#pragma unroll
    for (int i = 0; i < 8; ++i) kw[i] = k_norm[sub * 8 + i];
    for (int t = (blockIdx.x * NT + tid) >> 4; t < NTOK; t += (gridDim.x * NT) >> 4) {
        const u32x4 v = *(const u32x4*)(KR + (size_t)t * 128 + sub * 8);
        float f[8] = {bflo(v.x), bfhi(v.x), bflo(v.y), bfhi(v.y), bflo(v.z), bfhi(v.z), bflo(v.w), bfhi(v.w)};
        float ss = 0.f;
#pragma unroll
        for (int i = 0; i < 8; ++i) ss += f[i] * f[i];
        ss += shx(ss, 1, lane); ss += shx(ss, 2, lane); ss += shx(ss, 4, lane); ss += shx(ss, 8, lane);
        const float rs = rsqrtf(ss * (1.0f / 128.0f) + RMS_EPS);
        u32x2 o; o.x = pack_fp8x4(f[0] * rs * kw[0] * ATT_KS, f[1] * rs * kw[1] * ATT_KS, f[2] * rs * kw[2] * ATT_KS, f[3] * rs * kw[3] * ATT_KS);
        o.y = pack_fp8x4(f[4] * rs * kw[4] * ATT_KS, f[5] * rs * kw[5] * ATT_KS, f[6] * rs * kw[6] * ATT_KS, f[7] * rs * kw[7] * ATT_KS);
        *(u32x2*)((unsigned char*)Kn + (size_t)t * 128 + sub * 8) = o;
    }
}

__device__ __forceinline__ unsigned f2sort(float f) { const unsigned u = __float_as_uint(f); return (u & 0x80000000u) ? ~u : (u | 0x80000000u); }
constexpr int IDX_SC_BYTES = 8 * 2 * 2048 * 4;
constexpr int IDX_KT_BYTES = 64 * 144;
#define WRLANE2(word, lo, hi, lane_idx) asm("s_nop 1\n\tv_writelane_b32 %0, %1, " #lane_idx "\n\tv_writelane_b32 %0, %2, " #lane_idx "+1" : "+v"(word) : "s"(lo), "s"(hi))
typedef short s16x2_t __attribute__((ext_vector_type(2)));
__device__ __forceinline__ unsigned relu_bf16x2(unsigned v) { const s16x2_t z = {0, 0}; return __builtin_bit_cast(unsigned, __builtin_elementwise_max(__builtin_bit_cast(s16x2_t, v), z)); }
__device__ __forceinline__ void indexer_phase(int wv, const unsigned char* proj, unsigned* __restrict__ MASK, unsigned char* lds) {
    const int tid = tid_fresh(wv), lane = tid & 63, fr = lane & 15, fq = lane >> 4;
    const bf16_t* QI = (const bf16_t*)(proj + PJ_QI); const bf16_t* KI = (const bf16_t*)(proj + PJ_KI); const float* WI = (const float*)(proj + PJ_WI);
    float* scl = (float*)lds + (size_t)wv * 2 * 2048;
    unsigned char* ktl = lds + IDX_SC_BYTES;
    const int nunits = NB * 128;
    for (int uu = blockIdx.x; uu < nunits; uu += gridDim.x) {
        int b, q16;
        if (gridDim.x == 256) { b = blockIdx.x >> 4; const int r = blockIdx.x & 15, k = (uu - blockIdx.x) / 256; q16 = (k & 1) ? (k >> 1) * 32 + 31 - r : (k >> 1) * 32 + r; }
        else { b = uu >> 7; q16 = uu & 127; }
        const int p0 = q16 * 16, pw = p0 + 2 * wv;
        const size_t t0 = (size_t)b * NS + pw;
        bf16x8 qa[2][2], wa;
#pragma unroll
        for (int tk = 0; tk < 2; ++tk)
#pragma unroll
            for (int ks = 0; ks < 2; ++ks) qa[tk][ks] = *(const bf16x8*)(QI + (t0 + tk) * 1024 + fr * 64 + ks * 32 + fq * 8);
        {
            const f32x4 w0 = *(const f32x4*)(WI + (t0 + 0) * 16 + fq * 4), w1 = *(const f32x4*)(WI + (t0 + 1) * 16 + fq * 4);
            u32x4 wp = (u32x4){0u, 0u, 0u, 0u};
            if (fr == 0) { wp.x = cvt_pk_bf16(w0[0], w0[1]); wp.y = cvt_pk_bf16(w0[2], w0[3]); }
            if (fr == 1) { wp.z = cvt_pk_bf16(w1[0], w1[1]); wp.w = cvt_pk_bf16(w1[2], w1[3]); }
            wa = __builtin_bit_cast(bf16x8, wp);
        }
        const int nkt = (p0 >> 6) + 1;
        const int krow = tid >> 3, kch = tid & 7;
        const bf16_t* kgp = KI + ((size_t)b * NS + krow) * 64 + kch * 8;
        const int klast = nkt - 1;
#define IDX_LD(x) (*(const u32x4*)(kgp + (size_t)((x) < klast ? (x) : klast) * (64 * 64)))
        u32x4 kr0 = IDX_LD(0), kr1 = IDX_LD(1), kr2 = IDX_LD(2), kr3 = IDX_LD(3);
        __syncthreads();
        *(u32x4*)(ktl + krow * 144 + kch * 16) = kr0;
        kr0 = IDX_LD(4);
        __syncthreads();
#define IDX_SB __builtin_amdgcn_sched_barrier(0);
#define IDX_TILE(KT, KRN) { \
            const int kt_ = (KT); \
            const unsigned char* kc = ktl + (kt_ & 1) * IDX_KT_BYTES; \
            bf16x8 kf[4][2]; \
            _Pragma("unroll") \
            for (int st = 0; st < 4; ++st) { kf[st][0] = *(const bf16x8*)(kc + (st * 16 + fr) * 144 + fq * 16); kf[st][1] = *(const bf16x8*)(kc + (st * 16 + fr) * 144 + 64 + fq * 16); } \
            f32x4 dd[4][2]; \
            IDX_SB \
            _Pragma("unroll") \
            for (int st = 0; st < 4; ++st) { \
                _Pragma("unroll") \
                for (int tk = 0; tk < 2; ++tk) dd[st][tk] = __builtin_amdgcn_mfma_f32_16x16x32_bf16(qa[tk][0], kf[st][0], (f32x4){0.f, 0.f, 0.f, 0.f}, 0, 0, 0); } \
            IDX_SB \
            _Pragma("unroll") \
            for (int st = 0; st < 4; ++st) { \
                _Pragma("unroll") \
                for (int tk = 0; tk < 2; ++tk) dd[st][tk] = __builtin_amdgcn_mfma_f32_16x16x32_bf16(qa[tk][1], kf[st][1], dd[st][tk], 0, 0, 0); } \
            IDX_SB \
            u32x4 rb[4]; \
            _Pragma("unroll") \
            for (int st = 0; st < 4; ++st) { \
                rb[st].x = relu_bf16x2(cvt_pk_bf16(dd[st][0][0], dd[st][0][1])); rb[st].y = relu_bf16x2(cvt_pk_bf16(dd[st][0][2], dd[st][0][3])); \
                rb[st].z = relu_bf16x2(cvt_pk_bf16(dd[st][1][0], dd[st][1][1])); rb[st].w = relu_bf16x2(cvt_pk_bf16(dd[st][1][2], dd[st][1][3])); } \
            IDX_SB \
            f32x4 sc[4]; \
            _Pragma("unroll") \
            for (int st = 0; st < 4; ++st) sc[st] = __builtin_amdgcn_mfma_f32_16x16x32_bf16(wa, __builtin_bit_cast(bf16x8, rb[st]), (f32x4){0.f, 0.f, 0.f, 0.f}, 0, 0, 0); \
            IDX_SB \
            if (kt_ == klast) { \
                _Pragma("unroll") \
                for (int st = 0; st < 4; ++st) { \
                    const int s = kt_ * 64 + st * 16 + fr; \
                    float v0 = sc[st][0], v1 = sc[st][1]; \
                    if (s > pw) v0 = -__builtin_inff(); \
                    if (s > pw + 1) v1 = -__builtin_inff(); \
                    if (fq == 0) { scl[s] = v0; scl[2048 + s] = v1; } \
                } \
            } else { \
                _Pragma("unroll") \
                for (int st = 0; st < 4; ++st) if (fq == 0) { scl[kt_ * 64 + st * 16 + fr] = sc[st][0]; scl[2048 + kt_ * 64 + st * 16 + fr] = sc[st][1]; } \
            } \
            if (kt_ + 1 < nkt) *(u32x4*)(ktl + ((kt_ + 1) & 1) * IDX_KT_BYTES + krow * 144 + kch * 16) = KRN; \
            KRN = IDX_LD(kt_ + 5); \
            __syncthreads(); }
        for (int kt = 0; kt < nkt; kt += 4) {
            IDX_TILE(kt, kr1)
            if (kt + 1 >= nkt) break;
            IDX_TILE(kt + 1, kr2)
            if (kt + 2 >= nkt) break;
            IDX_TILE(kt + 2, kr3)
            if (kt + 3 >= nkt) break;
            IDX_TILE(kt + 3, kr0)
        }
#undef IDX_TILE
#undef IDX_LD
        const int kbmax = klast;
#pragma unroll
        for (int tk = 0; tk < 2; ++tk) {
            const int p = pw + tk;
            unsigned u[32];
#pragma unroll
            for (int kb = 0; kb < 32; ++kb) u[kb] = (kb <= kbmax) ? f2sort(scl[tk * 2048 + kb * 64 + lane]) : 0u;
            unsigned thr = 0x00800000u;
            if (p + 1 > 256) {
                unsigned t = 0u;
                for (int bit = 31; bit >= 0; --bit) {
                    const unsigned cand = t | (1u << bit);
                    int n = 0;
#pragma unroll
                    for (int g8 = 0; g8 < 4; ++g8) {
                        if (g8 * 8 <= kbmax) {
#pragma unroll
                            for (int h4 = 0; h4 < 2; ++h4) {
                                unsigned long long m[4];
#pragma unroll
                                for (int kk = 0; kk < 4; ++kk) m[kk] = __ballot(u[g8 * 8 + h4 * 4 + kk] >= cand);
                                IDX_SB
#pragma unroll
                                for (int kk = 0; kk < 4; ++kk) n += __builtin_popcountll(m[kk]);
                                IDX_SB
                            }
                        }
                    }
                    if (n >= 256) t = cand;
                    if (n == 256) break;
                }
                thr = t;
            }
            int word = 0;
#define IDX_W(kb) { const unsigned long long bm = __ballot(u[kb] >= thr); const int lo_ = (int)(unsigned)bm, hi_ = (int)(unsigned)(bm >> 32); WRLANE2(word, lo_, hi_, (kb) * 2); }
            IDX_W(0) IDX_W(1) IDX_W(2) IDX_W(3) IDX_W(4) IDX_W(5) IDX_W(6) IDX_W(7) IDX_W(8) IDX_W(9) IDX_W(10) IDX_W(11) IDX_W(12) IDX_W(13) IDX_W(14) IDX_W(15)
            IDX_W(16) IDX_W(17) IDX_W(18) IDX_W(19) IDX_W(20) IDX_W(21) IDX_W(22) IDX_W(23) IDX_W(24) IDX_W(25) IDX_W(26) IDX_W(27) IDX_W(28) IDX_W(29) IDX_W(30) IDX_W(31)
#undef IDX_W
            MASK[(t0 + tk) * 64 + lane] = (unsigned)word;
        }
#undef IDX_SB
    }
    __syncthreads();
}

__device__ __forceinline__ void attn_phase(int wv, const unsigned char* proj, const unsigned* __restrict__ MASK, const float* __restrict__ q_norm, const float* __restrict__ k_norm, const float* __restrict__ rel_bias,
                           bf16_t* __restrict__ AO, unsigned char* lds) {
    const int tid = tid_fresh(wv), lane = tid & 63, w = wv  , fr = lane & 15, fq = lane >> 4;
    int vz = 0; asm volatile("" : "+v"(vz));
    const bf16_t* Q1 = (const bf16_t*)(proj + PJ_Q1); const bf16_t* Kn = (const bf16_t*)(proj + PJ_KN); const bf16_t* VT = (const bf16_t*)(proj + PJ_VT1);
    constexpr int ATT_BUF = 17408 + 18432;
    bf16_t* K_lds = (bf16_t*)lds;
    bf16_t* V_lds = (bf16_t*)(lds + 17408);
    float* bt = (float*)(lds + 2 * ATT_BUF);
    const float LOG2E = 1.4426950408889634f;
    float mq = 0.f, mk = 0.f;
    for (int i = 0; i < 128; ++i) { mq = fmaxf(mq, fabsf(q_norm[i])); mk = fmaxf(mk, fabsf(k_norm[i])); }
    const float Mb2 = 11.313708499f * mq * mk * LOG2E;
    __syncthreads();
    for (int i = tid; i < 128 * 16; i += NT) {
        const int d = i >> 4, h = i & 15;
        int bk = d;
        if (d >= 16) { bk = 16 + (int)(logf((float)d / 16.0f) / 2.0794415416798357f * 16.0f); bk = bk > 31 ? 31 : bk; }
        bt[i] = (rel_bias[bk * 16 + h] - rel_bias[31 * 16 + h]) * LOG2E;
    }
    __syncthreads();
    const int nunits = NB * 128;
    for (int uu = blockIdx.x; uu < nunits; uu += gridDim.x) {
        int b, q16;
        if (gridDim.x == 256) { b = blockIdx.x >> 4; const int r = blockIdx.x & 15, k = (uu - blockIdx.x) / 256; q16 = (k & 1) ? (k >> 1) * 32 + 31 - r : (k >> 1) * 32 + r; }
        else { b = uu >> 7; q16 = uu & 127; }
        const int p0 = q16 * 16;
        const size_t tb = (size_t)b * NS;
        v8i qf[2];
#pragma unroll
        for (int tk = 0; tk < 2; ++tk) {
            const size_t t = tb + p0 + 2 * w + tk;
            float f[32]; float ss = 0.f;
#pragma unroll
            for (int i = 0; i < 2; ++i) {
                const u32x4 v = *(const u32x4*)((const unsigned char*)Q1 + t * 2048 + fr * 128 + fq * 32 + i * 16);
                const int wds[4] = {(int)v.x, (int)v.y, (int)v.z, (int)v.w};
#pragma unroll
                for (int q4 = 0; q4 < 4; ++q4) {
                    f[i * 16 + q4 * 4 + 0] = __builtin_amdgcn_cvt_f32_fp8(wds[q4], 0); f[i * 16 + q4 * 4 + 1] = __builtin_amdgcn_cvt_f32_fp8(wds[q4], 1);
                    f[i * 16 + q4 * 4 + 2] = __builtin_amdgcn_cvt_f32_fp8(wds[q4], 2); f[i * 16 + q4 * 4 + 3] = __builtin_amdgcn_cvt_f32_fp8(wds[q4], 3);
                }
            }
#pragma unroll
            for (int i = 0; i < 32; ++i) ss += f[i] * f[i];
            ss += shx(ss, 16, lane); ss += shx(ss, 32, lane);
            const float rs = rsqrtf(ss * (1.0f / (128.0f * Q8_SCALE * Q8_SCALE)) + RMS_EPS) * (0.08838834764831845f * LOG2E * ATT_QS / Q8_SCALE);
            const float* qn = q_norm + fq * 32;
#pragma unroll
            for (int i = 0; i < 8; ++i) qf[tk][i] = (int)pack_fp8x4(f[i * 4 + 0] * rs * qn[i * 4 + 0], f[i * 4 + 1] * rs * qn[i * 4 + 1], f[i * 4 + 2] * rs * qn[i * 4 + 2], f[i * 4 + 3] * rs * qn[i * 4 + 3]);
        }
        f32x4 oacc[2][8];
#pragma unroll
        for (int tk = 0; tk < 2; ++tk)
#pragma unroll
            for (int dt = 0; dt < 8; ++dt) oacc[tk][dt] = (f32x4){0.f, 0.f, 0.f, 0.f};
        float lsum[2] = {0.f, 0.f};
        const int nkt = (p0 >> 6) + 1;
        const int kr0 = tid >> 3, kc0 = tid & 7, vr0 = tid >> 4, vc0 = tid & 15;
        const unsigned char* kgp = (const unsigned char*)Kn + (tb + kr0) * 128 + kc0 * 16;
        const bf16_t* vgp = VT + (tb + vr0) * 128 + vc0 * 8;
        const unsigned* mp0 = MASK + (tb + p0 + 2 * w) * 64 + vz;
        u32x4 kreg, vreg[2]; unsigned mreg[2][2];
        kreg = *(const u32x4*)(kgp);
        vreg[0] = *(const u32x4*)(vgp); vreg[1] = *(const u32x4*)(vgp + 32 * 128);
        mreg[0][0] = mp0[0]; mreg[0][1] = mp0[1]; mreg[1][0] = mp0[64]; mreg[1][1] = mp0[65];
        __syncthreads();
        *(u32x4*)((unsigned char*)K_lds + kr0 * 144 + kc0 * 16) = kreg;
        *(u32x4*)(V_lds + vr0 * 144 + vc0 * 8) = vreg[0]; *(u32x4*)(V_lds + (vr0 + 32) * 144 + vc0 * 8) = vreg[1];
        __syncthreads();
        for (int kt = 0; kt < nkt; ++kt) {
            const int s0 = kt * 64;
            const bf16_t* Kc = K_lds + (kt & 1) * (ATT_BUF / 2); const bf16_t* Vc = V_lds + (kt & 1) * (ATT_BUF / 2);
            const unsigned m00 = mreg[0][0], m01 = mreg[0][1], m10 = mreg[1][0], m11 = mreg[1][1];
            if (kt + 1 < nkt) {
                kreg = *(const u32x4*)(kgp + (size_t)(s0 + 64) * 128);
                vreg[0] = *(const u32x4*)(vgp + (size_t)(s0 + 64) * 128); vreg[1] = *(const u32x4*)(vgp + (size_t)(s0 + 64 + 32) * 128);
                mreg[0][0] = mp0[2 * kt + 2]; mreg[0][1] = mp0[2 * kt + 3]; mreg[1][0] = mp0[64 + 2 * kt + 2]; mreg[1][1] = mp0[64 + 2 * kt + 3];
            }
            const bool use_bias = (s0 + 63 + 128 > p0);
            f32x4 dA[2], dB[2]; unsigned pk[4][2][2];
            auto s_sub = [&](int sub, f32x4 (&d)[2]) {
                const unsigned char* kp = (const unsigned char*)Kc + (sub * 16 + fr) * 144 + fq * 32;
                const i32x4 klo = *(const i32x4*)kp, khi = *(const i32x4*)(kp + 16);
                const v8i kf = __builtin_shufflevector(klo, khi, 0, 1, 2, 3, 4, 5, 6, 7);
#pragma unroll
                for (int tk = 0; tk < 2; ++tk) {
                    d[tk] = (f32x4){-Mb2 * (ATT_QS * ATT_KS), -Mb2 * (ATT_QS * ATT_KS), -Mb2 * (ATT_QS * ATT_KS), -Mb2 * (ATT_QS * ATT_KS)};
                    d[tk] = __builtin_amdgcn_mfma_scale_f32_16x16x128_f8f6f4(kf, qf[tk], d[tk], 0, 0, 0, 0, 0, 0);
                }
            };
            auto soft = [&](int sub, const f32x4 (&d)[2]) {
#pragma unroll
                for (int tk = 0; tk < 2; ++tk) {
                    const int p = p0 + 2 * w + tk;
                    const unsigned mw = (sub < 2) ? (tk ? m10 : m00) : (tk ? m11 : m01);
                    const unsigned nib = (mw >> ((sub & 1) * 16 + fq * 4)) & 15u;
                    float pv[4];
                    f32x4 xx = d[tk] * (1.0f / (ATT_QS * ATT_KS));
                    if (use_bias) {
#pragma unroll
                        for (int j = 0; j < 4; ++j) { const int dd = p - (s0 + sub * 16 + fq * 4 + j); if (dd >= 0 && dd < 128) xx[j] += bt[dd * 16 + fr]; }
                    }
#pragma unroll
                    for (int j = 0; j < 4; ++j) {
                        const float x = xx[j];
                        float e = __builtin_amdgcn_exp2f(x);
                        e = ((nib >> j) & 1u) ? e : 0.f;
                        lsum[tk] += e; pv[j] = e;
                    }
                    pk[sub][tk][0] = cvt_pk_bf16(pv[0], pv[1]); pk[sub][tk][1] = cvt_pk_bf16(pv[2], pv[3]);
                }
            };
            auto pv_pair = [&](int kk) {
                bf16x8 pfr[2];
#pragma unroll
                for (int tk = 0; tk < 2; ++tk) { u32x4 a0; a0.x = pk[2 * kk][tk][0]; a0.y = pk[2 * kk][tk][1]; a0.z = pk[2 * kk + 1][tk][0]; a0.w = pk[2 * kk + 1][tk][1]; pfr[tk] = __builtin_bit_cast(bf16x8, a0); }
#pragma unroll
                for (int dt = 0; dt < 8; ++dt) {
                    const bf16_t* vp = Vc + ((2 * kk) * 16 + fq * 4 + (fr >> 2)) * 144 + dt * 16 + (fr & 3) * 4;
                    const s16x4_t va = __builtin_amdgcn_ds_read_tr16_b64_v4i16((__attribute__((address_space(3))) s16x4_t*)(vp));
                    const s16x4_t vb = __builtin_amdgcn_ds_read_tr16_b64_v4i16((__attribute__((address_space(3))) s16x4_t*)(vp + 16 * 144));
                    const bf16x8 vf = __builtin_bit_cast(bf16x8, __builtin_shufflevector(va, vb, 0, 1, 2, 3, 4, 5, 6, 7));
#pragma unroll
                    for (int tk = 0; tk < 2; ++tk) oacc[tk][dt] = __builtin_amdgcn_mfma_f32_16x16x32_bf16(vf, pfr[tk], oacc[tk][dt], 0, 0, 0);
                }
            };
            s_sub(0, dA);
            __builtin_amdgcn_sched_barrier(0);
            s_sub(1, dB); soft(0, dA);
            __builtin_amdgcn_sched_barrier(0);
            s_sub(2, dA); soft(1, dB); pv_pair(0);
            __builtin_amdgcn_sched_barrier(0);
            s_sub(3, dB); soft(2, dA);
            __builtin_amdgcn_sched_barrier(0);
            soft(3, dB); pv_pair(1);
            __builtin_amdgcn_sched_barrier(0);
            if (kt + 1 < nkt) {
                bf16_t* Kn_ = K_lds + ((kt + 1) & 1) * (ATT_BUF / 2); bf16_t* Vn_ = V_lds + ((kt + 1) & 1) * (ATT_BUF / 2);
                *(u32x4*)((unsigned char*)Kn_ + kr0 * 144 + kc0 * 16) = kreg;
                *(u32x4*)(Vn_ + vr0 * 144 + vc0 * 8) = vreg[0]; *(u32x4*)(Vn_ + (vr0 + 32) * 144 + vc0 * 8) = vreg[1];
            }
            __syncthreads();
        }
#pragma unroll
        for (int tk = 0; tk < 2; ++tk) {
            float l = lsum[tk];
            l += shx(l, 16, lane); l += shx(l, 32, lane);
            const float il = 1.0f / l;
            const size_t ob = (tb + p0 + 2 * w + tk) * 2048 + fr * 128 + fq * 4;
#pragma unroll
            for (int dt = 0; dt < 8; ++dt) {
                const f32x4 o = oacc[tk][dt] * il;
                if (F8_L1) *(unsigned*)((unsigned char*)AO + ob + dt * 16) = pack_fp8x4(o[0] * Y8_SCALE, o[1] * Y8_SCALE, o[2] * Y8_SCALE, o[3] * Y8_SCALE);
                else st_bf16x4(AO + ob + dt * 16, o);
            }
        }
    }
    __syncthreads();
}

#ifndef DUPMASK
#define DUPMASK 0
#endif
#define REPS(k) (((DUPMASK >> (k)) & 1) ? 2 : 1)

__device__ __forceinline__ unsigned char* opq(unsigned char* p) { asm volatile("" : "+s"(p)); return p; }

__global__ void __launch_bounds__(NT, 2) fwd(Args a_unused) {
    extern __shared__ __attribute__((aligned(16))) unsigned char lds[];
    volatile LAS unsigned* misc = (volatile LAS unsigned*)(lds + LDS_MISC);
    const int wv = __builtin_amdgcn_readfirstlane((int)(threadIdx.x >> 6));
    { const int t0 = tid_fresh(wv); if (t0 < 4) misc[t0] = 0u; }
    __syncthreads();
    XcdBarrier bar = xcd_barrier_post((unsigned*)(KA().ws() + WS_CTL), misc, wv);
    const int G = gridDim.x, bx = blockIdx.x;

    for (int rep = 0; rep < REPS(0); ++rep) { p0_prologue(wv, lds); xcd_barrier(bar); }

    for (int rep = 0; rep < REPS(1); ++rep) {
        const KA a; unsigned char* ws = a.ws();
        norm_phase<false, false, F8_P2, false, F8_P2_MIX>(wv, a.in(I_X), nullptr, a.in(I_NORM_MIX), (const float*)(ws + WS_MOD) + 0 * 16 * 6144, (bf16_t*)(ws + WS_H), lds, nullptr, nullptr, nullptr, nullptr, nullptr);
        xcd_barrier(bar);
    }
    for (int rep = 0; rep < REPS(2); ++rep) {
        const KA a; unsigned char* ws = a.ws();
        const int nM = NTOK / BM, nN = N_IN0 / BM;
        for (int k = 0, u = unit_index(0); u < nM * nN; u = unit_index(++k)) {
            int pm, pn; dense_tile(u, nN, pm, pn);
            RowPlain ro{(unsigned)(pm * BM) * ND, (unsigned)ND};
            const bool t8 = F8_P2 || (((unsigned)F8_P2_TILES >> pn) & 1u) != 0u;
            EpiIn0 E{ws + WS_PROJ, (const float2*)(ws + WS_ROT), pm, pn, (LAS bf16_t*)lds, wv, t8 ? 1.0f / W8_SCALE : 1.0f};
            if (t8) { RowPlain r8{(unsigned)(pm * BM) * (ND / 2), (unsigned)(ND / 2)};
                      gemm_unit<true>(wv, (bf16_t*)lds, (const bf16_t*)(F8_P2 ? ws + WS_H : ws + WS_H8), r8, (const bf16_t*)(ws + WS_WIN0F8 + (size_t)pn * BM * ND), ND / 2, ND / 2, E); }
            else gemm_unit<false>(wv, (bf16_t*)lds, (const bf16_t*)(ws + WS_H), ro, (const bf16_t*)(ws + WS_WIN0) + (size_t)pn * BM * ND, ND, ND, E);
        }
        xcd_barrier(bar);
    }
    for (int rep = 0; rep < REPS(3); ++rep) { const KA a; unsigned char* ws = a.ws(); retention_phase(wv, ws + WS_PROJ, (bf16_t*)(ws + WS_O), lds); xcd_barrier(bar); }
    for (int rep = 0; rep < REPS(4); ++rep) { const KA a; unsigned char* ws = a.ws(); ycat_phase(wv, ws + WS_PROJ, (const bf16_t*)(ws + WS_O), a.in(I_CONVW), a.in(I_CONVB), (bf16_t*)(ws + WS_H)); xcd_barrier(bar); }
    for (int rep = 0; rep < REPS(5); ++rep) {
        const KA a; unsigned char* ws = a.ws();
        const int nM = NTOK / BM, nN = ND / BM;
        for (int k = 0, u = unit_index(0); u < nM * nN; u = unit_index(++k)) {
            int pm, pn; dense_tile(u, nN, pm, pn);
            RowPlain ro{(unsigned)(pm * BM) * ND, (unsigned)ND};
            EpiRes<false, true> E{a.in(I_X), nullptr, (bf16_t*)(ws + WS_XB), (const float*)(ws + WS_MOD) + 0 * 16 * 6144 + 4096, pm, pn, (LAS float*)lds, (float*)(ws + WS_SSP), wv, F8_P5 ? 1.0f / (W8_SCALE * Y8_SCALE) : 1.0f};
            if (F8_P5) { RowPlain r8{(unsigned)(pm * BM) * (ND / 2), (unsigned)(ND / 2)}; gemm_unit<true>(wv, (bf16_t*)lds, (const bf16_t*)(ws + WS_H), r8, (const bf16_t*)(ws + WS_WOUT0 + (size_t)pn * BM * ND), ND / 2, ND / 2, E); }
            else gemm_unit<false>(wv, (bf16_t*)lds, (const bf16_t*)(ws + WS_H), ro, (const bf16_t*)(ws + WS_WOUT0) + (size_t)pn * BM * ND, ND, ND, E);
        }
        xcd_barrier(bar);
    }
    {
        const KA a; unsigned char* ws = a.ws();
        route_phase(wv, (const bf16_t*)(ws + WS_XB), a.in(I_NORM_FFN), (const float*)(ws + WS_MOD) + 1 * 16 * 6144, ws + WS_H, lds, a.in(I_WR), a.in(I_BR), (unsigned*)(ws + WS_CTL + CTL_CNT + 0 * 4096), (int*)(ws + WS_IDX), (float*)(ws + WS_GT), (const float*)(ws + WS_SSP));
        xcd_barrier(bar);
    }
    for (int rep = 0; rep < REPS(7); ++rep) { moe_phase1(wv, KA().ws(), 0, lds); xcd_barrier(bar); }
    { moe_phase2(wv, KA().ws(), 0, lds); xcd_barrier(bar); }

    for (int rep = 0; rep < REPS(9); ++rep) {
        const KA a; unsigned char* ws = a.ws();
        norm_phase<true, false, F8_L1 != 0, true, false, true>(wv, ws + WS_XB, (const bf16_t*)(ws + WS_TMP), a.in(I_NORM_MIX) + ND, (const float*)(ws + WS_MOD) + 2 * 16 * 6144, (bf16_t*)(ws + WS_H), lds, nullptr, nullptr, nullptr, nullptr, nullptr, (const bf16_t*)(ws + WS_TMP + 64 * MiB), (const float*)(ws + WS_MOD) + 1 * 16 * 6144 + 4096);
        xcd_barrier(bar);
    }
    for (int rep = 0; rep < REPS(10); ++rep) {
        const int nM = NTOK / BM, nN = N_IN1P / BM;
        for (int k = 0, u = unit_index(0); u < nM * nN; u = unit_index(++k)) {
            const KA a; unsigned char* ws = a.ws();
            int pm, pn; dense_tile(u, nN, pm, pn);
            RowPlain ro{(unsigned)(pm * BM) * ND, (unsigned)ND};
            EpiIn1 E{ws + WS_PROJ, pm, pn, F8_L1 ? 1.0f / W8_SCALE : 1.0f};
            if (F8_L1) { RowPlain r8{(unsigned)(pm * BM) * (ND / 2), (unsigned)(ND / 2)}; gemm_unit<true>(wv, (bf16_t*)lds, (const bf16_t*)(ws + WS_H), r8, (const bf16_t*)(ws + WS_WIN1 + (size_t)pn * BM * ND), ND / 2, ND / 2, E); }
            else gemm_unit<false>(wv, (bf16_t*)lds, (const bf16_t*)(ws + WS_H), ro, (const bf16_t*)(ws + WS_WIN1) + (size_t)pn * BM * ND, ND, ND, E);
        }
        xcd_barrier(bar);
    }
    for (int rep = 0; rep < REPS(11); ++rep) {
        const KA a; unsigned char* ws = a.ws();
        knorm_phase(wv, ws + WS_PROJ, a.in(I_KN), (bf16_t*)(ws + WS_PROJ + PJ_KN));
        indexer_phase(wv, ws + WS_PROJ, (unsigned*)(ws + WS_MASK), lds);
        xcd_barrier(bar);
    }
    for (int rep = 0; rep < REPS(12); ++rep) { const KA a; unsigned char* ws = a.ws(); attn_phase(wv, ws + WS_PROJ, (const unsigned*)(ws + WS_MASK), a.in(I_QN), a.in(I_KN), a.in(I_RELB), (bf16_t*)(ws + WS_H), lds); xcd_barrier(bar); }
    {
        const KA a; unsigned char* ws = a.ws();
        const int nM = NTOK / BM, nN = ND / BM;
        for (int k = 0, u = unit_index(0); u < nM * nN; u = unit_index(++k)) {
            int pm, pn; dense_tile(u, nN, pm, pn);
            RowPlain ro{(unsigned)(pm * BM) * ND, (unsigned)ND};
            EpiRes<false, false> E{ws + WS_XB, nullptr, (bf16_t*)(ws + WS_XB), (const float*)(ws + WS_MOD) + 2 * 16 * 6144 + 4096, pm, pn, (LAS float*)lds, (float*)(ws + WS_SSP), wv, F8_L1 ? 1.0f / (W8_SCALE * Y8_SCALE) : 1.0f};
            if (F8_L1) { RowPlain r8{(unsigned)(pm * BM) * (ND / 2), (unsigned)(ND / 2)}; gemm_unit<true>(wv, (bf16_t*)lds, (const bf16_t*)(ws + WS_H), r8, (const bf16_t*)(ws + WS_WOUT1 + (size_t)pn * BM * ND), ND / 2, ND / 2, E); }
            else gemm_unit<false>(wv, (bf16_t*)lds, (const bf16_t*)(ws + WS_H), ro, (const bf16_t*)(ws + WS_WOUT1) + (size_t)pn * BM * ND, ND, ND, E);
        }
        xcd_barrier(bar);
    }
    {
        const KA a; unsigned char* ws = a.ws();
        route_phase(wv, (const bf16_t*)(ws + WS_XB), a.in(I_NORM_FFN) + ND, (const float*)(ws + WS_MOD) + 3 * 16 * 6144, ws + WS_H, lds, a.in(I_WR), a.in(I_BR), (unsigned*)(ws + WS_CTL + CTL_CNT + 1 * 4096), (int*)(ws + WS_IDX), (float*)(ws + WS_GT), (const float*)(ws + WS_SSP));
        xcd_barrier(bar);
    }
    { moe_phase1(wv, KA().ws(), 1, lds); xcd_barrier(bar); }
    { moe_phase2(wv, KA().ws(), 1, lds); xcd_barrier(bar); }
    {
        const KA a; unsigned char* ws = a.ws();
        const bf16_t* tp = (const bf16_t*)(ws + WS_TMP); const bf16_t* xp = (const bf16_t*)(ws + WS_XB); f32x4* op = (f32x4*)a.out();
        const unsigned char* tp8 = (const unsigned char*)tp;
        for (size_t i = (size_t)bx * NT + tid_fresh(wv); i < (size_t)NTOK * ND / 8; i += (size_t)G * NT) {
            const u32x4 xv = *(const u32x4*)(xp + i * 8); const u32x2 tv = *(const u32x2*)(tp8 + i * 8), tw = *(const u32x2*)(tp8 + 64 * MiB + i * 8);
            const float* gp = (const float*)(ws + WS_MOD) + 3 * 16 * 6144 + 4096 + (size_t)((i * 8) >> 22) * 6144 + ((i * 8) & 2047);
            const f32x4 g0 = *(const f32x4*)gp * (1.0f / T8_SCALE), g1 = *(const f32x4*)(gp + 4) * (1.0f / T8_SCALE);
            f32x4 a0, a1;
            a0[0] = bflo(xv.x) + (__builtin_amdgcn_cvt_f32_fp8((int)tv.x, 0) + __builtin_amdgcn_cvt_f32_fp8((int)tw.x, 0)) * g0[0]; a0[1] = bfhi(xv.x) + (__builtin_amdgcn_cvt_f32_fp8((int)tv.x, 1) + __builtin_amdgcn_cvt_f32_fp8((int)tw.x, 1)) * g0[1];
            a0[2] = bflo(xv.y) + (__builtin_amdgcn_cvt_f32_fp8((int)tv.x, 2) + __builtin_amdgcn_cvt_f32_fp8((int)tw.x, 2)) * g0[2]; a0[3] = bfhi(xv.y) + (__builtin_amdgcn_cvt_f32_fp8((int)tv.x, 3) + __builtin_amdgcn_cvt_f32_fp8((int)tw.x, 3)) * g0[3];
            a1[0] = bflo(xv.z) + (__builtin_amdgcn_cvt_f32_fp8((int)tv.y, 0) + __builtin_amdgcn_cvt_f32_fp8((int)tw.y, 0)) * g1[0]; a1[1] = bfhi(xv.z) + (__builtin_amdgcn_cvt_f32_fp8((int)tv.y, 1) + __builtin_amdgcn_cvt_f32_fp8((int)tw.y, 1)) * g1[1];
            a1[2] = bflo(xv.w) + (__builtin_amdgcn_cvt_f32_fp8((int)tv.y, 2) + __builtin_amdgcn_cvt_f32_fp8((int)tw.y, 2)) * g1[2]; a1[3] = bfhi(xv.w) + (__builtin_amdgcn_cvt_f32_fp8((int)tv.y, 3) + __builtin_amdgcn_cvt_f32_fp8((int)tw.y, 3)) * g1[3];
            op[i * 2] = a0; op[i * 2 + 1] = a1;
        }
    }
}

extern "C" void kernel_launch(void* const* d_in, const int* in_sizes, int n_in, void* d_out, int out_size, void* d_ws, size_t ws_size, hipStream_t stream) {
    static int grid = 0;
    if (grid == 0) {
        int dev = 0, cus = 0, per_cu = 0;
        if (n_in != 22 || ws_size < WS_END) { fprintf(stderr, "kernel_launch: unexpected n_in %d / ws_size %zu (need %zu)\n", n_in, ws_size, (size_t)WS_END); grid = -1; return; }
        (void)hipGetDevice(&dev);
        (void)hipDeviceGetAttribute(&cus, hipDeviceAttributeMultiprocessorCount, dev);
        if (hipFuncSetAttribute((const void*)fwd, hipFuncAttributeMaxDynamicSharedMemorySize, LDS_BYTES) != hipSuccess) { fprintf(stderr, "kernel_launch: hipFuncSetAttribute failed\n"); grid = -1; return; }
        (void)hipOccupancyMaxActiveBlocksPerMultiprocessor(&per_cu, (const void*)fwd, NT, LDS_BYTES);
        (void)hipGetLastError();
        if (per_cu < 1) fprintf(stderr, "kernel_launch: occupancy query reports %d\n", per_cu);
        grid = cus;
    }
    if (grid < 0) return;
    (void)hipMemsetAsync((char*)d_ws + WS_CTL, 0, 65536 + 4 * 16 * 6144 * 4, stream);
    Args a{};
    for (int i = 0; i < 22; ++i) a.in[i] = (const float*)d_in[i];
    a.out = (float*)d_out; a.ws = (unsigned char*)d_ws;
    hipLaunchKernelGGL(fwd, dim3(grid), dim3(NT), LDS_BYTES, stream, a);
}
```

```cpp
#include <hip/hip_runtime.h>
#include <stdint.h>
#include <stdio.h>

#define XB_TMO      128
#define XB_XCNT(j)  (256  + 64 * (j))
#define XB_XSUB(j)  (1280 + 64 * (j))
#define XB_XGEN(j)  (2304 + 64 * (j))
#define XB_TOP      3328
#define XB_TOPGEN   3392
#define XCD_BAR_WORDS 3456
#define XB_SPIN_CAP (1u << 18)
#define LAS __attribute__((address_space(3)))
#define GAS __attribute__((address_space(1)))

__device__ __forceinline__ unsigned xb_ld(unsigned* p)              { return __hip_atomic_load(p, __ATOMIC_RELAXED, __HIP_MEMORY_SCOPE_AGENT); }
__device__ __forceinline__ unsigned xb_add(unsigned* p, unsigned v) { return __hip_atomic_fetch_add(p, v, __ATOMIC_RELAXED, __HIP_MEMORY_SCOPE_AGENT); }
__device__ __forceinline__ unsigned xb_xcc_id() { return (unsigned)__builtin_amdgcn_s_getreg((3 << 11) | 20) & 0xFu; }
#define XB_SPIN(cond, bar) do { unsigned _sp = 0; while (cond) { __builtin_amdgcn_s_sleep(1); \
    if ((++_sp & 255u) == 0u) { if (xb_ld(&(bar)[XB_TMO])) break; if (_sp > XB_SPIN_CAP) { atomicAdd(&(bar)[XB_TMO], 1u); break; } } } } while (0)

struct XcdBarrier { unsigned* bar; unsigned x; volatile LAS unsigned* st; int wv; };
__device__ __forceinline__ bool xb_thread0(int wv) { int l; asm volatile("v_mbcnt_lo_u32_b32 %0, -1, 0\n\tv_mbcnt_hi_u32_b32 %0, -1, %0" : "=v"(l)); return wv == 0 && l == 0; }

__device__ __forceinline__ XcdBarrier xcd_barrier_post(unsigned* bar, volatile LAS unsigned* st, int wv) {
    XcdBarrier b; b.bar = bar; b.x = xb_xcc_id(); b.st = st; b.wv = wv;
    if (xb_thread0(wv)) (void)xb_add(&bar[XB_XCNT(b.x)], 1u);
    return b;
}
__device__ __forceinline__ void xcd_barrier_complete(unsigned* bar, unsigned x, unsigned& nloc, unsigned& nx) {
    const unsigned G = gridDim.x * gridDim.y * gridDim.z;
    unsigned sum, cnt, mine, sp = 0u;
    for (;;) {
        sum = 0u; cnt = 0u; mine = 0u;
#pragma unroll
        for (unsigned j = 0; j < 16; ++j) { const unsigned c = xb_ld(&bar[XB_XCNT(j)]); sum += c; cnt += (c > 0u) ? 1u : 0u; mine = (j == x) ? c : mine; }
        if (sum == G) break;
        __builtin_amdgcn_s_sleep(1);
        if ((++sp & 255u) == 0u) { if (xb_ld(&bar[XB_TMO])) break; if (sp > XB_SPIN_CAP) { atomicAdd(&bar[XB_TMO], 1u); break; } }
    }
    nloc = mine > 0u ? mine : 1u; nx = cnt > 0u ? cnt : 1u;
}
__device__ __forceinline__ void xcd_barrier(const XcdBarrier& b) {
    asm volatile("s_waitcnt vmcnt(0)" ::: "memory");
    __syncthreads();
    if (xb_thread0(b.wv)) {
        unsigned* bar = b.bar; asm volatile("" : "+s"(bar));
        __builtin_amdgcn_s_waitcnt(0);
        unsigned nloc = b.st[0], nx = b.st[1];
        if (nloc == 0u) { xcd_barrier_complete(bar, b.x, nloc, nx); b.st[0] = nloc; b.st[1] = nx; }
        const unsigned old = xb_add(&bar[XB_XSUB(b.x)], 1u);
        const unsigned gen = old / nloc;
        if (old + 1u == (gen + 1u) * nloc) {
            __builtin_amdgcn_fence(__ATOMIC_RELEASE, "agent");
            asm volatile("s_waitcnt vmcnt(0)" ::: "memory");
            const unsigned og = xb_add(&bar[XB_TOP], 1u);
            const unsigned tg = og / nx;
            if (og + 1u == (tg + 1u) * nx) xb_add(&bar[XB_TOPGEN], 1u);
            else XB_SPIN(xb_ld(&bar[XB_TOPGEN]) == tg, bar);
            __builtin_amdgcn_fence(__ATOMIC_ACQUIRE, "agent");
            xb_add(&bar[XB_XGEN(b.x)], 1u);
            asm volatile("s_waitcnt vmcnt(0)" ::: "memory");
        } else {
            XB_SPIN(xb_ld(&bar[XB_XGEN(b.x)]) == gen, bar);
            __builtin_amdgcn_fence(__ATOMIC_ACQUIRE, "agent");
            asm volatile("s_waitcnt vmcnt(0)" ::: "memory");
        }
    }
    __syncthreads();
}

typedef unsigned short bf16_t;
typedef short bf16x8 __attribute__((ext_vector_type(8)));
typedef float f32x4 __attribute__((ext_vector_type(4)));
typedef unsigned u32x4 __attribute__((ext_vector_type(4)));
typedef unsigned u32x2 __attribute__((ext_vector_type(2)));

constexpr int NT = 512;
constexpr int NB = 16, NS = 2048, ND = 2048, NTOK = NB * NS;
constexpr int NE = 16, DEXP = 1024;
constexpr int N_IN0 = 7168, N_IN1 = 3408, N_IN1P = 3584;
constexpr float RMS_EPS = 1e-6f;
constexpr int LDS_MISC = 131072 + 2 * 64 * 144;
constexpr int LDS_BYTES = LDS_MISC + 8192;

constexpr size_t MiB = 1024ull * 1024ull;
constexpr size_t WS_CTL   = 0;
constexpr size_t CTL_CNT  = 16384;
constexpr size_t WS_MOD   = 64 * 1024;
constexpr size_t WS_ROT   = WS_MOD + 4ull * 16 * 6144 * 4;
constexpr size_t WS_IDX   = WS_ROT + 2048ull * 128 * 8;
constexpr size_t WS_GT    = WS_IDX + 16ull * 32768 * 4;
constexpr size_t WS_MASK  = WS_GT + 16ull * 32768 * 4;
constexpr size_t WS_WIN0  = 16 * MiB;
constexpr size_t WS_WOUT0 = WS_WIN0 + 28 * MiB;
constexpr size_t WS_WIN1  = WS_WOUT0 + 8 * MiB;
constexpr size_t WS_WOUT1 = WS_WIN1 + 14 * MiB;
constexpr size_t WS_W13   = WS_WOUT1 + 8 * MiB;
constexpr size_t WS_XB    = WS_W13 + 128 * MiB;
constexpr size_t WS_W2    = WS_W13 + 256 * MiB;
constexpr size_t WS_H     = WS_W2 + 128 * MiB;
constexpr size_t WS_O     = WS_H + 128 * MiB;
constexpr size_t WS_TMP   = WS_O + 64 * MiB;
constexpr size_t WS_PROJ  = WS_TMP + 128 * MiB;
constexpr size_t WS_END   = WS_PROJ + 448 * MiB;
constexpr size_t WS_TMP1  = WS_PROJ + 128 * MiB;
constexpr size_t WS_H8    = WS_O;
constexpr size_t WS_WIN0F8 = WS_W2 + 64 * MiB;
constexpr size_t PJ_AB = 0, PJ_U = 64 * MiB, PJ_Q = 128 * MiB, PJ_K = 192 * MiB, PJ_KT = 256 * MiB, PJ_VT = 320 * MiB, PJ_SG = 384 * MiB;
constexpr size_t PJ_Q1 = 0, PJ_QI = 128 * MiB, PJ_KR = 192 * MiB, PJ_VT1 = 200 * MiB, PJ_KI = 208 * MiB, PJ_WI = 212 * MiB, PJ_KN = 216 * MiB;
constexpr size_t PJ_ACT = 0;

struct Args { const float* in[22]; float* out; unsigned char* ws; };
#define CAS __attribute__((address_space(4)))
struct KA {
    const CAS unsigned char* kp;
    __device__ __forceinline__ KA() { kp = (const CAS unsigned char*)__builtin_amdgcn_kernarg_segment_ptr(); asm volatile("" : "+s"(kp)); }
    __device__ __forceinline__ const float* in(int i) const { return *(const float* const CAS*)(kp + 8 * i); }
    __device__ __forceinline__ float* out() const { return *(float* const CAS*)(kp + 8 * 22); }
    __device__ __forceinline__ unsigned char* ws() const { return *(unsigned char* const CAS*)(kp + 8 * 23); }
};
enum { I_X = 0, I_C, I_RELB, I_WR, I_BR, I_NORM_MIX, I_ADAW_MIX, I_ADAB_MIX, I_NORM_FFN, I_ADAW_FFN, I_ADAB_FFN, I_AB_WIN, I_CONVW, I_CONVB, I_AB_WOUT,
       I_C_WIN, I_QN, I_KN, I_C_WOUT, I_W1, I_W3, I_W2 };

typedef __bf16 bf16x2_t __attribute__((ext_vector_type(2)));
__device__ __forceinline__ unsigned cvt_pk_bf16(float lo, float hi) { bf16x2_t v = {(__bf16)lo, (__bf16)hi}; return __builtin_bit_cast(unsigned, v); }
__device__ __forceinline__ float bflo(unsigned u) { return __uint_as_float(u << 16); }
__device__ __forceinline__ float bfhi(unsigned u) { return __uint_as_float(u & 0xffff0000u); }
__device__ __forceinline__ f32x4 ld_bf16x4(const bf16_t* p) { const u32x2 t = *(const GAS u32x2*)p; return (f32x4){bflo(t.x), bfhi(t.x), bflo(t.y), bfhi(t.y)}; }
__device__ __forceinline__ float bf2f(bf16_t h) { return __uint_as_float((unsigned)h << 16); }
__device__ __forceinline__ bf16_t f2bf(float f) { return (bf16_t)(cvt_pk_bf16(f, 0.f) & 0xffffu); }
__device__ __forceinline__ float silu_f(float v) { return v * __builtin_amdgcn_rcpf(1.f + __builtin_amdgcn_exp2f(-1.4426950408889634f * v)); }
__device__ __forceinline__ int tid_fresh(int wv) {
    int l; asm volatile("v_mbcnt_lo_u32_b32 %0, -1, 0\n\tv_mbcnt_hi_u32_b32 %0, -1, %0" : "=v"(l));
    return wv * 64 + l;
}
__device__ __forceinline__ float shx(float v, int o, int lane) { return __int_as_float(__builtin_amdgcn_ds_bpermute((lane ^ o) << 2, __float_as_int(v))); }
__device__ __forceinline__ float shi(float v, int src) { return __int_as_float(__builtin_amdgcn_ds_bpermute(src << 2, __float_as_int(v))); }
__device__ __forceinline__ float wave_sum(float v, int lane) {
#pragma unroll
    for (int o = 32; o >= 1; o >>= 1) v += shx(v, o, lane);
    return v;
}

#ifndef F8_L1
#define F8_L1 1
#endif
#ifndef F8_P2_TILES
#define F8_P2_TILES 0xFFFFFFFu
#endif
#define F8_P2 ((F8_P2_TILES) == 0xFFFFFFFu)
#define F8_P2_MIX ((F8_P2_TILES) != 0u && (F8_P2_TILES) != 0xFFFFFFFu)

#ifndef F8_P5
#define F8_P5 1
#endif
constexpr float Y8_SCALE = 4.0f;
constexpr float W8_SCALE = 64.0f, A8_SCALE = 8.0f;
__device__ __forceinline__ float clamp8(float v) { return fminf(fmaxf(v, -448.0f), 448.0f); }
__device__ __forceinline__ unsigned pack_fp8x4(float a, float b, float c, float d) { int w; asm volatile("" : "=v"(w));     w = __builtin_amdgcn_cvt_pk_fp8_f32(clamp8(a), clamp8(b), w, false); w = __builtin_amdgcn_cvt_pk_fp8_f32(clamp8(c), clamp8(d), w, true); return (unsigned)w; }
template <bool FP8OUT>
__device__ __forceinline__ void tr_tile(int wv, const float* __restrict__ src, int ldn, int N, int k0, int n0, float* tile, bf16_t* dstbase, int ldk, int rowmap_kind) {
    const int tid = tid_fresh(wv);
#pragma unroll
    for (int it = 0; it < 2; ++it) {
        const int i = tid + it * NT, k = i >> 4, q = i & 15, n = n0 + q * 4;
        float4 v = make_float4(0.f, 0.f, 0.f, 0.f);
        if (n < N) v = *(const float4*)(src + (size_t)(k0 + k) * ldn + n);
        float* tp = tile + k * 65 + q * 4;
        tp[0] = v.x; tp[1] = v.y; tp[2] = v.z; tp[3] = v.w;
    }
    __syncthreads();
    {
        const int nl = tid >> 3, kc = tid & 7, n = n0 + nl;
        if (n < N) {
            float f[8];
#pragma unroll
            for (int j = 0; j < 8; ++j) f[j] = tile[(kc * 8 + j) * 65 + nl];
            int row = n;
            if (rowmap_kind == 1) {
                const int s = n >> 10, c = n & 1023;
                if (s == 1) row = 1024 + (c >> 7) * 256 + (c & 127);
                else if (s == 2) row = 1024 + (c >> 7) * 256 + 128 + (c & 127);
            } else if (rowmap_kind == 2) {
                row = (n >> 7) * 256 + (n & 127);
            } else if (rowmap_kind == 3) {
                row = (n >> 7) * 256 + 128 + (n & 127);
            }
            if (FP8OUT) {
                u32x2 o; o.x = pack_fp8x4(f[0] * W8_SCALE, f[1] * W8_SCALE, f[2] * W8_SCALE, f[3] * W8_SCALE); o.y = pack_fp8x4(f[4] * W8_SCALE, f[5] * W8_SCALE, f[6] * W8_SCALE, f[7] * W8_SCALE);
                *(u32x2*)((unsigned char*)dstbase + (size_t)row * ldk + k0 + kc * 8) = o;
            } else {
                u32x4 o; o.x = cvt_pk_bf16(f[0], f[1]); o.y = cvt_pk_bf16(f[2], f[3]); o.z = cvt_pk_bf16(f[4], f[5]); o.w = cvt_pk_bf16(f[6], f[7]);
                *(u32x4*)(dstbase + (size_t)row * ldk + k0 + kc * 8) = o;
            }
        }
    }
    __syncthreads();
}

__device__ __forceinline__ void p0_prologue(int wv, unsigned char* lds) {
    const int tid = tid_fresh(wv), G = gridDim.x, bx = blockIdx.x;
    const KA a; unsigned char* ws = a.ws();
    {
        float2* rot = (float2*)(ws + WS_ROT);
        for (int i = bx * NT + tid; i < 2048 * 128; i += G * NT) {
            const int pos = i >> 7, j = i & 127;
            const float inv = 1.0f / powf(10000.0f, (float)j / 127.0f);
            const float ang = (float)pos * inv;
            float s, c; sincosf(ang, &s, &c);
            rot[i] = make_float2(c, s);
        }
    }
    {
        constexpr int esz = F8_L1 ? 1 : 2;
        u32x4* z = (u32x4*)(ws + WS_WIN1 + (size_t)N_IN1 * 2048 * esz);
        const int n16 = (N_IN1P - N_IN1) * 2048 * esz / 16;
        for (int i = bx * NT + tid; i < n16; i += G * NT) z[i] = (u32x4){0u, 0u, 0u, 0u};
    }
    {
        float* sc = (float*)lds;
        float* red = (float*)(lds + 65536);
        float* mod = (float*)(ws + WS_MOD);
        const int lane = tid & 63, wave = tid >> 6;
        const int q = lane & 15, kg = (lane >> 4) + wave * 4;
        int cur_half = -1;
        for (int item = bx; item < 2 * 4 * 96; item += G) {
            const int half = item / (4 * 96), it2 = item % (4 * 96);
            const int w = it2 / 96, col0 = (it2 % 96) * 64;
            const float* adaw = (w & 1) ? a.in(I_ADAW_FFN) : a.in(I_ADAW_MIX);
            const float* adab = (w & 1) ? a.in(I_ADAB_FFN) : a.in(I_ADAB_MIX);
            const int layer = w >> 1;
            adaw += (size_t)layer * 2048 * 6144; adab += (size_t)layer * 6144;
            if (half != cur_half) {
                __syncthreads();
                for (int i = tid; i < 1024 * 16; i += NT) { const int k = i >> 4, b = i & 15; sc[i] = silu_f(a.in(I_C)[b * 2048 + half * 1024 + k]); }
                cur_half = half;
                __syncthreads();
            }
            float acc[16][4];
#pragma unroll
            for (int b = 0; b < 16; ++b) { acc[b][0] = 0.f; acc[b][1] = 0.f; acc[b][2] = 0.f; acc[b][3] = 0.f; }
            const float* wp = adaw + (size_t)(half * 1024 + kg * 32) * 6144 + col0 + q * 4;
            for (int kk0 = 0; kk0 < 32; kk0 += 4) {
                float4 wv8[4];
#pragma unroll
                for (int j = 0; j < 4; ++j) wv8[j] = *(const float4*)(wp + (size_t)(kk0 + j) * 6144);
#pragma unroll
                for (int j = 0; j < 4; ++j) {
                    const float4* sp = (const float4*)(sc + (kg * 32 + kk0 + j) * 16);
#pragma unroll
                    for (int b4 = 0; b4 < 4; ++b4) {
                        const float4 s4 = sp[b4];
                        const float sv[4] = {s4.x, s4.y, s4.z, s4.w};
#pragma unroll
                        for (int bb = 0; bb < 4; ++bb) {
                            acc[b4 * 4 + bb][0] += sv[bb] * wv8[j].x; acc[b4 * 4 + bb][1] += sv[bb] * wv8[j].y;
                            acc[b4 * 4 + bb][2] += sv[bb] * wv8[j].z; acc[b4 * 4 + bb][3] += sv[bb] * wv8[j].w;
                        }
                    }
                }
            }
#pragma unroll
            for (int b = 0; b < 16; ++b)
#pragma unroll
                for (int j = 0; j < 4; ++j) { float v = acc[b][j]; v += shx(v, 16, lane); v += shx(v, 32, lane); acc[b][j] = v; }
            __syncthreads();
            if (lane < 16) {
#pragma unroll
                for (int b = 0; b < 16; ++b) *(float4*)(red + (wave * 16 + b) * 64 + q * 4) = make_float4(acc[b][0], acc[b][1], acc[b][2], acc[b][3]);
            }
            __syncthreads();
            for (int i = tid; i < 1024; i += NT) {
                const int b = i >> 6, cidx = i & 63;
                float sm = (half == 0) ? adab[col0 + cidx] : 0.f;
#pragma unroll
                for (int wvi = 0; wvi < 8; ++wvi) sm += red[(wvi * 16 + b) * 64 + cidx];
                atomicAdd(mod + ((size_t)w * 16 + b) * 6144 + col0 + cidx, sm);
            }
        }
        __syncthreads();
    }
    {
        constexpr int T0 = 16 * 56, T1 = T0 + 256, T2 = T1 + 16 * 27, T3 = T2 + 256, T4 = T3 + 4096, T5 = T4 + 4096, T6 = T5 + 4096;
        struct TD { const float* src; unsigned char* dst; int ldn, N, k0, n0, ldk, kind, f8; };
        auto decode = [&](int t) {
            TD d;
            if (t < T0) { const int kt = t / 56, nt = t % 56;
                const int n = nt * 128, sct = n >> 10, c = n & 1023; const int row = (sct == 0) ? c : (sct == 1) ? 1024 + (c >> 7) * 256 + (c & 127) : (sct == 2) ? 1024 + (c >> 7) * 256 + 128 + (c & 127) : n;
                const int f8 = (int)(((unsigned)F8_P2_TILES >> (row >> 8)) & 1u);
                d = TD{a.in(I_AB_WIN), f8 ? ws + WS_WIN0F8 : ws + WS_WIN0, 7168, 7168, kt * 128, nt * 128, 2048, 1, f8}; }
            else if (t < T1) { const int u = t - T0, kt = u / 16, nt = u % 16; d = TD{a.in(I_AB_WOUT), ws + WS_WOUT0, 2048, 2048, kt * 128, nt * 128, 2048, 0, F8_P5}; }
            else if (t < T2) { const int u = t - T1, kt = u / 27, nt = u % 27; d = TD{a.in(I_C_WIN), ws + WS_WIN1, N_IN1, N_IN1, kt * 128, nt * 128, 2048, 0, F8_L1}; }
            else if (t < T3) { const int u = t - T2, kt = u / 16, nt = u % 16; d = TD{a.in(I_C_WOUT), ws + WS_WOUT1, 2048, 2048, kt * 128, nt * 128, 2048, 0, F8_L1}; }
            else if (t < T5) { const bool is3 = t >= T4; const int u = t - (is3 ? T4 : T3), mat = u / 128, v = u % 128, kt = v / 8, nt = v % 8;
                d = TD{(is3 ? a.in(I_W3) : a.in(I_W1)) + (size_t)mat * 2048 * 1024, ws + WS_W13 + (size_t)mat * 2048 * 2048, 1024, 1024, kt * 128, nt * 128, 2048, is3 ? 3 : 2, 1}; }
            else { const int u = t - T5, mat = u / 128, v = u % 128, kt = v / 16, nt = v % 16;
                d = TD{a.in(I_W2) + (size_t)mat * 1024 * 2048, ws + WS_W2 + (size_t)mat * 2048 * 1024, 2048, 2048, kt * 128, nt * 128, 1024, 0, 1}; }
            return d;
        };
        auto load8 = [&](const TD& d, float4 (&v)[8]) {
#pragma unroll
            for (int it = 0; it < 8; ++it) {
                const int i = tid + it * NT, k = i >> 5, q = i & 31, n = d.n0 + q * 4;
                v[it] = (n < d.N) ? *(const float4*)(d.src + (size_t)(d.k0 + k) * d.ldn + n) : make_float4(0.f, 0.f, 0.f, 0.f);
            }
        };
        float4 cur[8], nx1[8], nx2[8];
        int t = bx, buf = 0;
        TD d = decode(t < T6 ? t : 0), d1 = decode(t + G < T6 ? t + G : 0);
        if (t < T6) load8(d, cur);
        if (t + G < T6) load8(d1, nx1);
        __syncthreads();
        for (; t < T6; t += G) {
            float* tile = (float*)lds + buf * (128 * 129);
#pragma unroll
            for (int it = 0; it < 8; ++it) {
                const int i = tid + it * NT, k = i >> 5, q = i & 31;
                float* tp = tile + k * 129 + q * 4;
                tp[0] = cur[it].x; tp[1] = cur[it].y; tp[2] = cur[it].z; tp[3] = cur[it].w;
            }
            const TD d2 = decode(t + 2 * G < T6 ? t + 2 * G : t);
            if (t + 2 * G < T6) load8(d2, nx2);
            __syncthreads();
#pragma unroll
            for (int rep = 0; rep < 2; ++rep) {
                const int item = tid + rep * NT, nl = item >> 3, kc = item & 7, n = d.n0 + nl;
                if (n < d.N) {
                    float f[16];
#pragma unroll
                    for (int j = 0; j < 16; ++j) f[j] = tile[(kc * 16 + j) * 129 + nl];
                    int row = n;
                    if (d.kind == 1) { const int sct = n >> 10, c = n & 1023; if (sct == 1) row = 1024 + (c >> 7) * 256 + (c & 127); else if (sct == 2) row = 1024 + (c >> 7) * 256 + 128 + (c & 127); }
                    else if (d.kind == 2) row = (n >> 7) * 256 + (n & 127);
                    else if (d.kind == 3) row = (n >> 7) * 256 + 128 + (n & 127);
                    if (d.f8) {
                        u32x4 o;
                        o.x = pack_fp8x4(f[0] * W8_SCALE, f[1] * W8_SCALE, f[2] * W8_SCALE, f[3] * W8_SCALE); o.y = pack_fp8x4(f[4] * W8_SCALE, f[5] * W8_SCALE, f[6] * W8_SCALE, f[7] * W8_SCALE);
                        o.z = pack_fp8x4(f[8] * W8_SCALE, f[9] * W8_SCALE, f[10] * W8_SCALE, f[11] * W8_SCALE); o.w = pack_fp8x4(f[12] * W8_SCALE, f[13] * W8_SCALE, f[14] * W8_SCALE, f[15] * W8_SCALE);
                        *(u32x4*)(d.dst + (size_t)row * d.ldk + d.k0 + kc * 16) = o;
                    } else {
                        u32x4 o0, o1;
                        o0.x = cvt_pk_bf16(f[0], f[1]); o0.y = cvt_pk_bf16(f[2], f[3]); o0.z = cvt_pk_bf16(f[4], f[5]); o0.w = cvt_pk_bf16(f[6], f[7]);
                        o1.x = cvt_pk_bf16(f[8], f[9]); o1.y = cvt_pk_bf16(f[10], f[11]); o1.z = cvt_pk_bf16(f[12], f[13]); o1.w = cvt_pk_bf16(f[14], f[15]);
                        u32x4* op = (u32x4*)(d.dst + ((size_t)row * d.ldk + d.k0 + kc * 16) * 2);
                        op[0] = o0; op[1] = o1;
                    }
                }
            }
            d = d1; d1 = d2;
#pragma unroll
            for (int it = 0; it < 8; ++it) { cur[it] = nx1[it]; nx1[it] = nx2[it]; }
            buf ^= 1;
        }
        __syncthreads();
    }
}

template <bool ADD_TMP, bool ROUTE, bool OUT8, bool XBF, bool DUAL = false, bool WB = false>
__device__ __forceinline__ void norm_phase(int wv, const void* xsrc_, const bf16_t* __restrict__ tmp, const float* __restrict__ normw, const float* __restrict__ mod  ,
                           bf16_t* __restrict__ H, unsigned char* lds, const float* __restrict__ w_router, const float* __restrict__ b_router,
                           unsigned* __restrict__ cnt  , int* __restrict__ idx, float* __restrict__ gts, const bf16_t* __restrict__ tmp2 = nullptr, const float* __restrict__ gatev = nullptr  ) {
    const int tid = tid_fresh(wv), lane = tid & 63, wave = tid >> 6;
    float* wr_lds = (float*)lds;
    int* rt_e = (int*)(lds + 131072 + 64);
    (void)rt_e;
    if (ROUTE) {
        for (int i = tid; i < 2048 * 16; i += NT) { const int k = i >> 4, e = i & 15; wr_lds[e * 2048 + k] = w_router[i]; }
        __syncthreads();
    }
    float br[16];
    if (ROUTE) {
#pragma unroll
        for (int e = 0; e < 16; ++e) br[e] = b_router[e];
    }
    const int rows_per_block = NTOK / (int)gridDim.x;
    const int rows_per_wave = rows_per_block / 8;
    const int row0 = blockIdx.x * rows_per_block + wave * rows_per_wave;
    const int b = row0 / NS;
    float g[32], sh[32];
#pragma unroll
    for (int i = 0; i < 8; ++i) {
        const int c = i * 256 + lane * 4;
        const float4 nw = *(const float4*)(normw + c);
        const float4 s4 = *(const float4*)(mod + (size_t)b * 6144 + c);
        const float4 c4 = *(const float4*)(mod + (size_t)b * 6144 + 2048 + c);
        g[i * 4 + 0] = nw.x * (1.f + c4.x); g[i * 4 + 1] = nw.y * (1.f + c4.y); g[i * 4 + 2] = nw.z * (1.f + c4.z); g[i * 4 + 3] = nw.w * (1.f + c4.w);
        sh[i * 4 + 0] = s4.x; sh[i * 4 + 1] = s4.y; sh[i * 4 + 2] = s4.z; sh[i * 4 + 3] = s4.w;
    }
    float gt[32];
    if (WB) {
#pragma unroll
        for (int i = 0; i < 8; ++i) { const float4 g4 = *(const float4*)(gatev + (size_t)b * 6144 + i * 256 + lane * 4); gt[i * 4 + 0] = g4.x * (1.0f / 16.0f); gt[i * 4 + 1] = g4.y * (1.0f / 16.0f); gt[i * 4 + 2] = g4.z * (1.0f / 16.0f); gt[i * 4 + 3] = g4.w * (1.0f / 16.0f); }
    }
    for (int r = 0; r < rows_per_wave; ++r) {
        const int t = row0 + r;
        float v[32];
        float ss = 0.f;
#pragma unroll
        for (int i = 0; i < 8; ++i) {
            const int c = i * 256 + lane * 4;
            float4 x4;
            if (XBF) { const f32x4 xb = ld_bf16x4((const bf16_t*)xsrc_ + (size_t)t * ND + c); x4 = make_float4(xb[0], xb[1], xb[2], xb[3]); }
            else x4 = *(const float4*)((const float*)xsrc_ + (size_t)t * ND + c);
            if (ADD_TMP && !WB) {
                const u32x2 tv = *(const u32x2*)(tmp + (size_t)t * ND + c);
                x4.x += bflo(tv.x); x4.y += bfhi(tv.x); x4.z += bflo(tv.y); x4.w += bfhi(tv.y);
            }
            if (WB) {
                const int tv = *(const int*)((const unsigned char*)tmp + (size_t)t * ND + c), tw = *(const int*)((const unsigned char*)tmp2 + (size_t)t * ND + c);
                x4.x += (__builtin_amdgcn_cvt_f32_fp8(tv, 0) + __builtin_amdgcn_cvt_f32_fp8(tw, 0)) * gt[i * 4 + 0]; x4.y += (__builtin_amdgcn_cvt_f32_fp8(tv, 1) + __builtin_amdgcn_cvt_f32_fp8(tw, 1)) * gt[i * 4 + 1];
                x4.z += (__builtin_amdgcn_cvt_f32_fp8(tv, 2) + __builtin_amdgcn_cvt_f32_fp8(tw, 2)) * gt[i * 4 + 2]; x4.w += (__builtin_amdgcn_cvt_f32_fp8(tv, 3) + __builtin_amdgcn_cvt_f32_fp8(tw, 3)) * gt[i * 4 + 3];
                u32x2 o; o.x = cvt_pk_bf16(x4.x, x4.y); o.y = cvt_pk_bf16(x4.z, x4.w);
                *(u32x2*)((bf16_t*)xsrc_ + (size_t)t * ND + c) = o;
            }
            v[i * 4 + 0] = x4.x; v[i * 4 + 1] = x4.y; v[i * 4 + 2] = x4.z; v[i * 4 + 3] = x4.w;
            ss += x4.x * x4.x + x4.y * x4.y + x4.z * x4.z + x4.w * x4.w;
        }
        ss = wave_sum(ss, lane);
        const float rs = rsqrtf(ss * (1.0f / ND) + RMS_EPS);
#pragma unroll
        for (int i = 0; i < 32; ++i) v[i] = v[i] * rs * g[i] + sh[i];
#pragma unroll
        for (int i = 0; i < 8; ++i) {
            const int c = i * 256 + lane * 4;
            if (DUAL) *(unsigned*)((unsigned char*)H + (size_t)(WS_H8 - WS_H) + (size_t)t * ND + c) = pack_fp8x4(v[i * 4 + 0], v[i * 4 + 1], v[i * 4 + 2], v[i * 4 + 3]);
            if (OUT8) {
                *(unsigned*)((unsigned char*)H + (size_t)t * ND + c) = pack_fp8x4(v[i * 4 + 0], v[i * 4 + 1], v[i * 4 + 2], v[i * 4 + 3]);
            } else {
                u32x2 o; o.x = cvt_pk_bf16(v[i * 4 + 0], v[i * 4 + 1]); o.y = cvt_pk_bf16(v[i * 4 + 2], v[i * 4 + 3]);
                *(u32x2*)(H + (size_t)t * ND + c) = o;
            }
        }
        if (ROUTE) {
            float lg[16];
            int lo = lane * 4; asm volatile("" : "+v"(lo));
#pragma unroll
            for (int e = 0; e < 16; ++e) {
                float s = 0.f;
#pragma unroll
                for (int i = 0; i < 8; ++i) {
                    const float4 w4 = *(const float4*)(wr_lds + e * 2048 + i * 256 + lo);
                    s += v[i * 4 + 0] * w4.x + v[i * 4 + 1] * w4.y + v[i * 4 + 2] * w4.z + v[i * 4 + 3] * w4.w;
                }
                lg[e] = wave_sum(s, lane);
            }
            float mx = lg[0];
#pragma unroll
            for (int e = 1; e < 16; ++e) mx = fmaxf(mx, lg[e]);
            float p[16], sum = 0.f;
#pragma unroll
            for (int e = 0; e < 16; ++e) { p[e] = __expf(lg[e] - mx); sum += p[e]; }
            const float isum = 1.f / sum;
            float sel[16];
#pragma unroll
            for (int e = 0; e < 16; ++e) { p[e] *= isum; sel[e] = p[e] + br[e]; }
            int grp = 0; float best = -1e30f;
#pragma unroll
            for (int gI = 0; gI < 4; ++gI) {
                float m1 = -1e30f, m2 = -1e30f;
#pragma unroll
                for (int j = 0; j < 4; ++j) { const float s = sel[gI * 4 + j]; if (s > m1) { m2 = m1; m1 = s; } else if (s > m2) { m2 = s; } }
                const float gs = m1 + m2;
                if (gs > best) { best = gs; grp = gI; }
            }
            float s4[4], p4[4];
#pragma unroll
            for (int j = 0; j < 4; ++j) { s4[j] = 0.f; p4[j] = 0.f; }
#pragma unroll
            for (int gI = 0; gI < 4; ++gI)
#pragma unroll
                for (int j = 0; j < 4; ++j) if (grp == gI) { s4[j] = sel[gI * 4 + j]; p4[j] = p[gI * 4 + j]; }
            int i1 = 0; float v1 = s4[0];
#pragma unroll
            for (int j = 1; j < 4; ++j) if (s4[j] > v1) { v1 = s4[j]; i1 = j; }
            int i2 = -1; float v2 = -1e30f;
#pragma unroll
            for (int j = 0; j < 4; ++j) if (j != i1 && s4[j] > v2) { v2 = s4[j]; i2 = j; }
            float pa = 0.f, pb = 0.f;
#pragma unroll
            for (int j = 0; j < 4; ++j) { if (j == i1) pa = p4[j]; if (j == i2) pb = p4[j]; }
            const float inv = 1.f / (pa + pb);
            if (lane == 0) {
                const int e0 = grp * 4 + i1, e1 = grp * 4 + i2;
                const unsigned p0 = atomicAdd(cnt + e0 * 64, 1u);
                const unsigned p1 = atomicAdd(cnt + e1 * 64, 1u);
                idx[e0 * 32768 + p0] = t * 2 + 0; gts[e0 * 32768 + p0] = pa * inv;
                idx[e1 * 32768 + p1] = t * 2 + 1; gts[e1 * 32768 + p1] = pb * inv;
            }
        }
    }
    __syncthreads();
}

#define DPP_ADD(v, CTRL) ((v) + __int_as_float(__builtin_amdgcn_update_dpp(0, __float_as_int(v), (CTRL), 0xf, 0xf, false)))
#define DPP_GET(v, CTRL) __int_as_float(__builtin_amdgcn_update_dpp(0, __float_as_int(v), (CTRL), 0xf, 0xf, false))
__device__ __forceinline__ float swap32_sum(float a, float b) {
    const auto r = __builtin_amdgcn_permlane32_swap(__float_as_uint(a), __float_as_uint(b), false, false);
    return __uint_as_float(r[0]) + __uint_as_float(r[1]);
}
__device__ __forceinline__ float swap16_sum(float a, float b) {
    const auto r = __builtin_amdgcn_permlane16_swap(__float_as_uint(a), __float_as_uint(b), false, false);
    return __uint_as_float(r[0]) + __uint_as_float(r[1]);
}
__device__ __forceinline__ float bfly16(const float (&pl)[16], int lane) {
    float a8[8], a4[4], a2[2], a1;
#pragma unroll
    for (int i = 0; i < 8; ++i) a8[i] = swap32_sum(pl[i], pl[8 + i]);
#pragma unroll
    for (int i = 0; i < 4; ++i) a4[i] = swap16_sum(a8[i], a8[4 + i]);
    { const bool hi = (lane & 2) != 0;
#pragma unroll
      for (int i = 0; i < 2; ++i) { const float keep = hi ? a4[2 + i] : a4[i], send = hi ? a4[i] : a4[2 + i]; a2[i] = keep + DPP_GET(send, 0x4e  ); } }
    { const bool hi = (lane & 1) != 0; const float keep = hi ? a2[1] : a2[0], send = hi ? a2[0] : a2[1]; a1 = keep + DPP_GET(send, 0xb1  ); }
    return a1 + DPP_GET(a1, 0x124) + DPP_GET(a1, 0x128) + DPP_GET(a1, 0x12c);
}
__device__ __forceinline__ int bfly16_slot(int lane) { return ((lane >> 5) & 1) * 8 + ((lane >> 4) & 1) * 4 + (lane & 3); }
__device__ __forceinline__ float wave_total(float v) {
    v = swap32_sum(v, v); v = swap16_sum(v, v);
    v = v + DPP_GET(v, 0x124) + DPP_GET(v, 0x128) + DPP_GET(v, 0x12c);
    v = DPP_ADD(v, 0x4e); v = DPP_ADD(v, 0xb1);
    return v;
}
__device__ __forceinline__ void route_phase(int wv, const bf16_t* __restrict__ XB, const float* __restrict__ normw, const float* __restrict__ mod, unsigned char* __restrict__ H8, unsigned char* lds,
                                            const float* __restrict__ w_router, const float* __restrict__ b_router, unsigned* __restrict__ cnt, int* __restrict__ idx, float* __restrict__ gts) {
    const int tid = tid_fresh(wv), lane = tid & 63, w = tid >> 6, fr = lane & 15, fq = lane >> 4;
    constexpr int RB = 128;
    constexpr int GWP = 2048 + 8;
    bf16_t* gwh = (bf16_t*)lds;
    bf16_t* gwl = gwh + 16 * GWP;
    float* part = (float*)(gwl + 16 * GWP);
    float* part_c = part + RB * 17;
    float* rs_lds = part_c + 128;
    unsigned* lcnt = (unsigned*)(rs_lds + RB);
    const int row0 = blockIdx.x * RB;
    const int st = w & 3, rh = w >> 2;
    const int b = row0 / NS, col0 = st * 512 + lane * 8;
    float gg[8], shv[8];
#pragma unroll
    for (int h4 = 0; h4 < 2; ++h4) {
        const float4 nw = *(const float4*)(normw + col0 + h4 * 4);
        const float4 s4 = *(const float4*)(mod + (size_t)b * 6144 + col0 + h4 * 4);
        const float4 c4 = *(const float4*)(mod + (size_t)b * 6144 + 2048 + col0 + h4 * 4);
        gg[h4 * 4 + 0] = nw.x * (1.f + c4.x); gg[h4 * 4 + 1] = nw.y * (1.f + c4.y); gg[h4 * 4 + 2] = nw.z * (1.f + c4.z); gg[h4 * 4 + 3] = nw.w * (1.f + c4.w);
        shv[h4 * 4 + 0] = s4.x; shv[h4 * 4 + 1] = s4.y; shv[h4 * 4 + 2] = s4.z; shv[h4 * 4 + 3] = s4.w;
    }
    __syncthreads();
    {
        const int k0 = tid * 4;
        const float4 nw = *(const float4*)(normw + k0);
        const float4 s4 = *(const float4*)(mod + (size_t)b * 6144 + k0);
        const float4 c4 = *(const float4*)(mod + (size_t)b * 6144 + 2048 + k0);
        const float gk[4] = {nw.x * (1.f + c4.x), nw.y * (1.f + c4.y), nw.z * (1.f + c4.z), nw.w * (1.f + c4.w)};
        const float sk[4] = {s4.x, s4.y, s4.z, s4.w};
        float ce[16];
#pragma unroll
        for (int e = 0; e < 16; ++e) ce[e] = 0.f;
        float wk[4][16];
#pragma unroll
        for (int j = 0; j < 4; ++j)
#pragma unroll
            for (int e4 = 0; e4 < 4; ++e4) {
                const float4 wr = *(const float4*)(w_router + (size_t)(k0 + j) * 16 + e4 * 4);
                wk[j][e4 * 4 + 0] = wr.x; wk[j][e4 * 4 + 1] = wr.y; wk[j][e4 * 4 + 2] = wr.z; wk[j][e4 * 4 + 3] = wr.w;
            }
#pragma unroll
        for (int e = 0; e < 16; ++e) {
            float hi[4], lo[4];
#pragma unroll
            for (int j = 0; j < 4; ++j) { const float v = gk[j] * wk[j][e]; ce[e] += sk[j] * wk[j][e]; hi[j] = bf2f(f2bf(v)); lo[j] = v - hi[j]; }
            u32x2 oh, ol; oh.x = cvt_pk_bf16(hi[0], hi[1]); oh.y = cvt_pk_bf16(hi[2], hi[3]); ol.x = cvt_pk_bf16(lo[0], lo[1]); ol.y = cvt_pk_bf16(lo[2], lo[3]);
            *(u32x2*)(gwh + e * GWP + k0) = oh; *(u32x2*)(gwl + e * GWP + k0) = ol;
        }
        const float ct = bfly16(ce, lane);
        if ((lane & 12) == 0) part_c[w * 16 + bfly16_slot(lane)] = ct;
        if (tid < 16) lcnt[tid] = 0u;
    }
    __syncthreads();
    {
        const bf16_t* xp = XB + (size_t)(row0 + w * 16 + fr) * ND + fq * 8;
        const bf16_t* hp = gwh + fr * GWP + fq * 8;
        const bf16_t* lp = gwl + fr * GWP + fq * 8;
        f32x4 ah[2], al[2], sq[2];
        ah[0] = ah[1] = al[0] = al[1] = sq[0] = sq[1] = (f32x4){0.f, 0.f, 0.f, 0.f};
        bf16x8 xa[8], xn[8];
#pragma unroll
        for (int i = 0; i < 8; ++i) xa[i] = *(const bf16x8*)(xp + i * 32);
        for (int kb = 0; kb < 64; kb += 8) {
            const int kn = (kb + 8 < 64) ? kb + 8 : kb;
#pragma unroll
            for (int i = 0; i < 8; ++i) xn[i] = *(const bf16x8*)(xp + (kn + i) * 32);
#pragma unroll
            for (int i = 0; i < 8; ++i) {
                const bf16x8 bh = *(const bf16x8*)(hp + (kb + i) * 32), bl = *(const bf16x8*)(lp + (kb + i) * 32);
                ah[i & 1] = __builtin_amdgcn_mfma_f32_16x16x32_bf16(xa[i], bh, ah[i & 1], 0, 0, 0);
                al[i & 1] = __builtin_amdgcn_mfma_f32_16x16x32_bf16(xa[i], bl, al[i & 1], 0, 0, 0);
                sq[i & 1] = __builtin_amdgcn_mfma_f32_16x16x32_bf16(xa[i], xa[i], sq[i & 1], 0, 0, 0);
            }
#pragma unroll
            for (int i = 0; i < 8; ++i) xa[i] = xn[i];
        }
#pragma unroll
        for (int j = 0; j < 4; ++j) {
            float* pr = part + (size_t)(w * 16 + fq * 4 + j) * 17;
            pr[fr] = (ah[0][j] + ah[1][j]) + (al[0][j] + al[1][j]);
            if (fr == fq * 4 + j) pr[16] = sq[0][j] + sq[1][j];
        }
    }
    __syncthreads();
    int re0 = 0, re1 = 0; unsigned rp0 = 0, rp1 = 0; float rg0 = 0.f, rg1 = 0.f;
    if (tid < RB) {
        float lg[16], ss = 0.f;
#pragma unroll
        for (int e = 0; e < 16; ++e) lg[e] = 0.f;
        {
            const float* pr = part + (size_t)tid * 17;
#pragma unroll
            for (int e = 0; e < 16; ++e) lg[e] += pr[e];
            ss += pr[16];
        }
        const float rs = rsqrtf(ss * (1.0f / ND) + RMS_EPS);
        rs_lds[tid] = rs;
#pragma unroll
        for (int e = 0; e < 16; ++e) {
            float c = 0.f;
#pragma unroll
            for (int ww = 0; ww < 8; ++ww) c += part_c[ww * 16 + e];
            lg[e] = lg[e] * rs + c;
        }
        float mx = lg[0];
#pragma unroll
        for (int e = 1; e < 16; ++e) mx = fmaxf(mx, lg[e]);
        float p[16], sum = 0.f;
#pragma unroll
        for (int e = 0; e < 16; ++e) { p[e] = __expf(lg[e] - mx); sum += p[e]; }
        const float isum = 1.f / sum;
        float sel[16];
#pragma unroll
        for (int e = 0; e < 16; ++e) { p[e] *= isum; sel[e] = p[e] + b_router[e]; }
        int grp = 0; float best = -1e30f;
#pragma unroll
        for (int gI = 0; gI < 4; ++gI) {
            float m1 = -1e30f, m2 = -1e30f;
#pragma unroll
            for (int j = 0; j < 4; ++j) { const float sv = sel[gI * 4 + j]; if (sv > m1) { m2 = m1; m1 = sv; } else if (sv > m2) { m2 = sv; } }
            const float gs = m1 + m2;
            if (gs > best) { best = gs; grp = gI; }
        }
        float s4[4], p4[4];
#pragma unroll
        for (int j = 0; j < 4; ++j) { s4[j] = 0.f; p4[j] = 0.f; }
#pragma unroll
        for (int gI = 0; gI < 4; ++gI)
#pragma unroll
            for (int j = 0; j < 4; ++j) if (grp == gI) { s4[j] = sel[gI * 4 + j]; p4[j] = p[gI * 4 + j]; }
        int i1 = 0; float v1 = s4[0];
#pragma unroll
        for (int j = 1; j < 4; ++j) if (s4[j] > v1) { v1 = s4[j]; i1 = j; }
        int i2 = -1; float v2 = -1e30f;
#pragma unroll
        for (int j = 0; j < 4; ++j) if (j != i1 && s4[j] > v2) { v2 = s4[j]; i2 = j; }
        float pa = 0.f, pb = 0.f;
#pragma unroll
        for (int j = 0; j < 4; ++j) { if (j == i1) pa = p4[j]; if (j == i2) pb = p4[j]; }
        const float inv = 1.f / (pa + pb);
        re0 = grp * 4 + i1; re1 = grp * 4 + i2; rg0 = pa * inv; rg1 = pb * inv;
        rp0 = atomicAdd(&lcnt[re0], 1u);
        rp1 = atomicAdd(&lcnt[re1], 1u);
    }
    __syncthreads();
    if (tid < 16) lcnt[16 + tid] = atomicAdd(cnt + tid * 64, lcnt[tid]);
    __syncthreads();
    if (tid < RB) {
        const int t = row0 + tid;
        const unsigned p0 = lcnt[16 + re0] + rp0, p1 = lcnt[16 + re1] + rp1;
        idx[re0 * 32768 + p0] = t * 2 + 0; gts[re0 * 32768 + p0] = rg0;
        idx[re1 * 32768 + p1] = t * 2 + 1; gts[re1 * 32768 + p1] = rg1;
    }
    for (int rb = 0; rb < 64; rb += 8) {
        u32x4 xr[8];
#pragma unroll
        for (int q = 0; q < 8; ++q) xr[q] = *(const u32x4*)(XB + (size_t)(row0 + rh * 64 + rb + q) * ND + col0);
#pragma unroll
        for (int q = 0; q < 8; ++q) {
            const float rs = rs_lds[rh * 64 + rb + q];
            u32x2 o;
            o.x = pack_fp8x4(bflo(xr[q].x) * rs * gg[0] + shv[0], bfhi(xr[q].x) * rs * gg[1] + shv[1], bflo(xr[q].y) * rs * gg[2] + shv[2], bfhi(xr[q].y) * rs * gg[3] + shv[3]);
            o.y = pack_fp8x4(bflo(xr[q].z) * rs * gg[4] + shv[4], bfhi(xr[q].z) * rs * gg[5] + shv[5], bflo(xr[q].w) * rs * gg[6] + shv[6], bfhi(xr[q].w) * rs * gg[7] + shv[7]);
            *(u32x2*)(H8 + (size_t)(row0 + rh * 64 + rb + q) * ND + col0) = o;
        }
    }
    __syncthreads();
}

constexpr int BM = 256, BK = 64, HALF = 128, HT = HALF * BK;
__device__ __forceinline__ int lds_byte(int r, int c) {
    const int st = (r >> 4) * 2 + (c >> 5), rr = r & 15, cc = c & 31, ob = rr * 64 + cc * 2;
    return st * 1024 + (ob ^ (((ob >> 9) & 1) << 5));
}
__device__ __forceinline__ void stage_rc(int b, int& R, int& C) {
    const int st = b / 1024, sb = b % 1024, swz = sb ^ (((sb >> 9) & 1) << 5);
    R = (st >> 1) * 16 + swz / 64; C = (st & 1) * 32 + (swz % 64) / 2;
}

typedef int v8i __attribute__((ext_vector_type(8)));
typedef int i32x4 __attribute__((ext_vector_type(4)));
template <bool F8, class RowOff, class Epi>
__device__ __forceinline__ void gemm_unit(int wv, bf16_t* shm, const bf16_t* __restrict__ A_in, const RowOff& rowoff, const bf16_t* __restrict__ Bt_in, int ldb, int K, const Epi& epi) {
    const bf16_t* A; const bf16_t* Bt;
#define SA(b, h) (shm + ((b) * 2 + (h)) * HT)
#define SB(b, h) (shm + (4 + (b) * 2 + (h)) * HT)
#define GLDS(sbase, voff, m0v) do { unsigned _keep; asm volatile("s_mov_b32 %0, m0\n\ts_mov_b32 m0, %3\n\ts_nop 0\n\tglobal_load_lds_dwordx4 %1, %2\n\ts_mov_b32 m0, %0" \
        : "=&s"(_keep) : "v"(voff), "s"(sbase), "s"(m0v) : "memory"); } while (0)
#define STAGE_A(P, h, kt) do { const char* _ab = (const char*)A + (size_t)(kt) * (BK * 2) + (h) * a_h; const unsigned _m0 = ldsb + (unsigned)((char*)(P) - (char*)shm) + (unsigned)wv * 1024u; \
        GLDS(_ab, aoff[h][0], _m0); GLDS(_ab + a_i, aoff[h][1], _m0 + 8192u); } while (0)
#define STAGE_B(P, h, kt) do { const char* _bb = (const char*)Bt + ((size_t)((h) * HALF) * ldb + (size_t)(kt) * BK) * 2; const unsigned _m0 = ldsb + (unsigned)((char*)(P) - (char*)shm) + (unsigned)wv * 1024u; \
        GLDS(_bb, boff, _m0); GLDS(_bb + (size_t)64 * ldb * 2, boff, _m0 + 8192u); } while (0)
#define LDFRAG(dst, base, row) do { const i32x4 _lo = *reinterpret_cast<const i32x4*>((char*)(base) + lds_byte((row), fq * 8)); \
        const i32x4 _hi = *reinterpret_cast<const i32x4*>((char*)(base) + lds_byte((row), 32 + fq * 8)); \
        dst = __builtin_shufflevector(_lo, _hi, 0, 1, 2, 3, 4, 5, 6, 7); } while (0)
#define LDA(dst, b, h) _Pragma("unroll") for (int m = 0; m < 4; ++m) LDFRAG(dst[m], SA(b, h), wr * 64 + m * 16 + fr)
#define LDB(dst, b, h) _Pragma("unroll") for (int n = 0; n < 2; ++n) LDFRAG(dst[n], SB(b, h), wc * 32 + n * 16 + fr)
#define MMA(ai, bj, Af, Bf) do { __builtin_amdgcn_s_setprio(1); \
        _Pragma("unroll") for (int m = 0; m < 4; ++m) _Pragma("unroll") for (int n = 0; n < 2; ++n) { \
            if (F8) acc[ai][bj][m][n] = __builtin_amdgcn_mfma_scale_f32_16x16x128_f8f6f4(Bf[n], Af[m], acc[ai][bj][m][n], 0, 0, 0, 0, 0, 0);     \
            else { acc[ai][bj][m][n] = __builtin_amdgcn_mfma_f32_16x16x32_bf16(__builtin_bit_cast(bf16x8, __builtin_shufflevector(Bf[n], Bf[n], 0, 1, 2, 3)), __builtin_bit_cast(bf16x8, __builtin_shufflevector(Af[m], Af[m], 0, 1, 2, 3)), acc[ai][bj][m][n], 0, 0, 0); \
                   acc[ai][bj][m][n] = __builtin_amdgcn_mfma_f32_16x16x32_bf16(__builtin_bit_cast(bf16x8, __builtin_shufflevector(Bf[n], Bf[n], 4, 5, 6, 7)), __builtin_bit_cast(bf16x8, __builtin_shufflevector(Af[m], Af[m], 4, 5, 6, 7)), acc[ai][bj][m][n], 0, 0, 0); } } \
        __builtin_amdgcn_s_setprio(0); } while (0)
#define WAIT_V(n) asm volatile("s_waitcnt vmcnt(" #n ")" ::: "memory")
#define WAIT_L(n) asm volatile("s_waitcnt lgkmcnt(" #n ")" ::: "memory")
#define BAR __builtin_amdgcn_s_barrier()
#define SCHED __builtin_amdgcn_sched_barrier(0)
    asm volatile("" : "+s"(wv));
    int tx = tid_fresh(wv);
    constexpr unsigned ldsb = 0u;
    {
        const size_t a_ = (size_t)A_in, b_ = (size_t)Bt_in;
        A = (const bf16_t*)(((size_t)(unsigned)__builtin_amdgcn_readfirstlane((int)(a_ >> 32)) << 32) | (size_t)(unsigned)__builtin_amdgcn_readfirstlane((int)a_));
        Bt = (const bf16_t*)(((size_t)(unsigned)__builtin_amdgcn_readfirstlane((int)(b_ >> 32)) << 32) | (size_t)(unsigned)__builtin_amdgcn_readfirstlane((int)b_));
    }
    int lane = tx & 63, wr = wv >> 2, wc = wv & 3, fr = lane & 15, fq = lane >> 4;
    unsigned aoff[2][2], boff;
    {
        int r0, c0; stage_rc(tx * 16, r0, c0);
        boff = (unsigned)(r0 * ldb + c0) * 2u;
        if (RowOff::PLAIN) { aoff[0][0] = (rowoff(r0) + (unsigned)c0) * 2u; aoff[0][1] = aoff[0][0]; aoff[1][0] = aoff[0][0]; aoff[1][1] = aoff[0][0]; }
        else {
            aoff[0][0] = (rowoff(r0) + (unsigned)c0) * 2u; aoff[0][1] = (rowoff(r0 + 64) + (unsigned)c0) * 2u;
            aoff[1][0] = (rowoff(HALF + r0) + (unsigned)c0) * 2u; aoff[1][1] = (rowoff(HALF + r0 + 64) + (unsigned)c0) * 2u;
        }
    }
    const size_t a_h = RowOff::PLAIN ? (size_t)rowoff.ld * HALF * 2 : 0, a_i = RowOff::PLAIN ? (size_t)rowoff.ld * 64 * 2 : 0;
    f32x4 acc[2][2][4][2] = {};
    v8i At[4] = {}, B0[2] = {}, B1[2] = {};
    const int nt = K / BK;
    STAGE_B(SB(0, 0), 0, 0); STAGE_A(SA(0, 0), 0, 0);
    STAGE_B(SB(0, 1), 1, 0); STAGE_A(SA(0, 1), 1, 0);
    if (wr == 1) BAR;
    WAIT_V(4); BAR;
    STAGE_B(SB(1, 0), 0, 1); STAGE_A(SA(1, 0), 0, 1); STAGE_B(SB(1, 1), 1, 1);
    WAIT_V(6); BAR;
    for (int t = 0; t < nt - 2; t += 2) {
        LDB(B0, 0, 0); SCHED; LDA(At, 0, 0); STAGE_A(SA(1, 1), 1, t + 1);
        WAIT_L(8); BAR; WAIT_L(0); MMA(0, 0, At, B0); BAR; SCHED;
        LDB(B1, 0, 1); STAGE_B(SB(0, 0), 0, t + 2);
        BAR; WAIT_L(0); MMA(0, 1, At, B1); BAR;
        LDA(At, 0, 1); STAGE_A(SA(0, 0), 0, t + 2);
        BAR; WAIT_L(0); MMA(1, 0, At, B0); BAR; SCHED;
        STAGE_B(SB(0, 1), 1, t + 2);
        WAIT_V(6); BAR; MMA(1, 1, At, B1); BAR;
        LDB(B0, 1, 0); SCHED; LDA(At, 1, 0); STAGE_A(SA(0, 1), 1, t + 2);
        WAIT_L(8); BAR; WAIT_L(0); MMA(0, 0, At, B0); BAR; SCHED;
        LDB(B1, 1, 1); STAGE_B(SB(1, 0), 0, t + 3);
        BAR; WAIT_L(0); MMA(0, 1, At, B1); BAR;
        LDA(At, 1, 1); STAGE_A(SA(1, 0), 0, t + 3);
        BAR; WAIT_L(0); MMA(1, 0, At, B0); BAR; SCHED;
        STAGE_B(SB(1, 1), 1, t + 3);
        WAIT_V(6); BAR; MMA(1, 1, At, B1); BAR;
    }
    { LDB(B0, 0, 0); WAIT_V(0); LDA(At, 0, 0); STAGE_A(SA(1, 1), 1, nt - 1);
      BAR; WAIT_L(0); MMA(0, 0, At, B0); BAR;
      LDB(B1, 0, 1); BAR; WAIT_L(0); MMA(0, 1, At, B1); BAR;
      LDA(At, 0, 1); WAIT_V(4); BAR; WAIT_L(0); MMA(1, 0, At, B0); MMA(1, 1, At, B1); BAR; }
    { LDB(B0, 1, 0); LDA(At, 1, 0); WAIT_V(2); BAR; WAIT_L(0); MMA(0, 0, At, B0); BAR;
      LDB(B1, 1, 1); WAIT_V(0); BAR; WAIT_L(0); MMA(0, 1, At, B1); BAR;
      LDA(At, 1, 1); BAR; WAIT_L(0); MMA(1, 0, At, B0); MMA(1, 1, At, B1); BAR; }
    if (wr == 0) BAR;
    int tz = tid_fresh(wv); lane = tz & 63; fr = lane & 15; fq = lane >> 4;
    Epi epi2 = epi; epi2.launder();
    epi2(acc, wr, wc, fr, fq);
#undef SA
#undef SB
#undef STAGE_A
#undef GLDS
#undef STAGE_B
#undef LDA
#undef LDFRAG
#undef LDB
#undef MMA
#undef WAIT_V
#undef WAIT_L
#undef BAR
#undef SCHED
}

__device__ __forceinline__ int unit_index(int k) { return (gridDim.x == 256) ? ((k * 8 + (int)(blockIdx.x & 7)) * 32 + (int)(blockIdx.x >> 3)) : (k * (int)gridDim.x + (int)blockIdx.x); }
__device__ __forceinline__ void dense_tile(int i, int nN, int& pm, int& pn) { const int g = i / (8 * nN), rem = i - g * 8 * nN; pn = rem >> 3; pm = g * 8 + (rem & 7); }
__device__ __forceinline__ int lauv(int v) { v = __builtin_amdgcn_readfirstlane(v); asm volatile("" : "+s"(v)); return v; }
template <class T> __device__ __forceinline__ T* lauv(T* p) { const size_t a_ = (size_t)p; unsigned lo = (unsigned)__builtin_amdgcn_readfirstlane((int)a_), hi = (unsigned)__builtin_amdgcn_readfirstlane((int)(a_ >> 32)); asm volatile("" : "+s"(lo), "+s"(hi)); return (T*)(((size_t)hi << 32) | lo); }
struct RowPlain { static constexpr bool PLAIN = true; unsigned base; unsigned ld; __device__ __forceinline__ unsigned operator()(int r) const { return base + (unsigned)r * ld; } };

typedef f32x4 AccT[2][2][4][2];

__device__ __forceinline__ void st_bf16x4(bf16_t* p, f32x4 v) { u32x2 o; o.x = cvt_pk_bf16(v[0], v[1]); o.y = cvt_pk_bf16(v[2], v[3]); *(GAS u32x2*)p = o; }

typedef float f32x2_t __attribute__((ext_vector_type(2)));
struct EpiIn0 {
    unsigned char* proj; const float2* rot; int pm, pn; LAS bf16_t* tl  ; int wv; float sc  ;
    __device__ __forceinline__ void launder() { proj = lauv(proj); rot = lauv(rot); pm = lauv(pm); pn = lauv(pn); }
    __device__ __forceinline__ void tile_out(bf16_t* gbase  ) const {
        __syncthreads();
        const int tid = tid_fresh(wv);
#pragma unroll
        for (int it = 0; it < 16; ++it) {
            const int c = tid + it * NT, d = c >> 5, ch = c & 31;
            *(GAS u32x4*)(gbase + (size_t)((ch >> 3) * 256 + d) * 64 + (ch & 7) * 8) = *(const LAS u32x4*)(tl + d * 264 + ch * 8);
        }
        __syncthreads();
    }
    __device__ __forceinline__ void operator()(const AccT& acc, int wr, int wc, int fr, int fq) const {
        const int row0 = pm * BM + wr * 64 + fr;
        if (pn < 4) {
            bf16_t* O = (bf16_t*)(proj + PJ_AB);
#pragma unroll
            for (int ai = 0; ai < 2; ++ai)
#pragma unroll
                for (int m = 0; m < 4; ++m) { bf16_t* rp = O + (size_t)(row0 + ai * HALF + m * 16) * 1024 + pn * 256 + wc * 32 + fq * 4;
#pragma unroll
                    for (int bj = 0; bj < 2; ++bj)
#pragma unroll
                        for (int n = 0; n < 2; ++n) st_bf16x4(rp + bj * HALF + n * 16, acc[ai][bj][m][n] * sc); }
        } else if (pn < 12) {
            bf16_t* O = (bf16_t*)(proj + PJ_U);
#pragma unroll
            for (int ai = 0; ai < 2; ++ai)
#pragma unroll
                for (int m = 0; m < 4; ++m) { bf16_t* rp = O + (size_t)(row0 + ai * HALF + m * 16) * 1024 + (pn - 4) * 128 + wc * 32 + fq * 4;
#pragma unroll
                    for (int n = 0; n < 2; ++n) st_bf16x4(rp + n * 16, acc[ai][0][m][n] * acc[ai][1][m][n] * (sc * sc)); }
        } else if (pn < 20) {
            const bool isk = pn >= 16; const int hh = (pn - 12) & 3;
            const float lg2 = log2f(1.0f - exp2f(-5.0f - (float)hh));
            bf16_t* O = (bf16_t*)(proj + (isk ? PJ_K : PJ_Q));
#pragma unroll
            for (int ai = 0; ai < 2; ++ai)
#pragma unroll
                for (int m = 0; m < 4; ++m) {
                    const int t = row0 + ai * HALF + m * 16, pos = t & (NS - 1), bb = t >> 11;
                    const int pc = pos & 63;
                    const float dsc = (isk ? 0.0625f * exp2f(-lg2 * (float)pc) : exp2f(lg2 * (float)pc)) * sc;
                    bf16_t* rp = O + (size_t)t * 1024 + hh * 256 + wc * 32 + fq * 4;
#pragma unroll
                    for (int n = 0; n < 2; ++n) {
                        const int f0 = wc * 32 + n * 16 + fq * 4;
                        f32x4 o1, o2;
#pragma unroll
                        for (int j = 0; j < 4; ++j) {
                            const f32x2_t csv = *(const GAS f32x2_t*)(rot + pos * 128 + f0 + j); const float2 cs = make_float2(csv[0], csv[1]);
                            const float x1 = acc[ai][0][m][n][j], x2 = acc[ai][1][m][n][j];
                            o1[j] = (x1 * cs.x - x2 * cs.y) * dsc; o2[j] = (x1 * cs.y + x2 * cs.x) * dsc;
                        }
                        st_bf16x4(rp + n * 16, o1); st_bf16x4(rp + HALF + n * 16, o2);
                    }
                }
        } else if (pn < 24) {
            const int hh = pn - 20; bf16_t* OT = (bf16_t*)(proj + PJ_VT);
#pragma unroll
            for (int ai = 0; ai < 2; ++ai)
#pragma unroll
                for (int m = 0; m < 4; ++m) {
                    const int t = row0 + ai * HALF + m * 16;
#pragma unroll
                    for (int bj = 0; bj < 2; ++bj)
#pragma unroll
                        for (int n = 0; n < 2; ++n) {
                            LAS bf16_t* tp = tl + (bj * HALF + wc * 32 + n * 16 + fq * 4) * 264 + (t & 255);
#pragma unroll
                            for (int j = 0; j < 4; ++j) tp[j * 264] = f2bf(acc[ai][bj][m][n][j] * sc);
                        }
                }
            tile_out(OT + ((size_t)((((pm * BM) >> 11) * 4 + hh) * 32 + (((pm * BM) & (NS - 1)) >> 6)) * 256) * 64);
        } else {
            bf16_t* O = (bf16_t*)(proj + PJ_SG);
#pragma unroll
            for (int ai = 0; ai < 2; ++ai)
#pragma unroll
                for (int m = 0; m < 4; ++m) { bf16_t* rp = O + (size_t)(row0 + ai * HALF + m * 16) * 1024 + (pn - 24) * 256 + wc * 32 + fq * 4;
#pragma unroll
                    for (int bj = 0; bj < 2; ++bj)
#pragma unroll
                        for (int n = 0; n < 2; ++n) { f32x4 v = acc[ai][bj][m][n];
#pragma unroll
                            for (int j = 0; j < 4; ++j) v[j] = silu_f(v[j] * sc);
                            st_bf16x4(rp + bj * HALF + n * 16, v); } }
        }
    }
};

template <bool ADD_TMP, bool XIN_F32>
struct EpiRes {
    const void* xin; const bf16_t* tmp; bf16_t* xout; const float* gate  ; int pm, pn; float sc;
    __device__ __forceinline__ void launder() { xin = lauv(xin); tmp = lauv(tmp); xout = lauv(xout); gate = lauv(gate); pm = lauv(pm); pn = lauv(pn); }
    __device__ __forceinline__ void operator()(const AccT& acc, int wr, int wc, int fr, int fq) const {
        const int row0 = pm * BM + wr * 64 + fr, col0 = pn * BM + wc * 32 + fq * 4;
        const int bb = (pm * BM) >> 11;
        f32x4 gv[2][2];
#pragma unroll
        for (int bj = 0; bj < 2; ++bj)
#pragma unroll
            for (int n = 0; n < 2; ++n) gv[bj][n] = *(const GAS f32x4*)(gate + (size_t)bb * 6144 + col0 + bj * HALF + n * 16);
#pragma unroll
        for (int ai = 0; ai < 2; ++ai)
#pragma unroll
            for (int m = 0; m < 4; ++m) {
                const size_t ro = (size_t)(row0 + ai * HALF + m * 16) * ND + col0;
#pragma unroll
                for (int bj = 0; bj < 2; ++bj)
#pragma unroll
                    for (int n = 0; n < 2; ++n) {
                        f32x4 xv = XIN_F32 ? *(const GAS f32x4*)((const float*)xin + ro + bj * HALF + n * 16) : ld_bf16x4((const bf16_t*)xin + ro + bj * HALF + n * 16);
                        if (ADD_TMP) xv += ld_bf16x4(tmp + ro + bj * HALF + n * 16);
                        st_bf16x4(xout + ro + bj * HALF + n * 16, xv + gv[bj][n] * (acc[ai][bj][m][n] * sc));
                    }
            }
    }
};

typedef short s16x4_t __attribute__((ext_vector_type(4)));
__device__ __forceinline__ void retention_phase(int wv, unsigned char* proj, bf16_t* __restrict__ Og, unsigned char* lds) {
    const int tid = tid_fresh(wv);
    bf16_t* P_lds = (bf16_t*)lds;
    bf16_t* St_lds = (bf16_t*)(lds + 9216);
    bf16_t* Q_lds = (bf16_t*)(lds + 9216 + 33792);
    bf16_t* K_lds = (bf16_t*)(lds + 9216 + 2 * 33792);
    bf16_t* V_lds = (bf16_t*)(lds + 9216 + 3 * 33792);
    const bf16_t* Qg = (const bf16_t*)(proj + PJ_Q); const bf16_t* Kg = (const bf16_t*)(proj + PJ_K);
    const bf16_t* KTg = (const bf16_t*)(proj + PJ_KT); const bf16_t* VTg = (const bf16_t*)(proj + PJ_VT);
    const int ti = wv >> 1, hf = wv & 1;
    for (int u0 = blockIdx.x; u0 < 256; u0 += gridDim.x) {
        int tu = tid; asm volatile("" : "+v"(tu));
        const int srow = tu >> 5, sc16 = tu & 31;
        const int vrow = tu >> 3, vc8 = tu & 7;
        const int fr = tu & 15, fq = (tu >> 4) & 3, w = wv;
        int u = u0;
        if (gridDim.x == 256) { const int xcd = u0 & 7, j = u0 >> 3; u = (((j >> 2) * 8 + xcd) << 2) | (j & 3); }
        const int b = u >> 4, hh = (u >> 2) & 3, es = u & 3;
        const float gam = 1.0f - exp2f(-5.0f - (float)hh);
        const float g63 = exp2f(63.0f * log2f(gam));
        const size_t hrow = (size_t)(b * 4 + hh) * 256;
        const bf16_t* qsp = Qg + ((size_t)b * NS + srow) * 1024 + hh * 256 + sc16 * 8;
        const bf16_t* ksp = Kg + ((size_t)b * NS + srow) * 1024 + hh * 256 + sc16 * 8;
        const bf16_t* vsp = VTg + (hrow * 32 + es * 64 + vrow) * 64 + vc8 * 8;
        u32x4 qr[2][4], kr[2][4], vr[2];
#pragma unroll
        for (int i = 0; i < 4; ++i) { qr[0][i] = *(const u32x4*)(qsp + (size_t)(16 * i) * 1024); kr[0][i] = *(const u32x4*)(ksp + (size_t)(16 * i) * 1024); }
        vr[0] = *(const u32x4*)vsp; vr[1] = *(const u32x4*)(vsp + 256 * 64);
        __syncthreads();
        for (int i = tid; i < 64 * 264 / 2; i += NT) ((unsigned*)St_lds)[i] = 0u;
#pragma unroll
        for (int i = 0; i < 4; ++i) { *(u32x4*)(Q_lds + (srow + 16 * i) * 264 + sc16 * 8) = qr[0][i]; *(u32x4*)(K_lds + (srow + 16 * i) * 264 + sc16 * 8) = kr[0][i]; }
#pragma unroll
        for (int i = 0; i < 4; ++i) { qr[1][i] = *(const u32x4*)(qsp + (size_t)(64 + 16 * i) * 1024); kr[1][i] = *(const u32x4*)(ksp + (size_t)(64 + 16 * i) * 1024); }
        f32x4 S[2][4];
#pragma unroll
        for (int dl = 0; dl < 2; ++dl)
#pragma unroll
            for (int et = 0; et < 4; ++et) S[dl][et] = (f32x4){0.f, 0.f, 0.f, 0.f};
        __syncthreads();
        for (int c2 = 0; c2 < 32; c2 += 2) {
#pragma unroll
          for (int e = 0; e < 2; ++e) {
            const int c = c2 + e;
            int tl = tid; asm volatile("" : "+v"(tl));
            const int fr = tl & 15, fq = (tl >> 4) & 3, srow = tl >> 5, sc16 = tl & 31, vrow = tl >> 3, vc8 = tl & 7, w = wv;
            const bf16_t* qsp = Qg + ((size_t)b * NS + srow) * 1024 + hh * 256 + sc16 * 8;
            const bf16_t* ksp = Kg + ((size_t)b * NS + srow) * 1024 + hh * 256 + sc16 * 8;
            const bf16_t* vsp = VTg + (hrow * 32 + es * 64 + vrow) * 64 + vc8 * 8;
            const int j0 = c * 64;
            const size_t trow = (size_t)b * NS + j0;
            *(u32x4*)(V_lds + vrow * 72 + vc8 * 8) = vr[e];
            {
                const int cn = (c + 2 < 32) ? c + 2 : 31;
#pragma unroll
                for (int i = 0; i < 4; ++i) { qr[e][i] = *(const u32x4*)(qsp + (size_t)(cn * 64 + 16 * i) * 1024); kr[e][i] = *(const u32x4*)(ksp + (size_t)(cn * 64 + 16 * i) * 1024); }
                vr[e] = *(const u32x4*)(vsp + (size_t)cn * (256 * 64));
            }
            bf16x8 ktf[2][2];
#pragma unroll
            for (int dl = 0; dl < 2; ++dl)
#pragma unroll
                for (int ks = 0; ks < 2; ++ks) {
                    const bf16_t* kp = K_lds + (ks * 32 + fq * 8 + (fr >> 2)) * 264 + (2 * w + dl) * 16 + (fr & 3) * 4;
                    const s16x4_t t0 = __builtin_amdgcn_ds_read_tr16_b64_v4i16((__attribute__((address_space(3))) s16x4_t*)(kp));
                    const s16x4_t t1 = __builtin_amdgcn_ds_read_tr16_b64_v4i16((__attribute__((address_space(3))) s16x4_t*)(kp + 4 * 264));
                    ktf[dl][ks] = __builtin_bit_cast(bf16x8, __builtin_shufflevector(t0, t1, 0, 1, 2, 3, 4, 5, 6, 7));
                }
            f32x4 pacc[2], oacc[2];
            pacc[0] = pacc[1] = oacc[0] = oacc[1] = (f32x4){0.f, 0.f, 0.f, 0.f};
            bf16x8 opA[5], opB[5];
#define RET_SB __builtin_amdgcn_sched_barrier(0);
#define RET_RD(buf, ks) { buf[4] = *(const bf16x8*)(Q_lds + (ti * 16 + fr) * 264 + (ks) * 32 + fq * 8); \
                buf[0] = *(const bf16x8*)(K_lds + ((hf * 2 + 0) * 16 + fr) * 264 + (ks) * 32 + fq * 8); buf[1] = *(const bf16x8*)(K_lds + ((hf * 2 + 1) * 16 + fr) * 264 + (ks) * 32 + fq * 8); \
                buf[2] = *(const bf16x8*)(St_lds + ((hf * 2 + 0) * 16 + fr) * 264 + (ks) * 32 + fq * 8); buf[3] = *(const bf16x8*)(St_lds + ((hf * 2 + 1) * 16 + fr) * 264 + (ks) * 32 + fq * 8); }
#define RET_MM(buf, ks) { \
                pacc[0] = __builtin_amdgcn_mfma_f32_16x16x32_bf16(buf[0], buf[4], pacc[0], 0, 0, 0); pacc[1] = __builtin_amdgcn_mfma_f32_16x16x32_bf16(buf[1], buf[4], pacc[1], 0, 0, 0); \
                oacc[0] = __builtin_amdgcn_mfma_f32_16x16x32_bf16(buf[2], buf[4], oacc[0], 0, 0, 0); oacc[1] = __builtin_amdgcn_mfma_f32_16x16x32_bf16(buf[3], buf[4], oacc[1], 0, 0, 0); }
            RET_RD(opA, 0) RET_RD(opB, 1) RET_SB
            RET_MM(opA, 0) RET_SB RET_RD(opA, 2) RET_SB RET_MM(opB, 1) RET_SB RET_RD(opB, 3) RET_SB
            RET_MM(opA, 2) RET_SB RET_RD(opA, 4) RET_SB RET_MM(opB, 3) RET_SB RET_RD(opB, 5) RET_SB
            RET_MM(opA, 4) RET_SB RET_RD(opA, 6) RET_SB RET_MM(opB, 5) RET_SB RET_RD(opB, 7) RET_SB
            RET_MM(opA, 6) RET_SB RET_MM(opB, 7) RET_SB
#undef RET_RD
#undef RET_MM
#pragma unroll
            for (int tt = 0; tt < 2; ++tt) {
                const int tj = hf * 2 + tt;
                { const int i = ti * 16 + fr, jc = tj * 16 + fq * 4; f32x4 pv = pacc[tt];
#pragma unroll
                  for (int j = 0; j < 4; ++j) pv[j] = (jc + j <= i) ? pv[j] : 0.f;
                  u32x2 o; o.x = cvt_pk_bf16(pv[0], pv[1]); o.y = cvt_pk_bf16(pv[2], pv[3]); *(u32x2*)(P_lds + i * 72 + jc) = o; }
            }
            __syncthreads();
#pragma unroll
            for (int i = 0; i < 4; ++i) { *(u32x4*)(Q_lds + (srow + 16 * i) * 264 + sc16 * 8) = qr[e ^ 1][i]; *(u32x4*)(K_lds + (srow + 16 * i) * 264 + sc16 * 8) = kr[e ^ 1][i]; }
            bf16x8 pf[2], vfo[2][2], vf[4][2];
#pragma unroll
            for (int ks = 0; ks < 2; ++ks) {
                pf[ks] = *(const bf16x8*)(P_lds + (ti * 16 + fr) * 72 + ks * 32 + fq * 8);
#pragma unroll
                for (int tt = 0; tt < 2; ++tt) vfo[tt][ks] = *(const bf16x8*)(V_lds + ((hf * 2 + tt) * 16 + fr) * 72 + ks * 32 + fq * 8);
#pragma unroll
                for (int et = 0; et < 4; ++et) vf[et][ks] = *(const bf16x8*)(V_lds + (et * 16 + fr) * 72 + ks * 32 + fq * 8);
            }
            oacc[0] *= gam; oacc[1] *= gam;
#pragma unroll
            for (int dl = 0; dl < 2; ++dl)
#pragma unroll
                for (int et = 0; et < 4; ++et) S[dl][et] *= gam;
            RET_SB
#pragma unroll
            for (int ks = 0; ks < 2; ++ks) {
                oacc[0] = __builtin_amdgcn_mfma_f32_16x16x32_bf16(vfo[0][ks], pf[ks], oacc[0], 0, 0, 0);
                oacc[1] = __builtin_amdgcn_mfma_f32_16x16x32_bf16(vfo[1][ks], pf[ks], oacc[1], 0, 0, 0);
#pragma unroll
                for (int dl = 0; dl < 2; ++dl)
#pragma unroll
                    for (int et = 0; et < 4; ++et) S[dl][et] = __builtin_amdgcn_mfma_f32_16x16x32_bf16(ktf[dl][ks], vf[et][ks], S[dl][et], 0, 0, 0);
            }
            RET_SB
#pragma unroll
            for (int tt = 0; tt < 2; ++tt) {
                const int te = hf * 2 + tt;
                st_bf16x4(Og + (trow + ti * 16 + fr) * 1024 + hh * 256 + es * 64 + te * 16 + fq * 4, oacc[tt]);
            }
#pragma unroll
            for (int dl = 0; dl < 2; ++dl)
#pragma unroll
                for (int et = 0; et < 4; ++et) {
                    const f32x4 sv = S[dl][et] * g63; S[dl][et] = sv;
                    u32x2 o; o.x = cvt_pk_bf16(sv[0], sv[1]); o.y = cvt_pk_bf16(sv[2], sv[3]);
                    *(u32x2*)(St_lds + (et * 16 + fr) * 264 + (2 * w + dl) * 16 + fq * 4) = o;
                }
#undef RET_SB
            __syncthreads();
          }
        }
    }
}

__device__ __forceinline__ void ycat_phase(int wv, const unsigned char* proj, const bf16_t* __restrict__ Og, const float* __restrict__ conv_w, const float* __restrict__ conv_b, bf16_t* __restrict__ Y) {
    const int tid = tid_fresh(wv), lane = tid & 63, wave = tid >> 6;
    const bf16_t* AB = (const bf16_t*)(proj + PJ_AB); const bf16_t* U = (const bf16_t*)(proj + PJ_U); const bf16_t* SG = (const bf16_t*)(proj + PJ_SG);
    const int ch0 = lane * 16;
    float cw0[16], cw1[16], cw2[16], cb[16];
#pragma unroll
    for (int i = 0; i < 16; ++i) { cw0[i] = conv_w[ch0 + i]; cw1[i] = conv_w[1024 + ch0 + i]; cw2[i] = conv_w[2048 + ch0 + i]; cb[i] = conv_b[ch0 + i]; }
    const int rows_per_wave = NTOK / ((int)gridDim.x * 8);
    const int row0 = (blockIdx.x * 8 + wave) * rows_per_wave;
    float u1[16], u2[16];
    auto load16 = [&](const bf16_t* p, float* f) {
        const u32x4 a = *(const u32x4*)p; const u32x4 c = *(const u32x4*)(p + 8);
        f[0] = bflo(a.x); f[1] = bfhi(a.x); f[2] = bflo(a.y); f[3] = bfhi(a.y); f[4] = bflo(a.z); f[5] = bfhi(a.z); f[6] = bflo(a.w); f[7] = bfhi(a.w);
        f[8] = bflo(c.x); f[9] = bfhi(c.x); f[10] = bflo(c.y); f[11] = bfhi(c.y); f[12] = bflo(c.z); f[13] = bfhi(c.z); f[14] = bflo(c.w); f[15] = bfhi(c.w);
    };
    auto store16 = [&](bf16_t* p, const float* f) {
        u32x4 a, c;
        a.x = cvt_pk_bf16(f[0], f[1]); a.y = cvt_pk_bf16(f[2], f[3]); a.z = cvt_pk_bf16(f[4], f[5]); a.w = cvt_pk_bf16(f[6], f[7]);
        c.x = cvt_pk_bf16(f[8], f[9]); c.y = cvt_pk_bf16(f[10], f[11]); c.z = cvt_pk_bf16(f[12], f[13]); c.w = cvt_pk_bf16(f[14], f[15]);
        *(u32x4*)p = a; *(u32x4*)(p + 8) = c;
    };
    auto store16f8 = [&](unsigned char* p, const float* f) {
        u32x4 a;
        a.x = pack_fp8x4(f[0] * Y8_SCALE, f[1] * Y8_SCALE, f[2] * Y8_SCALE, f[3] * Y8_SCALE); a.y = pack_fp8x4(f[4] * Y8_SCALE, f[5] * Y8_SCALE, f[6] * Y8_SCALE, f[7] * Y8_SCALE);
        a.z = pack_fp8x4(f[8] * Y8_SCALE, f[9] * Y8_SCALE, f[10] * Y8_SCALE, f[11] * Y8_SCALE); a.w = pack_fp8x4(f[12] * Y8_SCALE, f[13] * Y8_SCALE, f[14] * Y8_SCALE, f[15] * Y8_SCALE);
        *(u32x4*)p = a;
    };
    {
        const int pos = row0 & (NS - 1);
#pragma unroll
        for (int i = 0; i < 16; ++i) { u1[i] = 0.f; u2[i] = 0.f; }
        if (pos >= 1) load16(U + (size_t)(row0 - 1) * 1024 + ch0, u1);
        if (pos >= 2) load16(U + (size_t)(row0 - 2) * 1024 + ch0, u2);
    }
    for (int r = 0; r < rows_per_wave; ++r) {
        const int t = row0 + r;
        float ab[16], u0[16], y[16];
        load16(AB + (size_t)t * 1024 + ch0, ab); load16(U + (size_t)t * 1024 + ch0, u0);
        if ((t & (NS - 1)) == 0) {
#pragma unroll
            for (int i = 0; i < 16; ++i) { u1[i] = 0.f; u2[i] = 0.f; }
        }
#pragma unroll
        for (int i = 0; i < 16; ++i) { y[i] = ab[i] * (cb[i] + cw0[i] * u2[i] + cw1[i] * u1[i] + cw2[i] * u0[i]); u2[i] = u1[i]; u1[i] = u0[i]; }
        if (F8_P5) store16f8((unsigned char*)Y + (size_t)t * ND + ch0, y); else store16(Y + (size_t)t * ND + ch0, y);
        float o[16], sg[16];
        load16(Og + (size_t)t * 1024 + ch0, o); load16(SG + (size_t)t * 1024 + ch0, sg);
        float ss = 0.f;
#pragma unroll
        for (int i = 0; i < 16; ++i) ss += o[i] * o[i];
        ss += shx(ss, 1, lane); ss += shx(ss, 2, lane); ss += shx(ss, 4, lane); ss += shx(ss, 8, lane);
        const float rs = rsqrtf(ss * (1.0f / 256.0f) + RMS_EPS);
#pragma unroll
        for (int i = 0; i < 16; ++i) y[i] = o[i] * rs * sg[i];
        if (F8_P5) store16f8((unsigned char*)Y + (size_t)t * ND + 1024 + ch0, y); else store16(Y + (size_t)t * ND + 1024 + ch0, y);
    }
}

constexpr int MOE_TAB_OFF = 64;
__device__ __forceinline__ int moe_build_table(int wv, const unsigned* cntp, unsigned char* lds) {
    volatile LAS int* tab = (volatile LAS int*)(lds + LDS_MISC + MOE_TAB_OFF);
    __syncthreads();
    if (wv == 0) {
        const int lane = tid_fresh(wv) & 63;
        if (lane == 0) {
            int mt = 0;
            for (int e = 0; e < 16; ++e) {
                const int c = (int)__hip_atomic_load(cntp + e * 64, __ATOMIC_RELAXED, __HIP_MEMORY_SCOPE_AGENT);
                for (int lt = 0; lt * 256 < c; ++lt) { tab[4 + mt * 4 + 0] = e; tab[4 + mt * 4 + 1] = lt * 256; tab[4 + mt * 4 + 2] = c; ++mt; }
            }
            tab[0] = mt;
        }
    }
    __syncthreads();
    return __builtin_amdgcn_readfirstlane(tab[0]);
}
struct RowGather {
    static constexpr bool PLAIN = false; static constexpr unsigned ld = 0;
    const int* idx; int nvalid;
    __device__ __forceinline__ unsigned operator()(int r) const {
        const __amdgpu_buffer_rsrc_t rs = __builtin_amdgcn_make_buffer_rsrc((void*)idx, 0, 256 * 4, 0x00020000);
        const int v = (r < nvalid) ? (int)__builtin_amdgcn_raw_buffer_load_b32(rs, r * 4, 0, 0) : 0;
        return (unsigned)(v >> 1) * (unsigned)(ND / 2);
    }
};
struct EpiGate {
    bf16_t* act; int row0g  , colbase;
    __device__ __forceinline__ void launder() { act = lauv(act); row0g = lauv(row0g); colbase = lauv(colbase); }
    __device__ __forceinline__ void operator()(const AccT& acc, int wr, int wc, int fr, int fq) const {
        const int lo = fr * DEXP + fq * 4;
        const __amdgpu_buffer_rsrc_t rs = __builtin_amdgcn_make_buffer_rsrc((void*)((unsigned char*)act + (size_t)(row0g + wr * 64) * DEXP + colbase + wc * 32), 0, 256 * DEXP, 0x00020000);
#pragma unroll
        for (int ai = 0; ai < 2; ++ai)
#pragma unroll
            for (int m = 0; m < 4; ++m) {
#pragma unroll
                for (int n = 0; n < 2; ++n) { f32x4 v;
#pragma unroll
                    for (int j = 0; j < 4; ++j) v[j] = silu_f(acc[ai][0][m][n][j] * (1.0f / W8_SCALE)) * acc[ai][1][m][n][j] * (A8_SCALE / W8_SCALE);
                    __builtin_amdgcn_raw_buffer_store_b32(pack_fp8x4(v[0], v[1], v[2], v[3]), rs, lo + n * 16, (ai * HALF + m * 16) * DEXP, 0); } }
    }
};
constexpr float T8_SCALE = 16.0f;
struct EpiMoeOut {
    const int* idx; const float* gts; int nvalid; bf16_t* tmp1; bf16_t* tmp; const float* gate  ; int col0t; int tmp8  ;
    __device__ __forceinline__ void launder() { idx = lauv(idx); gts = lauv(gts); tmp1 = lauv(tmp1); tmp = lauv(tmp); gate = lauv(gate); nvalid = lauv(nvalid); col0t = lauv(col0t); tmp8 = lauv(tmp8); }
    __device__ __forceinline__ void operator()(const AccT& acc, int wr, int wc, int fr, int fq) const {
        const int colb = col0t + wc * 32 + fq * 4;
#pragma unroll
        for (int ai = 0; ai < 2; ++ai)
#pragma unroll
            for (int m = 0; m < 4; ++m) {
                const int r = ai * HALF + wr * 64 + m * 16 + fr;
                if (r < nvalid) {
                    const int v = ((const GAS int*)idx)[r]; const float g = ((const GAS float*)gts)[r];
                    const int tok = v >> 1;
                    const size_t ro = (size_t)tok * ND + colb;
#pragma unroll
                    for (int bj = 0; bj < 2; ++bj)
#pragma unroll
                        for (int n = 0; n < 2; ++n) {
                            const f32x4 y = acc[ai][bj][m][n] * (g * (1.0f / (W8_SCALE * A8_SCALE)));
                            *(GAS unsigned*)((unsigned char*)tmp + (size_t)(v & 1) * (64 * MiB) + ro + bj * HALF + n * 16) = pack_fp8x4(y[0] * T8_SCALE, y[1] * T8_SCALE, y[2] * T8_SCALE, y[3] * T8_SCALE);
                        }
                }
            }
    }
};

struct EpiGateLazy {
    int mt, nt;
    __device__ __forceinline__ void launder() { mt = lauv(mt); nt = lauv(nt); }
    __device__ __forceinline__ void operator()(const AccT& acc, int wr, int wc, int fr, int fq) const {
        const KA a; unsigned char* ws = a.ws();
        EpiGate E{(bf16_t*)(ws + WS_PROJ + PJ_ACT), mt * 256, nt * 128};
        E(acc, wr, wc, fr, fq);
    }
};
struct EpiMoeOutLazy {
    int e, r0, nvalid, layer, nt;
    __device__ __forceinline__ void launder() { e = lauv(e); r0 = lauv(r0); nvalid = lauv(nvalid); layer = lauv(layer); nt = lauv(nt); }
    __device__ __forceinline__ void operator()(const AccT& acc, int wr, int wc, int fr, int fq) const {
        const KA a; unsigned char* ws = a.ws();
        EpiMoeOut E{(const int*)(ws + WS_IDX) + e * 32768 + r0, (const float*)(ws + WS_GT) + e * 32768 + r0, nvalid, (bf16_t*)(ws + WS_TMP1), (bf16_t*)(ws + WS_TMP),
                    (const float*)(ws + WS_MOD) + (size_t)(2 * layer + 1) * 16 * 6144 + 4096, nt * 256, layer};
        E(acc, wr, wc, fr, fq);
    }
};
__device__ __forceinline__ void moe_phase1(int wv, unsigned char* ws0, int layer, unsigned char* lds) {
    const int nmt = moe_build_table(wv, (const unsigned*)(ws0 + WS_CTL + CTL_CNT + layer * 4096), lds);
    for (int k = 0, u = unit_index(0); u < nmt * 8; u = unit_index(++k)) {
        const KA a; unsigned char* ws = a.ws();
        const LAS int* tab = (const LAS int*)(lds + LDS_MISC + MOE_TAB_OFF);
        const int mt = u >> 3, nt = u & 7;
        const int e = __builtin_amdgcn_readfirstlane(tab[4 + mt * 4 + 0]), r0 = __builtin_amdgcn_readfirstlane(tab[4 + mt * 4 + 1]), cnt_e = __builtin_amdgcn_readfirstlane(tab[4 + mt * 4 + 2]);
        RowGather ro{(const int*)(ws + WS_IDX) + e * 32768 + r0, cnt_e - r0};
        EpiGateLazy E{mt, nt};
        gemm_unit<true>(wv, (bf16_t*)lds, (const bf16_t*)(ws + WS_H), ro, (const bf16_t*)(ws + WS_W13 + ((size_t)(layer * 16 + e) * 2048 + (size_t)nt * 256) * ND), ND / 2, ND / 2, E);
    }
}
__device__ __forceinline__ void moe_phase2(int wv, unsigned char* ws0, int layer, unsigned char* lds) {
    const int nmt = moe_build_table(wv, (const unsigned*)(ws0 + WS_CTL + CTL_CNT + layer * 4096), lds);
    for (int k = 0, u = unit_index(0); u < nmt * 8; u = unit_index(++k)) {
        const KA a; unsigned char* ws = a.ws();
        const LAS int* tab = (const LAS int*)(lds + LDS_MISC + MOE_TAB_OFF);
        const int mt = u >> 3, nt = u & 7;
        const int e = __builtin_amdgcn_readfirstlane(tab[4 + mt * 4 + 0]), r0 = __builtin_amdgcn_readfirstlane(tab[4 + mt * 4 + 1]), cnt_e = __builtin_amdgcn_readfirstlane(tab[4 + mt * 4 + 2]);
        RowPlain ro{(unsigned)(mt * 256) * (DEXP / 2), (unsigned)(DEXP / 2)};
        EpiMoeOutLazy E{e, r0, cnt_e - r0, layer, nt};
        gemm_unit<true>(wv, (bf16_t*)lds, (const bf16_t*)(ws + WS_PROJ + PJ_ACT), ro, (const bf16_t*)(ws + WS_W2 + ((size_t)(layer * 16 + e) * 2048 + (size_t)nt * 256) * DEXP), DEXP / 2, DEXP / 2, E);
    }
}

constexpr float Q8_SCALE = 8.0f;
struct EpiIn1 {
    unsigned char* proj; int pm, pn; float sc;
    __device__ __forceinline__ void launder() { proj = lauv(proj); pm = lauv(pm); pn = lauv(pn); }
    __device__ __forceinline__ void operator()(const AccT& acc, int wr, int wc, int fr, int fq) const {
        const int row0 = pm * BM + wr * 64 + fr;
        if (pn < 8 || (pn >= 9 && pn < 13)) {
            const bool isq = pn < 8;
            bf16_t* O = (bf16_t*)(proj + (isq ? PJ_Q1 : PJ_QI)); const int ld = isq ? 2048 : 1024, cb = (isq ? pn : pn - 9) * 256;
#pragma unroll
            for (int ai = 0; ai < 2; ++ai)
#pragma unroll
                for (int m = 0; m < 4; ++m) { bf16_t* rp = O + (size_t)(row0 + ai * HALF + m * 16) * ld + cb + wc * 32 + fq * 4;
                    unsigned char* rp8 = (unsigned char*)O + (size_t)(row0 + ai * HALF + m * 16) * 2048 + cb + wc * 32 + fq * 4;
#pragma unroll
                    for (int bj = 0; bj < 2; ++bj)
#pragma unroll
                        for (int n = 0; n < 2; ++n) {
                            if (isq) { const f32x4 v = acc[ai][bj][m][n] * (sc * Q8_SCALE); *(GAS unsigned*)(rp8 + bj * HALF + n * 16) = pack_fp8x4(v[0], v[1], v[2], v[3]); }
                            else st_bf16x4(rp + bj * HALF + n * 16, acc[ai][bj][m][n] * sc);
                        } }
        } else if (pn == 8) {
            bf16_t* KR = (bf16_t*)(proj + PJ_KR); bf16_t* VT = (bf16_t*)(proj + PJ_VT1);
#pragma unroll
            for (int ai = 0; ai < 2; ++ai)
#pragma unroll
                for (int m = 0; m < 4; ++m) {
                    const int t = row0 + ai * HALF + m * 16, pos = t & (NS - 1), bb = t >> 11;
#pragma unroll
                    for (int n = 0; n < 2; ++n) {
                        st_bf16x4(KR + (size_t)t * 128 + wc * 32 + n * 16 + fq * 4, acc[ai][0][m][n] * sc);
                        st_bf16x4(VT + (size_t)t * 128 + wc * 32 + n * 16 + fq * 4, acc[ai][1][m][n] * sc);
                    }
                }
        } else {
            bf16_t* KI = (bf16_t*)(proj + PJ_KI); float* WI = (float*)(proj + PJ_WI);
#pragma unroll
            for (int ai = 0; ai < 2; ++ai)
#pragma unroll
                for (int m = 0; m < 4; ++m) {
                    const int t = row0 + ai * HALF + m * 16;
                    if (wc < 2) {
#pragma unroll
                        for (int n = 0; n < 2; ++n) st_bf16x4(KI + (size_t)t * 64 + wc * 32 + n * 16 + fq * 4, acc[ai][0][m][n] * sc);
                    } else if (wc == 2) {
                        *(GAS f32x4*)(WI + (size_t)t * 16 + fq * 4) = acc[ai][0][m][0] * sc;
                    }
                }
        }
    }
};

constexpr float ATT_KS = 16.0f, ATT_QS = 64.0f;
__device__ __forceinline__ void knorm_phase(int wv, const unsigned char* proj, const float* __restrict__ k_norm, bf16_t* __restrict__ Kn) {
    const int tid = tid_fresh(wv), lane = tid & 63;
    const bf16_t* KR = (const bf16_t*)(proj + PJ_KR);
    const int sub = tid & 15;
    float kw[8];
#pragma unroll
    for (int i = 0; i < 8; ++i) kw[i] = k_norm[sub * 8 + i];
    for (int t = (blockIdx.x * NT + tid) >> 4; t < NTOK; t += (gridDim.x * NT) >> 4) {
        const u32x4 v = *(const u32x4*)(KR + (size_t)t * 128 + sub * 8);
        float f[8] = {bflo(v.x), bfhi(v.x), bflo(v.y), bfhi(v.y), bflo(v.z), bfhi(v.z), bflo(v.w), bfhi(v.w)};
        float ss = 0.f;
#pragma unroll
        for (int i = 0; i < 8; ++i) ss += f[i] * f[i];
        ss += shx(ss, 1, lane); ss += shx(ss, 2, lane); ss += shx(ss, 4, lane); ss += shx(ss, 8, lane);
        const float rs = rsqrtf(ss * (1.0f / 128.0f) + RMS_EPS);
        u32x2 o; o.x = pack_fp8x4(f[0] * rs * kw[0] * ATT_KS, f[1] * rs * kw[1] * ATT_KS, f[2] * rs * kw[2] * ATT_KS, f[3] * rs * kw[3] * ATT_KS);
        o.y = pack_fp8x4(f[4] * rs * kw[4] * ATT_KS, f[5] * rs * kw[5] * ATT_KS, f[6] * rs * kw[6] * ATT_KS, f[7] * rs * kw[7] * ATT_KS);
        *(u32x2*)((unsigned char*)Kn + (size_t)t * 128 + sub * 8) = o;
    }
}

__device__ __forceinline__ unsigned f2sort(float f) { const unsigned u = __float_as_uint(f); return (u & 0x80000000u) ? ~u : (u | 0x80000000u); }
constexpr int IDX_SC_BYTES = 8 * 2 * 2048 * 4;
constexpr int IDX_KT_BYTES = 64 * 144;
#define WRLANE2(word, lo, hi, lane_idx) asm("s_nop 1\n\tv_writelane_b32 %0, %1, " #lane_idx "\n\tv_writelane_b32 %0, %2, " #lane_idx "+1" : "+v"(word) : "s"(lo), "s"(hi))
typedef short s16x2_t __attribute__((ext_vector_type(2)));
__device__ __forceinline__ unsigned relu_bf16x2(unsigned v) { const s16x2_t z = {0, 0}; return __builtin_bit_cast(unsigned, __builtin_elementwise_max(__builtin_bit_cast(s16x2_t, v), z)); }
__device__ __forceinline__ void indexer_phase(int wv, const unsigned char* proj, unsigned* __restrict__ MASK, unsigned char* lds) {
    const int tid = tid_fresh(wv), lane = tid & 63, fr = lane & 15, fq = lane >> 4;
    const bf16_t* QI = (const bf16_t*)(proj + PJ_QI); const bf16_t* KI = (const bf16_t*)(proj + PJ_KI); const float* WI = (const float*)(proj + PJ_WI);
    float* scl = (float*)lds + (size_t)wv * 2 * 2048;
    unsigned char* ktl = lds + IDX_SC_BYTES;
    const int nunits = NB * 128;
    for (int uu = blockIdx.x; uu < nunits; uu += gridDim.x) {
        int b, q16;
        if (gridDim.x == 256) { b = blockIdx.x >> 4; const int r = blockIdx.x & 15, k = (uu - blockIdx.x) / 256; q16 = (k & 1) ? (k >> 1) * 32 + 31 - r : (k >> 1) * 32 + r; }
        else { b = uu >> 7; q16 = uu & 127; }
        const int p0 = q16 * 16, pw = p0 + 2 * wv;
        const size_t t0 = (size_t)b * NS + pw;
        bf16x8 qa[2][2], wa;
#pragma unroll
        for (int tk = 0; tk < 2; ++tk)
#pragma unroll
            for (int ks = 0; ks < 2; ++ks) qa[tk][ks] = *(const bf16x8*)(QI + (t0 + tk) * 1024 + fr * 64 + ks * 32 + fq * 8);
        {
            const f32x4 w0 = *(const f32x4*)(WI + (t0 + 0) * 16 + fq * 4), w1 = *(const f32x4*)(WI + (t0 + 1) * 16 + fq * 4);
            u32x4 wp = (u32x4){0u, 0u, 0u, 0u};
            if (fr == 0) { wp.x = cvt_pk_bf16(w0[0], w0[1]); wp.y = cvt_pk_bf16(w0[2], w0[3]); }
            if (fr == 1) { wp.z = cvt_pk_bf16(w1[0], w1[1]); wp.w = cvt_pk_bf16(w1[2], w1[3]); }
            wa = __builtin_bit_cast(bf16x8, wp);
        }
        const int nkt = (p0 >> 6) + 1;
        const int krow = tid >> 3, kch = tid & 7;
        const bf16_t* kgp = KI + ((size_t)b * NS + krow) * 64 + kch * 8;
        const int klast = nkt - 1;
#define IDX_LD(x) (*(const u32x4*)(kgp + (size_t)((x) < klast ? (x) : klast) * (64 * 64)))
        u32x4 kr0 = IDX_LD(0), kr1 = IDX_LD(1), kr2 = IDX_LD(2), kr3 = IDX_LD(3);
        __syncthreads();
        *(u32x4*)(ktl + krow * 144 + kch * 16) = kr0;
        kr0 = IDX_LD(4);
        __syncthreads();
#define IDX_SB __builtin_amdgcn_sched_barrier(0);
#define IDX_TILE(KT, KRN) { \
            const int kt_ = (KT); \
            const unsigned char* kc = ktl + (kt_ & 1) * IDX_KT_BYTES; \
            bf16x8 kf[4][2]; \
            _Pragma("unroll") \
            for (int st = 0; st < 4; ++st) { kf[st][0] = *(const bf16x8*)(kc + (st * 16 + fr) * 144 + fq * 16); kf[st][1] = *(const bf16x8*)(kc + (st * 16 + fr) * 144 + 64 + fq * 16); } \
            f32x4 dd[4][2]; \
            IDX_SB \
            _Pragma("unroll") \
            for (int st = 0; st < 4; ++st) { \
                _Pragma("unroll") \
                for (int tk = 0; tk < 2; ++tk) dd[st][tk] = __builtin_amdgcn_mfma_f32_16x16x32_bf16(qa[tk][0], kf[st][0], (f32x4){0.f, 0.f, 0.f, 0.f}, 0, 0, 0); } \
            IDX_SB \
            _Pragma("unroll") \
            for (int st = 0; st < 4; ++st) { \
                _Pragma("unroll") \
                for (int tk = 0; tk < 2; ++tk) dd[st][tk] = __builtin_amdgcn_mfma_f32_16x16x32_bf16(qa[tk][1], kf[st][1], dd[st][tk], 0, 0, 0); } \
            IDX_SB \
            u32x4 rb[4]; \
            _Pragma("unroll") \
            for (int st = 0; st < 4; ++st) { \
                rb[st].x = relu_bf16x2(cvt_pk_bf16(dd[st][0][0], dd[st][0][1])); rb[st].y = relu_bf16x2(cvt_pk_bf16(dd[st][0][2], dd[st][0][3])); \
                rb[st].z = relu_bf16x2(cvt_pk_bf16(dd[st][1][0], dd[st][1][1])); rb[st].w = relu_bf16x2(cvt_pk_bf16(dd[st][1][2], dd[st][1][3])); } \
            IDX_SB \
            f32x4 sc[4]; \
            _Pragma("unroll") \
            for (int st = 0; st < 4; ++st) sc[st] = __builtin_amdgcn_mfma_f32_16x16x32_bf16(wa, __builtin_bit_cast(bf16x8, rb[st]), (f32x4){0.f, 0.f, 0.f, 0.f}, 0, 0, 0); \
            IDX_SB \
            if (kt_ == klast) { \
                _Pragma("unroll") \
                for (int st = 0; st < 4; ++st) { \
                    const int s = kt_ * 64 + st * 16 + fr; \
                    float v0 = sc[st][0], v1 = sc[st][1]; \
                    if (s > pw) v0 = -__builtin_inff(); \
                    if (s > pw + 1) v1 = -__builtin_inff(); \
                    if (fq == 0) { scl[s] = v0; scl[2048 + s] = v1; } \
                } \
            } else { \
                _Pragma("unroll") \
                for (int st = 0; st < 4; ++st) if (fq == 0) { scl[kt_ * 64 + st * 16 + fr] = sc[st][0]; scl[2048 + kt_ * 64 + st * 16 + fr] = sc[st][1]; } \
            } \
            if (kt_ + 1 < nkt) *(u32x4*)(ktl + ((kt_ + 1) & 1) * IDX_KT_BYTES + krow * 144 + kch * 16) = KRN; \
            KRN = IDX_LD(kt_ + 5); \
            __syncthreads(); }
        for (int kt = 0; kt < nkt; kt += 4) {
            IDX_TILE(kt, kr1)
            if (kt + 1 >= nkt) break;
            IDX_TILE(kt + 1, kr2)
            if (kt + 2 >= nkt) break;
            IDX_TILE(kt + 2, kr3)
            if (kt + 3 >= nkt) break;
            IDX_TILE(kt + 3, kr0)
        }
#undef IDX_TILE
#undef IDX_LD
        const int kbmax = klast;
#pragma unroll
        for (int tk = 0; tk < 2; ++tk) {
            const int p = pw + tk;
            unsigned u[32];
#pragma unroll
            for (int kb = 0; kb < 32; ++kb) u[kb] = (kb <= kbmax) ? f2sort(scl[tk * 2048 + kb * 64 + lane]) : 0u;
            unsigned thr = 0x00800000u;
            if (p + 1 > 256) {
                unsigned t = 0u;
                for (int bit = 31; bit >= 0; --bit) {
                    const unsigned cand = t | (1u << bit);
                    int n = 0;
#pragma unroll
                    for (int g8 = 0; g8 < 4; ++g8) {
                        if (g8 * 8 <= kbmax) {
#pragma unroll
                            for (int h4 = 0; h4 < 2; ++h4) {
                                unsigned long long m[4];
#pragma unroll
                                for (int kk = 0; kk < 4; ++kk) m[kk] = __ballot(u[g8 * 8 + h4 * 4 + kk] >= cand);
                                IDX_SB
#pragma unroll
                                for (int kk = 0; kk < 4; ++kk) n += __builtin_popcountll(m[kk]);
                                IDX_SB
                            }
                        }
                    }
                    if (n >= 256) t = cand;
                    if (n == 256) break;
                }
                thr = t;
            }
            int word = 0;
#define IDX_W(kb) { const unsigned long long bm = __ballot(u[kb] >= thr); const int lo_ = (int)(unsigned)bm, hi_ = (int)(unsigned)(bm >> 32); WRLANE2(word, lo_, hi_, (kb) * 2); }
            IDX_W(0) IDX_W(1) IDX_W(2) IDX_W(3) IDX_W(4) IDX_W(5) IDX_W(6) IDX_W(7) IDX_W(8) IDX_W(9) IDX_W(10) IDX_W(11) IDX_W(12) IDX_W(13) IDX_W(14) IDX_W(15)
            IDX_W(16) IDX_W(17) IDX_W(18) IDX_W(19) IDX_W(20) IDX_W(21) IDX_W(22) IDX_W(23) IDX_W(24) IDX_W(25) IDX_W(26) IDX_W(27) IDX_W(28) IDX_W(29) IDX_W(30) IDX_W(31)
#undef IDX_W
            MASK[(t0 + tk) * 64 + lane] = (unsigned)word;
        }
#undef IDX_SB
    }
    __syncthreads();
}

__device__ __forceinline__ void attn_phase(int wv, const unsigned char* proj, const unsigned* __restrict__ MASK, const float* __restrict__ q_norm, const float* __restrict__ k_norm, const float* __restrict__ rel_bias,
                           bf16_t* __restrict__ AO, unsigned char* lds) {
    const int tid = tid_fresh(wv), lane = tid & 63, w = wv  , fr = lane & 15, fq = lane >> 4;
    int vz = 0; asm volatile("" : "+v"(vz));
    const bf16_t* Q1 = (const bf16_t*)(proj + PJ_Q1); const bf16_t* Kn = (const bf16_t*)(proj + PJ_KN); const bf16_t* VT = (const bf16_t*)(proj + PJ_VT1);
    constexpr int ATT_BUF = 17408 + 18432;
    bf16_t* K_lds = (bf16_t*)lds;
    bf16_t* V_lds = (bf16_t*)(lds + 17408);
    float* bt = (float*)(lds + 2 * ATT_BUF);
    const float LOG2E = 1.4426950408889634f;
    float mq = 0.f, mk = 0.f;
    for (int i = 0; i < 128; ++i) { mq = fmaxf(mq, fabsf(q_norm[i])); mk = fmaxf(mk, fabsf(k_norm[i])); }
    const float Mb2 = 11.313708499f * mq * mk * LOG2E;
    __syncthreads();
    for (int i = tid; i < 128 * 16; i += NT) {
        const int d = i >> 4, h = i & 15;
        int bk = d;
        if (d >= 16) { bk = 16 + (int)(logf((float)d / 16.0f) / 2.0794415416798357f * 16.0f); bk = bk > 31 ? 31 : bk; }
        bt[i] = (rel_bias[bk * 16 + h] - rel_bias[31 * 16 + h]) * LOG2E;
    }
    __syncthreads();
    const int nunits = NB * 128;
    for (int uu = blockIdx.x; uu < nunits; uu += gridDim.x) {
        int b, q16;
        if (gridDim.x == 256) { b = blockIdx.x >> 4; const int r = blockIdx.x & 15, k = (uu - blockIdx.x) / 256; q16 = (k & 1) ? (k >> 1) * 32 + 31 - r : (k >> 1) * 32 + r; }
        else { b = uu >> 7; q16 = uu & 127; }
        const int p0 = q16 * 16;
        const size_t tb = (size_t)b * NS;
        v8i qf[2];
#pragma unroll
        for (int tk = 0; tk < 2; ++tk) {
            const size_t t = tb + p0 + 2 * w + tk;
            float f[32]; float ss = 0.f;
#pragma unroll
            for (int i = 0; i < 2; ++i) {
                const u32x4 v = *(const u32x4*)((const unsigned char*)Q1 + t * 2048 + fr * 128 + fq * 32 + i * 16);
                const int wds[4] = {(int)v.x, (int)v.y, (int)v.z, (int)v.w};
#pragma unroll
                for (int q4 = 0; q4 < 4; ++q4) {
                    f[i * 16 + q4 * 4 + 0] = __builtin_amdgcn_cvt_f32_fp8(wds[q4], 0); f[i * 16 + q4 * 4 + 1] = __builtin_amdgcn_cvt_f32_fp8(wds[q4], 1);
                    f[i * 16 + q4 * 4 + 2] = __builtin_amdgcn_cvt_f32_fp8(wds[q4], 2); f[i * 16 + q4 * 4 + 3] = __builtin_amdgcn_cvt_f32_fp8(wds[q4], 3);
                }
            }
#pragma unroll
            for (int i = 0; i < 32; ++i) ss += f[i] * f[i];
            ss += shx(ss, 16, lane); ss += shx(ss, 32, lane);
            const float rs = rsqrtf(ss * (1.0f / (128.0f * Q8_SCALE * Q8_SCALE)) + RMS_EPS) * (0.08838834764831845f * LOG2E * ATT_QS / Q8_SCALE);
            const float* qn = q_norm + fq * 32;
#pragma unroll
            for (int i = 0; i < 8; ++i) qf[tk][i] = (int)pack_fp8x4(f[i * 4 + 0] * rs * qn[i * 4 + 0], f[i * 4 + 1] * rs * qn[i * 4 + 1], f[i * 4 + 2] * rs * qn[i * 4 + 2], f[i * 4 + 3] * rs * qn[i * 4 + 3]);
        }
        f32x4 oacc[2][8];
#pragma unroll
        for (int tk = 0; tk < 2; ++tk)
#pragma unroll
            for (int dt = 0; dt < 8; ++dt) oacc[tk][dt] = (f32x4){0.f, 0.f, 0.f, 0.f};
        float lsum[2] = {0.f, 0.f};
        const int nkt = (p0 >> 6) + 1;
        const int kr0 = tid >> 3, kc0 = tid & 7, vr0 = tid >> 4, vc0 = tid & 15;
        const unsigned char* kgp = (const unsigned char*)Kn + (tb + kr0) * 128 + kc0 * 16;
        const bf16_t* vgp = VT + (tb + vr0) * 128 + vc0 * 8;
        const unsigned* mp0 = MASK + (tb + p0 + 2 * w) * 64 + vz;
        u32x4 kreg, vreg[2]; unsigned mreg[2][2];
        kreg = *(const u32x4*)(kgp);
        vreg[0] = *(const u32x4*)(vgp); vreg[1] = *(const u32x4*)(vgp + 32 * 128);
        mreg[0][0] = mp0[0]; mreg[0][1] = mp0[1]; mreg[1][0] = mp0[64]; mreg[1][1] = mp0[65];
        __syncthreads();
        *(u32x4*)((unsigned char*)K_lds + kr0 * 144 + kc0 * 16) = kreg;
        *(u32x4*)(V_lds + vr0 * 144 + vc0 * 8) = vreg[0]; *(u32x4*)(V_lds + (vr0 + 32) * 144 + vc0 * 8) = vreg[1];
        __syncthreads();
        for (int kt = 0; kt < nkt; ++kt) {
            const int s0 = kt * 64;
            const bf16_t* Kc = K_lds + (kt & 1) * (ATT_BUF / 2); const bf16_t* Vc = V_lds + (kt & 1) * (ATT_BUF / 2);
            const unsigned m00 = mreg[0][0], m01 = mreg[0][1], m10 = mreg[1][0], m11 = mreg[1][1];
            if (kt + 1 < nkt) {
                kreg = *(const u32x4*)(kgp + (size_t)(s0 + 64) * 128);
                vreg[0] = *(const u32x4*)(vgp + (size_t)(s0 + 64) * 128); vreg[1] = *(const u32x4*)(vgp + (size_t)(s0 + 64 + 32) * 128);
                mreg[0][0] = mp0[2 * kt + 2]; mreg[0][1] = mp0[2 * kt + 3]; mreg[1][0] = mp0[64 + 2 * kt + 2]; mreg[1][1] = mp0[64 + 2 * kt + 3];
            }
            const bool use_bias = (s0 + 63 + 128 > p0);
            f32x4 dA[2], dB[2]; unsigned pk[4][2][2];
            auto s_sub = [&](int sub, f32x4 (&d)[2]) {
                const unsigned char* kp = (const unsigned char*)Kc + (sub * 16 + fr) * 144 + fq * 32;
                const i32x4 klo = *(const i32x4*)kp, khi = *(const i32x4*)(kp + 16);
                const v8i kf = __builtin_shufflevector(klo, khi, 0, 1, 2, 3, 4, 5, 6, 7);
#pragma unroll
                for (int tk = 0; tk < 2; ++tk) {
                    d[tk] = (f32x4){-Mb2 * (ATT_QS * ATT_KS), -Mb2 * (ATT_QS * ATT_KS), -Mb2 * (ATT_QS * ATT_KS), -Mb2 * (ATT_QS * ATT_KS)};
                    d[tk] = __builtin_amdgcn_mfma_scale_f32_16x16x128_f8f6f4(kf, qf[tk], d[tk], 0, 0, 0, 0, 0, 0);
                }
            };
            auto soft = [&](int sub, const f32x4 (&d)[2]) {
#pragma unroll
                for (int tk = 0; tk < 2; ++tk) {
                    const int p = p0 + 2 * w + tk;
                    const unsigned mw = (sub < 2) ? (tk ? m10 : m00) : (tk ? m11 : m01);
                    const unsigned nib = (mw >> ((sub & 1) * 16 + fq * 4)) & 15u;
                    float pv[4];
                    f32x4 xx = d[tk] * (1.0f / (ATT_QS * ATT_KS));
                    if (use_bias) {
#pragma unroll
                        for (int j = 0; j < 4; ++j) { const int dd = p - (s0 + sub * 16 + fq * 4 + j); if (dd >= 0 && dd < 128) xx[j] += bt[dd * 16 + fr]; }
                    }
#pragma unroll
                    for (int j = 0; j < 4; ++j) {
                        const float x = xx[j];
                        float e = __builtin_amdgcn_exp2f(x);
                        e = ((nib >> j) & 1u) ? e : 0.f;
                        lsum[tk] += e; pv[j] = e;
                    }
                    pk[sub][tk][0] = cvt_pk_bf16(pv[0], pv[1]); pk[sub][tk][1] = cvt_pk_bf16(pv[2], pv[3]);
                }
            };
            auto pv_pair = [&](int kk) {
                bf16x8 pfr[2];
#pragma unroll
                for (int tk = 0; tk < 2; ++tk) { u32x4 a0; a0.x = pk[2 * kk][tk][0]; a0.y = pk[2 * kk][tk][1]; a0.z = pk[2 * kk + 1][tk][0]; a0.w = pk[2 * kk + 1][tk][1]; pfr[tk] = __builtin_bit_cast(bf16x8, a0); }
#pragma unroll
                for (int dt = 0; dt < 8; ++dt) {
                    const bf16_t* vp = Vc + ((2 * kk) * 16 + fq * 4 + (fr >> 2)) * 144 + dt * 16 + (fr & 3) * 4;
                    const s16x4_t va = __builtin_amdgcn_ds_read_tr16_b64_v4i16((__attribute__((address_space(3))) s16x4_t*)(vp));
                    const s16x4_t vb = __builtin_amdgcn_ds_read_tr16_b64_v4i16((__attribute__((address_space(3))) s16x4_t*)(vp + 16 * 144));
                    const bf16x8 vf = __builtin_bit_cast(bf16x8, __builtin_shufflevector(va, vb, 0, 1, 2, 3, 4, 5, 6, 7));
#pragma unroll
                    for (int tk = 0; tk < 2; ++tk) oacc[tk][dt] = __builtin_amdgcn_mfma_f32_16x16x32_bf16(vf, pfr[tk], oacc[tk][dt], 0, 0, 0);
                }
            };
            s_sub(0, dA);
            __builtin_amdgcn_sched_barrier(0);
            s_sub(1, dB); soft(0, dA);
            __builtin_amdgcn_sched_barrier(0);
            s_sub(2, dA); soft(1, dB); pv_pair(0);
            __builtin_amdgcn_sched_barrier(0);
            s_sub(3, dB); soft(2, dA);
            __builtin_amdgcn_sched_barrier(0);
            soft(3, dB); pv_pair(1);
            __builtin_amdgcn_sched_barrier(0);
            if (kt + 1 < nkt) {
                bf16_t* Kn_ = K_lds + ((kt + 1) & 1) * (ATT_BUF / 2); bf16_t* Vn_ = V_lds + ((kt + 1) & 1) * (ATT_BUF / 2);
                *(u32x4*)((unsigned char*)Kn_ + kr0 * 144 + kc0 * 16) = kreg;
                *(u32x4*)(Vn_ + vr0 * 144 + vc0 * 8) = vreg[0]; *(u32x4*)(Vn_ + (vr0 + 32) * 144 + vc0 * 8) = vreg[1];
            }
            __syncthreads();
        }
#pragma unroll
        for (int tk = 0; tk < 2; ++tk) {
            float l = lsum[tk];
            l += shx(l, 16, lane); l += shx(l, 32, lane);
            const float il = 1.0f / l;
            const size_t ob = (tb + p0 + 2 * w + tk) * 2048 + fr * 128 + fq * 4;
#pragma unroll
            for (int dt = 0; dt < 8; ++dt) {
                const f32x4 o = oacc[tk][dt] * il;
                if (F8_L1) *(unsigned*)((unsigned char*)AO + ob + dt * 16) = pack_fp8x4(o[0] * Y8_SCALE, o[1] * Y8_SCALE, o[2] * Y8_SCALE, o[3] * Y8_SCALE);
                else st_bf16x4(AO + ob + dt * 16, o);
            }
        }
    }
    __syncthreads();
}

#ifndef DUPMASK
#define DUPMASK 0
#endif
#define REPS(k) (((DUPMASK >> (k)) & 1) ? 2 : 1)

__device__ __forceinline__ unsigned char* opq(unsigned char* p) { asm volatile("" : "+s"(p)); return p; }

__global__ void __launch_bounds__(NT, 2) fwd(Args a_unused) {
    extern __shared__ __attribute__((aligned(16))) unsigned char lds[];
    volatile LAS unsigned* misc = (volatile LAS unsigned*)(lds + LDS_MISC);
    const int wv = __builtin_amdgcn_readfirstlane((int)(threadIdx.x >> 6));
    { const int t0 = tid_fresh(wv); if (t0 < 4) misc[t0] = 0u; }
    __syncthreads();
    XcdBarrier bar = xcd_barrier_post((unsigned*)(KA().ws() + WS_CTL), misc, wv);
    const int G = gridDim.x, bx = blockIdx.x;

    for (int rep = 0; rep < REPS(0); ++rep) { p0_prologue(wv, lds); xcd_barrier(bar); }

    for (int rep = 0; rep < REPS(1); ++rep) {
        const KA a; unsigned char* ws = a.ws();
        norm_phase<false, false, F8_P2, false, F8_P2_MIX>(wv, a.in(I_X), nullptr, a.in(I_NORM_MIX), (const float*)(ws + WS_MOD) + 0 * 16 * 6144, (bf16_t*)(ws + WS_H), lds, nullptr, nullptr, nullptr, nullptr, nullptr);
        xcd_barrier(bar);
    }
    for (int rep = 0; rep < REPS(2); ++rep) {
        const KA a; unsigned char* ws = a.ws();
        const int nM = NTOK / BM, nN = N_IN0 / BM;
        for (int k = 0, u = unit_index(0); u < nM * nN; u = unit_index(++k)) {
            int pm, pn; dense_tile(u, nN, pm, pn);
            RowPlain ro{(unsigned)(pm * BM) * ND, (unsigned)ND};
            const bool t8 = F8_P2 || (((unsigned)F8_P2_TILES >> pn) & 1u) != 0u;
            EpiIn0 E{ws + WS_PROJ, (const float2*)(ws + WS_ROT), pm, pn, (LAS bf16_t*)lds, wv, t8 ? 1.0f / W8_SCALE : 1.0f};
            if (t8) { RowPlain r8{(unsigned)(pm * BM) * (ND / 2), (unsigned)(ND / 2)};
                      gemm_unit<true>(wv, (bf16_t*)lds, (const bf16_t*)(F8_P2 ? ws + WS_H : ws + WS_H8), r8, (const bf16_t*)(ws + WS_WIN0F8 + (size_t)pn * BM * ND), ND / 2, ND / 2, E); }
            else gemm_unit<false>(wv, (bf16_t*)lds, (const bf16_t*)(ws + WS_H), ro, (const bf16_t*)(ws + WS_WIN0) + (size_t)pn * BM * ND, ND, ND, E);
        }
        xcd_barrier(bar);
    }
    for (int rep = 0; rep < REPS(3); ++rep) { const KA a; unsigned char* ws = a.ws(); retention_phase(wv, ws + WS_PROJ, (bf16_t*)(ws + WS_O), lds); xcd_barrier(bar); }
    for (int rep = 0; rep < REPS(4); ++rep) { const KA a; unsigned char* ws = a.ws(); ycat_phase(wv, ws + WS_PROJ, (const bf16_t*)(ws + WS_O), a.in(I_CONVW), a.in(I_CONVB), (bf16_t*)(ws + WS_H)); xcd_barrier(bar); }
    for (int rep = 0; rep < REPS(5); ++rep) {
        const KA a; unsigned char* ws = a.ws();
        const int nM = NTOK / BM, nN = ND / BM;
        for (int k = 0, u = unit_index(0); u < nM * nN; u = unit_index(++k)) {
            int pm, pn; dense_tile(u, nN, pm, pn);
            RowPlain ro{(unsigned)(pm * BM) * ND, (unsigned)ND};
            EpiRes<false, true> E{a.in(I_X), nullptr, (bf16_t*)(ws + WS_XB), (const float*)(ws + WS_MOD) + 0 * 16 * 6144 + 4096, pm, pn, F8_P5 ? 1.0f / (W8_SCALE * Y8_SCALE) : 1.0f};
            if (F8_P5) { RowPlain r8{(unsigned)(pm * BM) * (ND / 2), (unsigned)(ND / 2)}; gemm_unit<true>(wv, (bf16_t*)lds, (const bf16_t*)(ws + WS_H), r8, (const bf16_t*)(ws + WS_WOUT0 + (size_t)pn * BM * ND), ND / 2, ND / 2, E); }
            else gemm_unit<false>(wv, (bf16_t*)lds, (const bf16_t*)(ws + WS_H), ro, (const bf16_t*)(ws + WS_WOUT0) + (size_t)pn * BM * ND, ND, ND, E);
        }
        xcd_barrier(bar);
    }
    {
        const KA a; unsigned char* ws = a.ws();
        route_phase(wv, (const bf16_t*)(ws + WS_XB), a.in(I_NORM_FFN), (const float*)(ws + WS_MOD) + 1 * 16 * 6144, ws + WS_H, lds, a.in(I_WR), a.in(I_BR), (unsigned*)(ws + WS_CTL + CTL_CNT + 0 * 4096), (int*)(ws + WS_IDX), (float*)(ws + WS_GT));
        xcd_barrier(bar);
    }
    for (int rep = 0; rep < REPS(7); ++rep) { moe_phase1(wv, KA().ws(), 0, lds); xcd_barrier(bar); }
    { moe_phase2(wv, KA().ws(), 0, lds); xcd_barrier(bar); }

    for (int rep = 0; rep < REPS(9); ++rep) {
        const KA a; unsigned char* ws = a.ws();
        norm_phase<true, false, F8_L1 != 0, true, false, true>(wv, ws + WS_XB, (const bf16_t*)(ws + WS_TMP), a.in(I_NORM_MIX) + ND, (const float*)(ws + WS_MOD) + 2 * 16 * 6144, (bf16_t*)(ws + WS_H), lds, nullptr, nullptr, nullptr, nullptr, nullptr, (const bf16_t*)(ws + WS_TMP + 64 * MiB), (const float*)(ws + WS_MOD) + 1 * 16 * 6144 + 4096);
        xcd_barrier(bar);
    }
    for (int rep = 0; rep < REPS(10); ++rep) {
        const int nM = NTOK / BM, nN = N_IN1P / BM;
        for (int k = 0, u = unit_index(0); u < nM * nN; u = unit_index(++k)) {
            const KA a; unsigned char* ws = a.ws();
            int pm, pn; dense_tile(u, nN, pm, pn);
            RowPlain ro{(unsigned)(pm * BM) * ND, (unsigned)ND};
            EpiIn1 E{ws + WS_PROJ, pm, pn, F8_L1 ? 1.0f / W8_SCALE : 1.0f};
            if (F8_L1) { RowPlain r8{(unsigned)(pm * BM) * (ND / 2), (unsigned)(ND / 2)}; gemm_unit<true>(wv, (bf16_t*)lds, (const bf16_t*)(ws + WS_H), r8, (const bf16_t*)(ws + WS_WIN1 + (size_t)pn * BM * ND), ND / 2, ND / 2, E); }
            else gemm_unit<false>(wv, (bf16_t*)lds, (const bf16_t*)(ws + WS_H), ro, (const bf16_t*)(ws + WS_WIN1) + (size_t)pn * BM * ND, ND, ND, E);
        }
        xcd_barrier(bar);
    }
    for (int rep = 0; rep < REPS(11); ++rep) {
        const KA a; unsigned char* ws = a.ws();
        knorm_phase(wv, ws + WS_PROJ, a.in(I_KN), (bf16_t*)(ws + WS_PROJ + PJ_KN));
        indexer_phase(wv, ws + WS_PROJ, (unsigned*)(ws + WS_MASK), lds);
        xcd_barrier(bar);
    }
    for (int rep = 0; rep < REPS(12); ++rep) { const KA a; unsigned char* ws = a.ws(); attn_phase(wv, ws + WS_PROJ, (const unsigned*)(ws + WS_MASK), a.in(I_QN), a.in(I_KN), a.in(I_RELB), (bf16_t*)(ws + WS_H), lds); xcd_barrier(bar); }
    {
        const KA a; unsigned char* ws = a.ws();
        const int nM = NTOK / BM, nN = ND / BM;
        for (int k = 0, u = unit_index(0); u < nM * nN; u = unit_index(++k)) {
            int pm, pn; dense_tile(u, nN, pm, pn);
            RowPlain ro{(unsigned)(pm * BM) * ND, (unsigned)ND};
            EpiRes<false, false> E{ws + WS_XB, nullptr, (bf16_t*)(ws + WS_XB), (const float*)(ws + WS_MOD) + 2 * 16 * 6144 + 4096, pm, pn, F8_L1 ? 1.0f / (W8_SCALE * Y8_SCALE) : 1.0f};
            if (F8_L1) { RowPlain r8{(unsigned)(pm * BM) * (ND / 2), (unsigned)(ND / 2)}; gemm_unit<true>(wv, (bf16_t*)lds, (const bf16_t*)(ws + WS_H), r8, (const bf16_t*)(ws + WS_WOUT1 + (size_t)pn * BM * ND), ND / 2, ND / 2, E); }
            else gemm_unit<false>(wv, (bf16_t*)lds, (const bf16_t*)(ws + WS_H), ro, (const bf16_t*)(ws + WS_WOUT1) + (size_t)pn * BM * ND, ND, ND, E);
        }
        xcd_barrier(bar);
    }
    {
        const KA a; unsigned char* ws = a.ws();
        route_phase(wv, (const bf16_t*)(ws + WS_XB), a.in(I_NORM_FFN) + ND, (const float*)(ws + WS_MOD) + 3 * 16 * 6144, ws + WS_H, lds, a.in(I_WR), a.in(I_BR), (unsigned*)(ws + WS_CTL + CTL_CNT + 1 * 4096), (int*)(ws + WS_IDX), (float*)(ws + WS_GT));
        xcd_barrier(bar);
    }
    { moe_phase1(wv, KA().ws(), 1, lds); xcd_barrier(bar); }
    { moe_phase2(wv, KA().ws(), 1, lds); xcd_barrier(bar); }
    {
        const KA a; unsigned char* ws = a.ws();
        const bf16_t* tp = (const bf16_t*)(ws + WS_TMP); const bf16_t* xp = (const bf16_t*)(ws + WS_XB); f32x4* op = (f32x4*)a.out();
        const unsigned char* tp8 = (const unsigned char*)tp;
        for (size_t i = (size_t)bx * NT + tid_fresh(wv); i < (size_t)NTOK * ND / 8; i += (size_t)G * NT) {
            const u32x4 xv = *(const u32x4*)(xp + i * 8); const u32x2 tv = *(const u32x2*)(tp8 + i * 8), tw = *(const u32x2*)(tp8 + 64 * MiB + i * 8);
            const float* gp = (const float*)(ws + WS_MOD) + 3 * 16 * 6144 + 4096 + (size_t)((i * 8) >> 22) * 6144 + ((i * 8) & 2047);
            const f32x4 g0 = *(const f32x4*)gp * (1.0f / T8_SCALE), g1 = *(const f32x4*)(gp + 4) * (1.0f / T8_SCALE);
            f32x4 a0, a1;
            a0[0] = bflo(xv.x) + (__builtin_amdgcn_cvt_f32_fp8((int)tv.x, 0) + __builtin_amdgcn_cvt_f32_fp8((int)tw.x, 0)) * g0[0]; a0[1] = bfhi(xv.x) + (__builtin_amdgcn_cvt_f32_fp8((int)tv.x, 1) + __builtin_amdgcn_cvt_f32_fp8((int)tw.x, 1)) * g0[1];
            a0[2] = bflo(xv.y) + (__builtin_amdgcn_cvt_f32_fp8((int)tv.x, 2) + __builtin_amdgcn_cvt_f32_fp8((int)tw.x, 2)) * g0[2]; a0[3] = bfhi(xv.y) + (__builtin_amdgcn_cvt_f32_fp8((int)tv.x, 3) + __builtin_amdgcn_cvt_f32_fp8((int)tw.x, 3)) * g0[3];
            a1[0] = bflo(xv.z) + (__builtin_amdgcn_cvt_f32_fp8((int)tv.y, 0) + __builtin_amdgcn_cvt_f32_fp8((int)tw.y, 0)) * g1[0]; a1[1] = bfhi(xv.z) + (__builtin_amdgcn_cvt_f32_fp8((int)tv.y, 1) + __builtin_amdgcn_cvt_f32_fp8((int)tw.y, 1)) * g1[1];
            a1[2] = bflo(xv.w) + (__builtin_amdgcn_cvt_f32_fp8((int)tv.y, 2) + __builtin_amdgcn_cvt_f32_fp8((int)tw.y, 2)) * g1[2]; a1[3] = bfhi(xv.w) + (__builtin_amdgcn_cvt_f32_fp8((int)tv.y, 3) + __builtin_amdgcn_cvt_f32_fp8((int)tw.y, 3)) * g1[3];
            op[i * 2] = a0; op[i * 2 + 1] = a1;
        }
    }
}

extern "C" void kernel_launch(void* const* d_in, const int* in_sizes, int n_in, void* d_out, int out_size, void* d_ws, size_t ws_size, hipStream_t stream) {
    static int grid = 0;
    if (grid == 0) {
        int dev = 0, cus = 0, per_cu = 0;
        if (n_in != 22 || ws_size < WS_END) { fprintf(stderr, "kernel_launch: unexpected n_in %d / ws_size %zu (need %zu)\n", n_in, ws_size, (size_t)WS_END); grid = -1; return; }
        (void)hipGetDevice(&dev);
        (void)hipDeviceGetAttribute(&cus, hipDeviceAttributeMultiprocessorCount, dev);
        if (hipFuncSetAttribute((const void*)fwd, hipFuncAttributeMaxDynamicSharedMemorySize, LDS_BYTES) != hipSuccess) { fprintf(stderr, "kernel_launch: hipFuncSetAttribute failed\n"); grid = -1; return; }
        (void)hipOccupancyMaxActiveBlocksPerMultiprocessor(&per_cu, (const void*)fwd, NT, LDS_BYTES);
        (void)hipGetLastError();
        if (per_cu < 1) fprintf(stderr, "kernel_launch: occupancy query reports %d\n", per_cu);
        grid = cus;
    }
    if (grid < 0) return;
    (void)hipMemsetAsync((char*)d_ws + WS_CTL, 0, 65536 + 4 * 16 * 6144 * 4, stream);
    Args a{};
    for (int i = 0; i < 22; ++i) a.in[i] = (const float*)d_in[i];
    a.out = (float*)d_out; a.ws = (unsigned char*)d_ws;
    hipLaunchKernelGGL(fwd, dim3(grid), dim3(NT), LDS_BYTES, stream, a);
}
```

```cpp
#include <hip/hip_runtime.h>
#include <stdint.h>
#include <stdio.h>

#define XB_TMO      128
#define XB_XCNT(j)  (256  + 64 * (j))
#define XB_XSUB(j)  (1280 + 64 * (j))
#define XB_XGEN(j)  (2304 + 64 * (j))
#define XB_TOP      3328
#define XB_TOPGEN   3392
#define XCD_BAR_WORDS 3456
#define XB_SPIN_CAP (1u << 18)
#define LAS __attribute__((address_space(3)))
#define GAS __attribute__((address_space(1)))

__device__ __forceinline__ unsigned xb_ld(unsigned* p)              { return __hip_atomic_load(p, __ATOMIC_RELAXED, __HIP_MEMORY_SCOPE_AGENT); }
__device__ __forceinline__ unsigned xb_add(unsigned* p, unsigned v) { return __hip_atomic_fetch_add(p, v, __ATOMIC_RELAXED, __HIP_MEMORY_SCOPE_AGENT); }
__device__ __forceinline__ unsigned xb_xcc_id() { return (unsigned)__builtin_amdgcn_s_getreg((3 << 11) | 20) & 0xFu; }
#define XB_SPIN(cond, bar) do { unsigned _sp = 0; while (cond) { __builtin_amdgcn_s_sleep(1); \
    if ((++_sp & 255u) == 0u) { if (xb_ld(&(bar)[XB_TMO])) break; if (_sp > XB_SPIN_CAP) { atomicAdd(&(bar)[XB_TMO], 1u); break; } } } } while (0)

struct XcdBarrier { unsigned* bar; unsigned x; volatile LAS unsigned* st; int wv; };
__device__ __forceinline__ bool xb_thread0(int wv) { int l; asm volatile("v_mbcnt_lo_u32_b32 %0, -1, 0\n\tv_mbcnt_hi_u32_b32 %0, -1, %0" : "=v"(l)); return wv == 0 && l == 0; }

__device__ __forceinline__ XcdBarrier xcd_barrier_post(unsigned* bar, volatile LAS unsigned* st, int wv) {
    XcdBarrier b; b.bar = bar; b.x = xb_xcc_id(); b.st = st; b.wv = wv;
    if (xb_thread0(wv)) (void)xb_add(&bar[XB_XCNT(b.x)], 1u);
    return b;
}
__device__ __forceinline__ void xcd_barrier_complete(unsigned* bar, unsigned x, unsigned& nloc, unsigned& nx) {
    const unsigned G = gridDim.x * gridDim.y * gridDim.z;
    unsigned sum, cnt, mine, sp = 0u;
    for (;;) {
        sum = 0u; cnt = 0u; mine = 0u;
#pragma unroll
        for (unsigned j = 0; j < 16; ++j) { const unsigned c = xb_ld(&bar[XB_XCNT(j)]); sum += c; cnt += (c > 0u) ? 1u : 0u; mine = (j == x) ? c : mine; }
        if (sum == G) break;
        __builtin_amdgcn_s_sleep(1);
        if ((++sp & 255u) == 0u) { if (xb_ld(&bar[XB_TMO])) break; if (sp > XB_SPIN_CAP) { atomicAdd(&bar[XB_TMO], 1u); break; } }
    }
    nloc = mine > 0u ? mine : 1u; nx = cnt > 0u ? cnt : 1u;
}
__device__ __forceinline__ void xcd_barrier(const XcdBarrier& b) {
    asm volatile("s_waitcnt vmcnt(0)" ::: "memory");
    __syncthreads();
    if (xb_thread0(b.wv)) {
        unsigned* bar = b.bar; asm volatile("" : "+s"(bar));
        __builtin_amdgcn_s_waitcnt(0);
        unsigned nloc = b.st[0], nx = b.st[1];
        if (nloc == 0u) { xcd_barrier_complete(bar, b.x, nloc, nx); b.st[0] = nloc; b.st[1] = nx; }
        const unsigned old = xb_add(&bar[XB_XSUB(b.x)], 1u);
        const unsigned gen = old / nloc;
        if (old + 1u == (gen + 1u) * nloc) {
            __builtin_amdgcn_fence(__ATOMIC_RELEASE, "agent");
            asm volatile("s_waitcnt vmcnt(0)" ::: "memory");
            const unsigned og = xb_add(&bar[XB_TOP], 1u);
            const unsigned tg = og / nx;
            if (og + 1u == (tg + 1u) * nx) xb_add(&bar[XB_TOPGEN], 1u);
            else XB_SPIN(xb_ld(&bar[XB_TOPGEN]) == tg, bar);
            __builtin_amdgcn_fence(__ATOMIC_ACQUIRE, "agent");
            xb_add(&bar[XB_XGEN(b.x)], 1u);
            asm volatile("s_waitcnt vmcnt(0)" ::: "memory");
        } else {
            XB_SPIN(xb_ld(&bar[XB_XGEN(b.x)]) == gen, bar);
            __builtin_amdgcn_fence(__ATOMIC_ACQUIRE, "agent");
            asm volatile("s_waitcnt vmcnt(0)" ::: "memory");
        }
    }
    __syncthreads();
}

typedef unsigned short bf16_t;
typedef short bf16x8 __attribute__((ext_vector_type(8)));
typedef float f32x4 __attribute__((ext_vector_type(4)));
typedef unsigned u32x4 __attribute__((ext_vector_type(4)));
typedef unsigned u32x2 __attribute__((ext_vector_type(2)));

constexpr int NT = 512;
constexpr int NB = 16, NS = 2048, ND = 2048, NTOK = NB * NS;
constexpr int NE = 16, DEXP = 1024;
constexpr int N_IN0 = 7168, N_IN1 = 3408, N_IN1P = 3584;
constexpr float RMS_EPS = 1e-6f;
constexpr int LDS_MISC = 131072 + 2 * 64 * 144;
constexpr int LDS_BYTES = LDS_MISC + 8192;

constexpr size_t MiB = 1024ull * 1024ull;
constexpr size_t WS_CTL   = 0;
constexpr size_t CTL_CNT  = 16384;
constexpr size_t WS_MOD   = 64 * 1024;
constexpr size_t WS_ROT   = WS_MOD + 4ull * 16 * 6144 * 4;
constexpr size_t WS_IDX   = WS_ROT + 2048ull * 128 * 8;
constexpr size_t WS_GT    = WS_IDX + 16ull * 32768 * 4;
constexpr size_t WS_MASK  = WS_GT + 16ull * 32768 * 4;
constexpr size_t WS_WIN0  = 16 * MiB;
constexpr size_t WS_WOUT0 = WS_WIN0 + 28 * MiB;
constexpr size_t WS_WIN1  = WS_WOUT0 + 8 * MiB;
constexpr size_t WS_WOUT1 = WS_WIN1 + 14 * MiB;
constexpr size_t WS_W13   = WS_WOUT1 + 8 * MiB;
constexpr size_t WS_XB    = WS_W13 + 128 * MiB;
constexpr size_t WS_W2    = WS_W13 + 256 * MiB;
constexpr size_t WS_H     = WS_W2 + 128 * MiB;
constexpr size_t WS_O     = WS_H + 128 * MiB;
constexpr size_t WS_TMP   = WS_O + 64 * MiB;
constexpr size_t WS_PROJ  = WS_TMP + 128 * MiB;
constexpr size_t WS_END   = WS_PROJ + 448 * MiB;
constexpr size_t WS_TMP1  = WS_PROJ + 128 * MiB;
constexpr size_t WS_H8    = WS_O;
constexpr size_t WS_WIN0F8 = WS_W2 + 64 * MiB;
constexpr size_t PJ_AB = 0, PJ_U = 64 * MiB, PJ_Q = 128 * MiB, PJ_K = 192 * MiB, PJ_KT = 256 * MiB, PJ_VT = 320 * MiB, PJ_SG = 384 * MiB;
constexpr size_t PJ_Q1 = 0, PJ_QI = 128 * MiB, PJ_KR = 192 * MiB, PJ_VT1 = 200 * MiB, PJ_KI = 208 * MiB, PJ_WI = 212 * MiB, PJ_KN = 216 * MiB;
constexpr size_t PJ_ACT = 0;

struct Args { const float* in[22]; float* out; unsigned char* ws; };
#define CAS __attribute__((address_space(4)))
struct KA {
    const CAS unsigned char* kp;
    __device__ __forceinline__ KA() { kp = (const CAS unsigned char*)__builtin_amdgcn_kernarg_segment_ptr(); asm volatile("" : "+s"(kp)); }
    __device__ __forceinline__ const float* in(int i) const { return *(const float* const CAS*)(kp + 8 * i); }
    __device__ __forceinline__ float* out() const { return *(float* const CAS*)(kp + 8 * 22); }
    __device__ __forceinline__ unsigned char* ws() const { return *(unsigned char* const CAS*)(kp + 8 * 23); }
};
enum { I_X = 0, I_C, I_RELB, I_WR, I_BR, I_NORM_MIX, I_ADAW_MIX, I_ADAB_MIX, I_NORM_FFN, I_ADAW_FFN, I_ADAB_FFN, I_AB_WIN, I_CONVW, I_CONVB, I_AB_WOUT,
       I_C_WIN, I_QN, I_KN, I_C_WOUT, I_W1, I_W3, I_W2 };

typedef __bf16 bf16x2_t __attribute__((ext_vector_type(2)));
__device__ __forceinline__ unsigned cvt_pk_bf16(float lo, float hi) { bf16x2_t v = {(__bf16)lo, (__bf16)hi}; return __builtin_bit_cast(unsigned, v); }
__device__ __forceinline__ float bflo(unsigned u) { return __uint_as_float(u << 16); }
__device__ __forceinline__ float bfhi(unsigned u) { return __uint_as_float(u & 0xffff0000u); }
__device__ __forceinline__ f32x4 ld_bf16x4(const bf16_t* p) { const u32x2 t = *(const GAS u32x2*)p; return (f32x4){bflo(t.x), bfhi(t.x), bflo(t.y), bfhi(t.y)}; }
__device__ __forceinline__ float bf2f(bf16_t h) { return __uint_as_float((unsigned)h << 16); }
__device__ __forceinline__ bf16_t f2bf(float f) { return (bf16_t)(cvt_pk_bf16(f, 0.f) & 0xffffu); }
__device__ __forceinline__ float silu_f(float v) { return v * __builtin_amdgcn_rcpf(1.f + __builtin_amdgcn_exp2f(-1.4426950408889634f * v)); }
__device__ __forceinline__ int tid_fresh(int wv) {
    int l; asm volatile("v_mbcnt_lo_u32_b32 %0, -1, 0\n\tv_mbcnt_hi_u32_b32 %0, -1, %0" : "=v"(l));
    return wv * 64 + l;
}
__device__ __forceinline__ float shx(float v, int o, int lane) { return __int_as_float(__builtin_amdgcn_ds_bpermute((lane ^ o) << 2, __float_as_int(v))); }
__device__ __forceinline__ float shi(float v, int src) { return __int_as_float(__builtin_amdgcn_ds_bpermute(src << 2, __float_as_int(v))); }
__device__ __forceinline__ float wave_sum(float v, int lane) {
#pragma unroll
    for (int o = 32; o >= 1; o >>= 1) v += shx(v, o, lane);
    return v;
}

#ifndef F8_L1
#define F8_L1 1
#endif
#ifndef F8_P2_TILES
#define F8_P2_TILES 0xFFFFFFFu
#endif
#define F8_P2 ((F8_P2_TILES) == 0xFFFFFFFu)
#define F8_P2_MIX ((F8_P2_TILES) != 0u && (F8_P2_TILES) != 0xFFFFFFFu)

#ifndef F8_P5
#define F8_P5 1
#endif
constexpr float Y8_SCALE = 4.0f;
constexpr float W8_SCALE = 64.0f, A8_SCALE = 8.0f;
__device__ __forceinline__ float clamp8(float v) { return fminf(fmaxf(v, -448.0f), 448.0f); }
__device__ __forceinline__ unsigned pack_fp8x4(float a, float b, float c, float d) { int w; asm volatile("" : "=v"(w));     w = __builtin_amdgcn_cvt_pk_fp8_f32(clamp8(a), clamp8(b), w, false); w = __builtin_amdgcn_cvt_pk_fp8_f32(clamp8(c), clamp8(d), w, true); return (unsigned)w; }
template <bool FP8OUT>
__device__ __forceinline__ void tr_tile(int wv, const float* __restrict__ src, int ldn, int N, int k0, int n0, float* tile, bf16_t* dstbase, int ldk, int rowmap_kind) {
    const int tid = tid_fresh(wv);
#pragma unroll
    for (int it = 0; it < 2; ++it) {
        const int i = tid + it * NT, k = i >> 4, q = i & 15, n = n0 + q * 4;
        float4 v = make_float4(0.f, 0.f, 0.f, 0.f);
        if (n < N) v = *(const float4*)(src + (size_t)(k0 + k) * ldn + n);
        float* tp = tile + k * 65 + q * 4;
        tp[0] = v.x; tp[1] = v.y; tp[2] = v.z; tp[3] = v.w;
    }
    __syncthreads();
    {
        const int nl = tid >> 3, kc = tid & 7, n = n0 + nl;
        if (n < N) {
            float f[8];
#pragma unroll
            for (int j = 0; j < 8; ++j) f[j] = tile[(kc * 8 + j) * 65 + nl];
            int row = n;
            if (rowmap_kind == 1) {
                const int s = n >> 10, c = n & 1023;
                if (s == 1) row = 1024 + (c >> 7) * 256 + (c & 127);
                else if (s == 2) row = 1024 + (c >> 7) * 256 + 128 + (c & 127);
            } else if (rowmap_kind == 2) {
                row = (n >> 7) * 256 + (n & 127);
            } else if (rowmap_kind == 3) {
                row = (n >> 7) * 256 + 128 + (n & 127);
            }
            if (FP8OUT) {
                u32x2 o; o.x = pack_fp8x4(f[0] * W8_SCALE, f[1] * W8_SCALE, f[2] * W8_SCALE, f[3] * W8_SCALE); o.y = pack_fp8x4(f[4] * W8_SCALE, f[5] * W8_SCALE, f[6] * W8_SCALE, f[7] * W8_SCALE);
                *(u32x2*)((unsigned char*)dstbase + (size_t)row * ldk + k0 + kc * 8) = o;
            } else {
                u32x4 o; o.x = cvt_pk_bf16(f[0], f[1]); o.y = cvt_pk_bf16(f[2], f[3]); o.z = cvt_pk_bf16(f[4], f[5]); o.w = cvt_pk_bf16(f[6], f[7]);
                *(u32x4*)(dstbase + (size_t)row * ldk + k0 + kc * 8) = o;
            }
        }
    }
    __syncthreads();
}

constexpr int WT0 = 16 * 56, WT1 = WT0 + 256, WT2 = WT1 + 16 * 27, WT3 = WT2 + 256, WT4 = WT3 + 4096, WT5 = WT4 + 4096, WT6 = WT5 + 4096;
struct WTile { const float* src; unsigned char* dst; int ldn, N, k0, n0, ldk, kind, f8; };
__device__ __forceinline__ WTile wt_decode(int t) {
    const KA a; unsigned char* ws = a.ws();
    WTile d;
    if (t < WT0) { const int kt = t / 56, nt = t % 56;
        const int n = nt * 128, sct = n >> 10, c = n & 1023; const int row = (sct == 0) ? c : (sct == 1) ? 1024 + (c >> 7) * 256 + (c & 127) : (sct == 2) ? 1024 + (c >> 7) * 256 + 128 + (c & 127) : n;
        const int f8 = (int)(((unsigned)F8_P2_TILES >> (row >> 8)) & 1u);
        d = WTile{a.in(I_AB_WIN), f8 ? ws + WS_WIN0F8 : ws + WS_WIN0, 7168, 7168, kt * 128, nt * 128, 2048, 1, f8}; }
    else if (t < WT1) { const int u = t - WT0, kt = u / 16, nt = u % 16; d = WTile{a.in(I_AB_WOUT), ws + WS_WOUT0, 2048, 2048, kt * 128, nt * 128, 2048, 0, F8_P5}; }
    else if (t < WT2) { const int u = t - WT1, kt = u / 27, nt = u % 27; d = WTile{a.in(I_C_WIN), ws + WS_WIN1, N_IN1, N_IN1, kt * 128, nt * 128, 2048, 0, F8_L1}; }
    else if (t < WT3) { const int u = t - WT2, kt = u / 16, nt = u % 16; d = WTile{a.in(I_C_WOUT), ws + WS_WOUT1, 2048, 2048, kt * 128, nt * 128, 2048, 0, F8_L1}; }
    else if (t < WT5) { const bool is3 = t >= WT4; const int u = t - (is3 ? WT4 : WT3), mat = u / 128, v = u % 128, kt = v / 8, nt = v % 8;
        d = WTile{(is3 ? a.in(I_W3) : a.in(I_W1)) + (size_t)mat * 2048 * 1024, ws + WS_W13 + (size_t)mat * 2048 * 2048, 1024, 1024, kt * 128, nt * 128, 2048, is3 ? 3 : 2, 1}; }
    else { const int u = t - WT5, mat = u / 128, v = u % 128, kt = v / 16, nt = v % 16;
        d = WTile{a.in(I_W2) + (size_t)mat * 1024 * 2048, ws + WS_W2 + (size_t)mat * 2048 * 1024, 2048, 2048, kt * 128, nt * 128, 1024, 0, 1}; }
    return d;
}
constexpr int WT_L0 = WT2 + 3 * 2048, WT_L1 = (WT3 - WT2) + 3 * 2048;
__device__ __forceinline__ int wt_l0_tile(int p) { return p < WT2 ? p : p < WT2 + 2048 ? WT3 + (p - WT2) : p < WT2 + 4096 ? WT4 + (p - WT2 - 2048) : WT5 + (p - WT2 - 4096); }
__device__ __forceinline__ int wt_l1_tile(int q) { const int nd = WT3 - WT2; return q < nd ? WT2 + q : q < nd + 2048 ? WT3 + 2048 + (q - nd) : q < nd + 4096 ? WT4 + 2048 + (q - nd - 2048) : WT5 + 2048 + (q - nd - 4096); }
__device__ __forceinline__ int wt_row(const WTile& d, int n) {
    int row = n;
    if (d.kind == 1) { const int sct = n >> 10, c = n & 1023; if (sct == 1) row = 1024 + (c >> 7) * 256 + (c & 127); else if (sct == 2) row = 1024 + (c >> 7) * 256 + 128 + (c & 127); }
    else if (d.kind == 2) row = (n >> 7) * 256 + (n & 127);
    else if (d.kind == 3) row = (n >> 7) * 256 + 128 + (n & 127);
    return row;
}
__device__ __forceinline__ void p0_prologue(int wv, unsigned char* lds) {
    const int tid = tid_fresh(wv), G = gridDim.x, bx = blockIdx.x;
    const KA a; unsigned char* ws = a.ws();
    {
        float2* rot = (float2*)(ws + WS_ROT);
        for (int i = bx * NT + tid; i < 2048 * 128; i += G * NT) {
            const int pos = i >> 7, j = i & 127;
            const float inv = 1.0f / powf(10000.0f, (float)j / 127.0f);
            const float ang = (float)pos * inv;
            float s, c; sincosf(ang, &s, &c);
            rot[i] = make_float2(c, s);
        }
    }
    {
        constexpr int esz = F8_L1 ? 1 : 2;
        u32x4* z = (u32x4*)(ws + WS_WIN1 + (size_t)N_IN1 * 2048 * esz);
        const int n16 = (N_IN1P - N_IN1) * 2048 * esz / 16;
        for (int i = bx * NT + tid; i < n16; i += G * NT) z[i] = (u32x4){0u, 0u, 0u, 0u};
    }
    {
        float* sc = (float*)lds;
        float* red = (float*)(lds + 65536);
        float* mod = (float*)(ws + WS_MOD);
        const int lane = tid & 63, wave = tid >> 6;
        const int q = lane & 15, kg = (lane >> 4) + wave * 4;
        int cur_half = -1;
        for (int item = bx; item < 2 * 4 * 96; item += G) {
            const int half = item / (4 * 96), it2 = item % (4 * 96);
            const int w = it2 / 96, col0 = (it2 % 96) * 64;
            const float* adaw = (w & 1) ? a.in(I_ADAW_FFN) : a.in(I_ADAW_MIX);
            const float* adab = (w & 1) ? a.in(I_ADAB_FFN) : a.in(I_ADAB_MIX);
            const int layer = w >> 1;
            adaw += (size_t)layer * 2048 * 6144; adab += (size_t)layer * 6144;
            if (half != cur_half) {
                __syncthreads();
                for (int i = tid; i < 1024 * 16; i += NT) { const int k = i >> 4, b = i & 15; sc[i] = silu_f(a.in(I_C)[b * 2048 + half * 1024 + k]); }
                cur_half = half;
                __syncthreads();
            }
            float acc[16][4];
#pragma unroll
            for (int b = 0; b < 16; ++b) { acc[b][0] = 0.f; acc[b][1] = 0.f; acc[b][2] = 0.f; acc[b][3] = 0.f; }
            const float* wp = adaw + (size_t)(half * 1024 + kg * 32) * 6144 + col0 + q * 4;
            for (int kk0 = 0; kk0 < 32; kk0 += 4) {
                float4 wv8[4];
#pragma unroll
                for (int j = 0; j < 4; ++j) wv8[j] = *(const float4*)(wp + (size_t)(kk0 + j) * 6144);
#pragma unroll
                for (int j = 0; j < 4; ++j) {
                    const float4* sp = (const float4*)(sc + (kg * 32 + kk0 + j) * 16);
#pragma unroll
                    for (int b4 = 0; b4 < 4; ++b4) {
                        const float4 s4 = sp[b4];
                        const float sv[4] = {s4.x, s4.y, s4.z, s4.w};
#pragma unroll
                        for (int bb = 0; bb < 4; ++bb) {
                            acc[b4 * 4 + bb][0] += sv[bb] * wv8[j].x; acc[b4 * 4 + bb][1] += sv[bb] * wv8[j].y;
                            acc[b4 * 4 + bb][2] += sv[bb] * wv8[j].z; acc[b4 * 4 + bb][3] += sv[bb] * wv8[j].w;
                        }
                    }
                }
            }
#pragma unroll
            for (int b = 0; b < 16; ++b)
#pragma unroll
                for (int j = 0; j < 4; ++j) { float v = acc[b][j]; v += shx(v, 16, lane); v += shx(v, 32, lane); acc[b][j] = v; }
            __syncthreads();
            if (lane < 16) {
#pragma unroll
                for (int b = 0; b < 16; ++b) *(float4*)(red + (wave * 16 + b) * 64 + q * 4) = make_float4(acc[b][0], acc[b][1], acc[b][2], acc[b][3]);
            }
            __syncthreads();
            for (int i = tid; i < 1024; i += NT) {
                const int b = i >> 6, cidx = i & 63;
                float sm = (half == 0) ? adab[col0 + cidx] : 0.f;
#pragma unroll
                for (int wvi = 0; wvi < 8; ++wvi) sm += red[(wvi * 16 + b) * 64 + cidx];
                atomicAdd(mod + ((size_t)w * 16 + b) * 6144 + col0 + cidx, sm);
            }
        }
        __syncthreads();
    }
    {
        constexpr int T6 = WT_L0; typedef WTile TD;
        auto decode = [&](int p) { return wt_decode(wt_l0_tile(p)); };
        auto load8 = [&](const TD& d, float4 (&v)[8]) {
#pragma unroll
            for (int it = 0; it < 8; ++it) {
                const int i = tid + it * NT, k = i >> 5, q = i & 31, n = d.n0 + q * 4;
                v[it] = (n < d.N) ? *(const float4*)(d.src + (size_t)(d.k0 + k) * d.ldn + n) : make_float4(0.f, 0.f, 0.f, 0.f);
            }
        };
        float4 cur[8], nx1[8], nx2[8];
        int t = bx, buf = 0;
        TD d = decode(t < T6 ? t : 0), d1 = decode(t + G < T6 ? t + G : 0);
        if (t < T6) load8(d, cur);
        if (t + G < T6) load8(d1, nx1);
        __syncthreads();
        for (; t < T6; t += G) {
            float* tile = (float*)lds + buf * (128 * 129);
#pragma unroll
            for (int it = 0; it < 8; ++it) {
                const int i = tid + it * NT, k = i >> 5, q = i & 31;
                float* tp = tile + k * 129 + q * 4;
                tp[0] = cur[it].x; tp[1] = cur[it].y; tp[2] = cur[it].z; tp[3] = cur[it].w;
            }
            const TD d2 = decode(t + 2 * G < T6 ? t + 2 * G : t);
            if (t + 2 * G < T6) load8(d2, nx2);
            __syncthreads();
#pragma unroll
            for (int rep = 0; rep < 2; ++rep) {
                const int item = tid + rep * NT, nl = item >> 3, kc = item & 7, n = d.n0 + nl;
                if (n < d.N) {
                    float f[16];
#pragma unroll
                    for (int j = 0; j < 16; ++j) f[j] = tile[(kc * 16 + j) * 129 + nl];
                    int row = n;
                    if (d.kind == 1) { const int sct = n >> 10, c = n & 1023; if (sct == 1) row = 1024 + (c >> 7) * 256 + (c & 127); else if (sct == 2) row = 1024 + (c >> 7) * 256 + 128 + (c & 127); }
                    else if (d.kind == 2) row = (n >> 7) * 256 + (n & 127);
                    else if (d.kind == 3) row = (n >> 7) * 256 + 128 + (n & 127);
                    if (d.f8) {
                        u32x4 o;
                        o.x = pack_fp8x4(f[0] * W8_SCALE, f[1] * W8_SCALE, f[2] * W8_SCALE, f[3] * W8_SCALE); o.y = pack_fp8x4(f[4] * W8_SCALE, f[5] * W8_SCALE, f[6] * W8_SCALE, f[7] * W8_SCALE);
                        o.z = pack_fp8x4(f[8] * W8_SCALE, f[9] * W8_SCALE, f[10] * W8_SCALE, f[11] * W8_SCALE); o.w = pack_fp8x4(f[12] * W8_SCALE, f[13] * W8_SCALE, f[14] * W8_SCALE, f[15] * W8_SCALE);
                        *(u32x4*)(d.dst + (size_t)row * d.ldk + d.k0 + kc * 16) = o;
                    } else {
                        u32x4 o0, o1;
                        o0.x = cvt_pk_bf16(f[0], f[1]); o0.y = cvt_pk_bf16(f[2], f[3]); o0.z = cvt_pk_bf16(f[4], f[5]); o0.w = cvt_pk_bf16(f[6], f[7]);
                        o1.x = cvt_pk_bf16(f[8], f[9]); o1.y = cvt_pk_bf16(f[10], f[11]); o1.z = cvt_pk_bf16(f[12], f[13]); o1.w = cvt_pk_bf16(f[14], f[15]);
                        u32x4* op = (u32x4*)(d.dst + ((size_t)row * d.ldk + d.k0 + kc * 16) * 2);
                        op[0] = o0; op[1] = o1;
                    }
                }
            }
            d = d1; d1 = d2;
#pragma unroll
            for (int it = 0; it < 8; ++it) { cur[it] = nx1[it]; nx1[it] = nx2[it]; }
            buf ^= 1;
        }
        __syncthreads();
    }
}

template <bool ADD_TMP, bool ROUTE, bool OUT8, bool XBF, bool DUAL = false, bool WB = false>
__device__ __forceinline__ void norm_phase(int wv, const void* xsrc_, const bf16_t* __restrict__ tmp, const float* __restrict__ normw, const float* __restrict__ mod  ,
                           bf16_t* __restrict__ H, unsigned char* lds, const float* __restrict__ w_router, const float* __restrict__ b_router,
                           unsigned* __restrict__ cnt  , int* __restrict__ idx, float* __restrict__ gts, const bf16_t* __restrict__ tmp2 = nullptr, const float* __restrict__ gatev = nullptr  ) {
    const int tid = tid_fresh(wv), lane = tid & 63, wave = tid >> 6;
    float* wr_lds = (float*)lds;
    int* rt_e = (int*)(lds + 131072 + 64);
    (void)rt_e;
    if (ROUTE) {
        for (int i = tid; i < 2048 * 16; i += NT) { const int k = i >> 4, e = i & 15; wr_lds[e * 2048 + k] = w_router[i]; }
        __syncthreads();
    }
    float br[16];
    if (ROUTE) {
#pragma unroll
        for (int e = 0; e < 16; ++e) br[e] = b_router[e];
    }
    const int rows_per_block = NTOK / (int)gridDim.x;
    const int rows_per_wave = rows_per_block / 8;
    const int row0 = blockIdx.x * rows_per_block + wave * rows_per_wave;
    const int b = row0 / NS;
    float g[32], sh[32];
#pragma unroll
    for (int i = 0; i < 8; ++i) {
        const int c = i * 256 + lane * 4;
        const float4 nw = *(const float4*)(normw + c);
        const float4 s4 = *(const float4*)(mod + (size_t)b * 6144 + c);
        const float4 c4 = *(const float4*)(mod + (size_t)b * 6144 + 2048 + c);
        g[i * 4 + 0] = nw.x * (1.f + c4.x); g[i * 4 + 1] = nw.y * (1.f + c4.y); g[i * 4 + 2] = nw.z * (1.f + c4.z); g[i * 4 + 3] = nw.w * (1.f + c4.w);
        sh[i * 4 + 0] = s4.x; sh[i * 4 + 1] = s4.y; sh[i * 4 + 2] = s4.z; sh[i * 4 + 3] = s4.w;
    }
    float gt[32];
    if (WB) {
#pragma unroll
        for (int i = 0; i < 8; ++i) { const float4 g4 = *(const float4*)(gatev + (size_t)b * 6144 + i * 256 + lane * 4); gt[i * 4 + 0] = g4.x * (1.0f / 16.0f); gt[i * 4 + 1] = g4.y * (1.0f / 16.0f); gt[i * 4 + 2] = g4.z * (1.0f / 16.0f); gt[i * 4 + 3] = g4.w * (1.0f / 16.0f); }
    }
    for (int r = 0; r < rows_per_wave; ++r) {
        const int t = row0 + r;
        float v[32];
        float ss = 0.f;
#pragma unroll
        for (int i = 0; i < 8; ++i) {
            const int c = i * 256 + lane * 4;
            float4 x4;
            if (XBF) { const f32x4 xb = ld_bf16x4((const bf16_t*)xsrc_ + (size_t)t * ND + c); x4 = make_float4(xb[0], xb[1], xb[2], xb[3]); }
            else x4 = *(const float4*)((const float*)xsrc_ + (size_t)t * ND + c);
            if (ADD_TMP && !WB) {
                const u32x2 tv = *(const u32x2*)(tmp + (size_t)t * ND + c);
                x4.x += bflo(tv.x); x4.y += bfhi(tv.x); x4.z += bflo(tv.y); x4.w += bfhi(tv.y);
            }
            if (WB) {
                const int tv = *(const int*)((const unsigned char*)tmp + (size_t)t * ND + c), tw = *(const int*)((const unsigned char*)tmp2 + (size_t)t * ND + c);
                x4.x += (__builtin_amdgcn_cvt_f32_fp8(tv, 0) + __builtin_amdgcn_cvt_f32_fp8(tw, 0)) * gt[i * 4 + 0]; x4.y += (__builtin_amdgcn_cvt_f32_fp8(tv, 1) + __builtin_amdgcn_cvt_f32_fp8(tw, 1)) * gt[i * 4 + 1];
                x4.z += (__builtin_amdgcn_cvt_f32_fp8(tv, 2) + __builtin_amdgcn_cvt_f32_fp8(tw, 2)) * gt[i * 4 + 2]; x4.w += (__builtin_amdgcn_cvt_f32_fp8(tv, 3) + __builtin_amdgcn_cvt_f32_fp8(tw, 3)) * gt[i * 4 + 3];
                u32x2 o; o.x = cvt_pk_bf16(x4.x, x4.y); o.y = cvt_pk_bf16(x4.z, x4.w);
                *(u32x2*)((bf16_t*)xsrc_ + (size_t)t * ND + c) = o;
            }
            v[i * 4 + 0] = x4.x; v[i * 4 + 1] = x4.y; v[i * 4 + 2] = x4.z; v[i * 4 + 3] = x4.w;
            ss += x4.x * x4.x + x4.y * x4.y + x4.z * x4.z + x4.w * x4.w;
        }
        ss = wave_sum(ss, lane);
        const float rs = rsqrtf(ss * (1.0f / ND) + RMS_EPS);
#pragma unroll
        for (int i = 0; i < 32; ++i) v[i] = v[i] * rs * g[i] + sh[i];
#pragma unroll
        for (int i = 0; i < 8; ++i) {
            const int c = i * 256 + lane * 4;
            if (DUAL) *(unsigned*)((unsigned char*)H + (size_t)(WS_H8 - WS_H) + (size_t)t * ND + c) = pack_fp8x4(v[i * 4 + 0], v[i * 4 + 1], v[i * 4 + 2], v[i * 4 + 3]);
            if (OUT8) {
                *(unsigned*)((unsigned char*)H + (size_t)t * ND + c) = pack_fp8x4(v[i * 4 + 0], v[i * 4 + 1], v[i * 4 + 2], v[i * 4 + 3]);
            } else {
                u32x2 o; o.x = cvt_pk_bf16(v[i * 4 + 0], v[i * 4 + 1]); o.y = cvt_pk_bf16(v[i * 4 + 2], v[i * 4 + 3]);
                *(u32x2*)(H + (size_t)t * ND + c) = o;
            }
        }
        if (ROUTE) {
            float lg[16];
            int lo = lane * 4; asm volatile("" : "+v"(lo));
#pragma unroll
            for (int e = 0; e < 16; ++e) {
                float s = 0.f;
#pragma unroll
                for (int i = 0; i < 8; ++i) {
                    const float4 w4 = *(const float4*)(wr_lds + e * 2048 + i * 256 + lo);
                    s += v[i * 4 + 0] * w4.x + v[i * 4 + 1] * w4.y + v[i * 4 + 2] * w4.z + v[i * 4 + 3] * w4.w;
                }
                lg[e] = wave_sum(s, lane);
            }
            float mx = lg[0];
#pragma unroll
            for (int e = 1; e < 16; ++e) mx = fmaxf(mx, lg[e]);
            float p[16], sum = 0.f;
#pragma unroll
            for (int e = 0; e < 16; ++e) { p[e] = __expf(lg[e] - mx); sum += p[e]; }
            const float isum = 1.f / sum;
            float sel[16];
#pragma unroll
            for (int e = 0; e < 16; ++e) { p[e] *= isum; sel[e] = p[e] + br[e]; }
            int grp = 0; float best = -1e30f;
#pragma unroll
            for (int gI = 0; gI < 4; ++gI) {
                float m1 = -1e30f, m2 = -1e30f;
#pragma unroll
                for (int j = 0; j < 4; ++j) { const float s = sel[gI * 4 + j]; if (s > m1) { m2 = m1; m1 = s; } else if (s > m2) { m2 = s; } }
                const float gs = m1 + m2;
                if (gs > best) { best = gs; grp = gI; }
            }
            float s4[4], p4[4];
#pragma unroll
            for (int j = 0; j < 4; ++j) { s4[j] = 0.f; p4[j] = 0.f; }
#pragma unroll
            for (int gI = 0; gI < 4; ++gI)
#pragma unroll
                for (int j = 0; j < 4; ++j) if (grp == gI) { s4[j] = sel[gI * 4 + j]; p4[j] = p[gI * 4 + j]; }
            int i1 = 0; float v1 = s4[0];
#pragma unroll
            for (int j = 1; j < 4; ++j) if (s4[j] > v1) { v1 = s4[j]; i1 = j; }
            int i2 = -1; float v2 = -1e30f;
#pragma unroll
            for (int j = 0; j < 4; ++j) if (j != i1 && s4[j] > v2) { v2 = s4[j]; i2 = j; }
            float pa = 0.f, pb = 0.f;
#pragma unroll
            for (int j = 0; j < 4; ++j) { if (j == i1) pa = p4[j]; if (j == i2) pb = p4[j]; }
            const float inv = 1.f / (pa + pb);
            if (lane == 0) {
                const int e0 = grp * 4 + i1, e1 = grp * 4 + i2;
                const unsigned p0 = atomicAdd(cnt + e0 * 64, 1u);
                const unsigned p1 = atomicAdd(cnt + e1 * 64, 1u);
                idx[e0 * 32768 + p0] = t * 2 + 0; gts[e0 * 32768 + p0] = pa * inv;
                idx[e1 * 32768 + p1] = t * 2 + 1; gts[e1 * 32768 + p1] = pb * inv;
            }
        }
    }
    __syncthreads();
}

#define DPP_ADD(v, CTRL) ((v) + __int_as_float(__builtin_amdgcn_update_dpp(0, __float_as_int(v), (CTRL), 0xf, 0xf, false)))
#define DPP_GET(v, CTRL) __int_as_float(__builtin_amdgcn_update_dpp(0, __float_as_int(v), (CTRL), 0xf, 0xf, false))
__device__ __forceinline__ float swap32_sum(float a, float b) {
    const auto r = __builtin_amdgcn_permlane32_swap(__float_as_uint(a), __float_as_uint(b), false, false);
    return __uint_as_float(r[0]) + __uint_as_float(r[1]);
}
__device__ __forceinline__ float swap16_sum(float a, float b) {
    const auto r = __builtin_amdgcn_permlane16_swap(__float_as_uint(a), __float_as_uint(b), false, false);
    return __uint_as_float(r[0]) + __uint_as_float(r[1]);
}
__device__ __forceinline__ float bfly16(const float (&pl)[16], int lane) {
    float a8[8], a4[4], a2[2], a1;
#pragma unroll
    for (int i = 0; i < 8; ++i) a8[i] = swap32_sum(pl[i], pl[8 + i]);
#pragma unroll
    for (int i = 0; i < 4; ++i) a4[i] = swap16_sum(a8[i], a8[4 + i]);
    { const bool hi = (lane & 2) != 0;
#pragma unroll
      for (int i = 0; i < 2; ++i) { const float keep = hi ? a4[2 + i] : a4[i], send = hi ? a4[i] : a4[2 + i]; a2[i] = keep + DPP_GET(send, 0x4e  ); } }
    { const bool hi = (lane & 1) != 0; const float keep = hi ? a2[1] : a2[0], send = hi ? a2[0] : a2[1]; a1 = keep + DPP_GET(send, 0xb1  ); }
    return a1 + DPP_GET(a1, 0x124) + DPP_GET(a1, 0x128) + DPP_GET(a1, 0x12c);
}
__device__ __forceinline__ int bfly16_slot(int lane) { return ((lane >> 5) & 1) * 8 + ((lane >> 4) & 1) * 4 + (lane & 3); }
__device__ __forceinline__ float wave_total(float v) {
    v = swap32_sum(v, v); v = swap16_sum(v, v);
    v = v + DPP_GET(v, 0x124) + DPP_GET(v, 0x128) + DPP_GET(v, 0x12c);
    v = DPP_ADD(v, 0x4e); v = DPP_ADD(v, 0xb1);
    return v;
}
__device__ __forceinline__ void route_phase(int wv, const bf16_t* __restrict__ XB, const float* __restrict__ normw, const float* __restrict__ mod, unsigned char* __restrict__ H8, unsigned char* lds,
                                            const float* __restrict__ w_router, const float* __restrict__ b_router, unsigned* __restrict__ cnt, int* __restrict__ idx, float* __restrict__ gts) {
    const int tid = tid_fresh(wv), lane = tid & 63, w = tid >> 6, fr = lane & 15, fq = lane >> 4;
    constexpr int RB = 128;
    constexpr int GWP = 2048 + 8;
    bf16_t* gwh = (bf16_t*)lds;
    bf16_t* gwl = gwh + 16 * GWP;
    float* part = (float*)(gwl + 16 * GWP);
    float* part_c = part + RB * 17;
    float* rs_lds = part_c + 128;
    unsigned* lcnt = (unsigned*)(rs_lds + RB);
    const int row0 = blockIdx.x * RB;
    const int st = w & 3, rh = w >> 2;
    const int b = row0 / NS, col0 = st * 512 + lane * 8;
    float gg[8], shv[8];
#pragma unroll
    for (int h4 = 0; h4 < 2; ++h4) {
        const float4 nw = *(const float4*)(normw + col0 + h4 * 4);
        const float4 s4 = *(const float4*)(mod + (size_t)b * 6144 + col0 + h4 * 4);
        const float4 c4 = *(const float4*)(mod + (size_t)b * 6144 + 2048 + col0 + h4 * 4);
        gg[h4 * 4 + 0] = nw.x * (1.f + c4.x); gg[h4 * 4 + 1] = nw.y * (1.f + c4.y); gg[h4 * 4 + 2] = nw.z * (1.f + c4.z); gg[h4 * 4 + 3] = nw.w * (1.f + c4.w);
        shv[h4 * 4 + 0] = s4.x; shv[h4 * 4 + 1] = s4.y; shv[h4 * 4 + 2] = s4.z; shv[h4 * 4 + 3] = s4.w;
    }
    __syncthreads();
    {
        const int k0 = tid * 4;
        const float4 nw = *(const float4*)(normw + k0);
        const float4 s4 = *(const float4*)(mod + (size_t)b * 6144 + k0);
        const float4 c4 = *(const float4*)(mod + (size_t)b * 6144 + 2048 + k0);
        const float gk[4] = {nw.x * (1.f + c4.x), nw.y * (1.f + c4.y), nw.z * (1.f + c4.z), nw.w * (1.f + c4.w)};
        const float sk[4] = {s4.x, s4.y, s4.z, s4.w};
        float ce[16];
#pragma unroll
        for (int e = 0; e < 16; ++e) ce[e] = 0.f;
        float wk[4][16];
#pragma unroll
        for (int j = 0; j < 4; ++j)
#pragma unroll
            for (int e4 = 0; e4 < 4; ++e4) {
                const float4 wr = *(const float4*)(w_router + (size_t)(k0 + j) * 16 + e4 * 4);
                wk[j][e4 * 4 + 0] = wr.x; wk[j][e4 * 4 + 1] = wr.y; wk[j][e4 * 4 + 2] = wr.z; wk[j][e4 * 4 + 3] = wr.w;
            }
#pragma unroll
        for (int e = 0; e < 16; ++e) {
            float hi[4], lo[4];
#pragma unroll
            for (int j = 0; j < 4; ++j) { const float v = gk[j] * wk[j][e]; ce[e] += sk[j] * wk[j][e]; hi[j] = bf2f(f2bf(v)); lo[j] = v - hi[j]; }
            u32x2 oh, ol; oh.x = cvt_pk_bf16(hi[0], hi[1]); oh.y = cvt_pk_bf16(hi[2], hi[3]); ol.x = cvt_pk_bf16(lo[0], lo[1]); ol.y = cvt_pk_bf16(lo[2], lo[3]);
            *(u32x2*)(gwh + e * GWP + k0) = oh; *(u32x2*)(gwl + e * GWP + k0) = ol;
        }
        const float ct = bfly16(ce, lane);
        if ((lane & 12) == 0) part_c[w * 16 + bfly16_slot(lane)] = ct;
        if (tid < 16) lcnt[tid] = 0u;
    }
    __syncthreads();
    {
        const bf16_t* xp = XB + (size_t)(row0 + w * 16 + fr) * ND + fq * 8;
        const bf16_t* hp = gwh + fr * GWP + fq * 8;
        const bf16_t* lp = gwl + fr * GWP + fq * 8;
        f32x4 ah[2], al[2], sq[2];
        ah[0] = ah[1] = al[0] = al[1] = sq[0] = sq[1] = (f32x4){0.f, 0.f, 0.f, 0.f};
        bf16x8 xa[8], xn[8];
#pragma unroll
        for (int i = 0; i < 8; ++i) xa[i] = *(const bf16x8*)(xp + i * 32);
        for (int kb = 0; kb < 64; kb += 8) {
            const int kn = (kb + 8 < 64) ? kb + 8 : kb;
#pragma unroll
            for (int i = 0; i < 8; ++i) xn[i] = *(const bf16x8*)(xp + (kn + i) * 32);
#pragma unroll
            for (int i = 0; i < 8; ++i) {
                const bf16x8 bh = *(const bf16x8*)(hp + (kb + i) * 32), bl = *(const bf16x8*)(lp + (kb + i) * 32);
                ah[i & 1] = __builtin_amdgcn_mfma_f32_16x16x32_bf16(xa[i], bh, ah[i & 1], 0, 0, 0);
                al[i & 1] = __builtin_amdgcn_mfma_f32_16x16x32_bf16(xa[i], bl, al[i & 1], 0, 0, 0);
                sq[i & 1] = __builtin_amdgcn_mfma_f32_16x16x32_bf16(xa[i], xa[i], sq[i & 1], 0, 0, 0);
            }
#pragma unroll
            for (int i = 0; i < 8; ++i) xa[i] = xn[i];
        }
#pragma unroll
        for (int j = 0; j < 4; ++j) {
            float* pr = part + (size_t)(w * 16 + fq * 4 + j) * 17;
            pr[fr] = (ah[0][j] + ah[1][j]) + (al[0][j] + al[1][j]);
            if (fr == fq * 4 + j) pr[16] = sq[0][j] + sq[1][j];
        }
    }
    __syncthreads();
    int re0 = 0, re1 = 0; unsigned rp0 = 0, rp1 = 0; float rg0 = 0.f, rg1 = 0.f;
    if (tid < RB) {
        float lg[16], ss = 0.f;
#pragma unroll
        for (int e = 0; e < 16; ++e) lg[e] = 0.f;
        {
            const float* pr = part + (size_t)tid * 17;
#pragma unroll
            for (int e = 0; e < 16; ++e) lg[e] += pr[e];
            ss += pr[16];
        }
        const float rs = rsqrtf(ss * (1.0f / ND) + RMS_EPS);
        rs_lds[tid] = rs;
#pragma unroll
        for (int e = 0; e < 16; ++e) {
            float c = 0.f;
#pragma unroll
            for (int ww = 0; ww < 8; ++ww) c += part_c[ww * 16 + e];
            lg[e] = lg[e] * rs + c;
        }
        float mx = lg[0];
#pragma unroll
        for (int e = 1; e < 16; ++e) mx = fmaxf(mx, lg[e]);
        float p[16], sum = 0.f;
#pragma unroll
        for (int e = 0; e < 16; ++e) { p[e] = __expf(lg[e] - mx); sum += p[e]; }
        const float isum = 1.f / sum;
        float sel[16];
#pragma unroll
        for (int e = 0; e < 16; ++e) { p[e] *= isum; sel[e] = p[e] + b_router[e]; }
        int grp = 0; float best = -1e30f;
#pragma unroll
        for (int gI = 0; gI < 4; ++gI) {
            float m1 = -1e30f, m2 = -1e30f;
#pragma unroll
            for (int j = 0; j < 4; ++j) { const float sv = sel[gI * 4 + j]; if (sv > m1) { m2 = m1; m1 = sv; } else if (sv > m2) { m2 = sv; } }
            const float gs = m1 + m2;
            if (gs > best) { best = gs; grp = gI; }
        }
        float s4[4], p4[4];
#pragma unroll
        for (int j = 0; j < 4; ++j) { s4[j] = 0.f; p4[j] = 0.f; }
#pragma unroll
        for (int gI = 0; gI < 4; ++gI)
#pragma unroll
            for (int j = 0; j < 4; ++j) if (grp == gI) { s4[j] = sel[gI * 4 + j]; p4[j] = p[gI * 4 + j]; }
        int i1 = 0; float v1 = s4[0];
#pragma unroll
        for (int j = 1; j < 4; ++j) if (s4[j] > v1) { v1 = s4[j]; i1 = j; }
        int i2 = -1; float v2 = -1e30f;
#pragma unroll
        for (int j = 0; j < 4; ++j) if (j != i1 && s4[j] > v2) { v2 = s4[j]; i2 = j; }
        float pa = 0.f, pb = 0.f;
#pragma unroll
        for (int j = 0; j < 4; ++j) { if (j == i1) pa = p4[j]; if (j == i2) pb = p4[j]; }
        const float inv = 1.f / (pa + pb);
        re0 = grp * 4 + i1; re1 = grp * 4 + i2; rg0 = pa * inv; rg1 = pb * inv;
        rp0 = atomicAdd(&lcnt[re0], 1u);
        rp1 = atomicAdd(&lcnt[re1], 1u);
    }
    __syncthreads();
    if (tid < 16) lcnt[16 + tid] = atomicAdd(cnt + tid * 64, lcnt[tid]);
    __syncthreads();
    if (tid < RB) {
        const int t = row0 + tid;
        const unsigned p0 = lcnt[16 + re0] + rp0, p1 = lcnt[16 + re1] + rp1;
        idx[re0 * 32768 + p0] = t * 2 + 0; gts[re0 * 32768 + p0] = rg0;
        idx[re1 * 32768 + p1] = t * 2 + 1; gts[re1 * 32768 + p1] = rg1;
    }
    for (int rb = 0; rb < 64; rb += 8) {
        u32x4 xr[8];
#pragma unroll
        for (int q = 0; q < 8; ++q) xr[q] = *(const u32x4*)(XB + (size_t)(row0 + rh * 64 + rb + q) * ND + col0);
#pragma unroll
        for (int q = 0; q < 8; ++q) {
            const float rs = rs_lds[rh * 64 + rb + q];
            u32x2 o;
            o.x = pack_fp8x4(bflo(xr[q].x) * rs * gg[0] + shv[0], bfhi(xr[q].x) * rs * gg[1] + shv[1], bflo(xr[q].y) * rs * gg[2] + shv[2], bfhi(xr[q].y) * rs * gg[3] + shv[3]);
            o.y = pack_fp8x4(bflo(xr[q].z) * rs * gg[4] + shv[4], bfhi(xr[q].z) * rs * gg[5] + shv[5], bflo(xr[q].w) * rs * gg[6] + shv[6], bfhi(xr[q].w) * rs * gg[7] + shv[7]);
            *(u32x2*)(H8 + (size_t)(row0 + rh * 64 + rb + q) * ND + col0) = o;
        }
    }
    __syncthreads();
}

constexpr int BM = 256, BK = 64, HALF = 128, HT = HALF * BK;
__device__ __forceinline__ int lds_byte(int r, int c) {
    const int st = (r >> 4) * 2 + (c >> 5), rr = r & 15, cc = c & 31, ob = rr * 64 + cc * 2;
    return st * 1024 + (ob ^ (((ob >> 9) & 1) << 5));
}
__device__ __forceinline__ void stage_rc(int b, int& R, int& C) {
    const int st = b / 1024, sb = b % 1024, swz = sb ^ (((sb >> 9) & 1) << 5);
    R = (st >> 1) * 16 + swz / 64; C = (st & 1) * 32 + (swz % 64) / 2;
}

typedef int v8i __attribute__((ext_vector_type(8)));
typedef int i32x4 __attribute__((ext_vector_type(4)));
template <bool F8, class RowOff, class Epi>
__device__ __forceinline__ void gemm_unit(int wv, bf16_t* shm, const bf16_t* __restrict__ A_in, const RowOff& rowoff, const bf16_t* __restrict__ Bt_in, int ldb, int K, const Epi& epi) {
    const bf16_t* A; const bf16_t* Bt;
#define SA(b, h) (shm + ((b) * 2 + (h)) * HT)
#define SB(b, h) (shm + (4 + (b) * 2 + (h)) * HT)
#define GLDS(sbase, voff, m0v) do { unsigned _keep; asm volatile("s_mov_b32 %0, m0\n\ts_mov_b32 m0, %3\n\ts_nop 0\n\tglobal_load_lds_dwordx4 %1, %2\n\ts_mov_b32 m0, %0" \
        : "=&s"(_keep) : "v"(voff), "s"(sbase), "s"(m0v) : "memory"); } while (0)
#define STAGE_A(P, h, kt) do { const char* _ab = (const char*)A + (size_t)(kt) * (BK * 2) + (h) * a_h; const unsigned _m0 = ldsb + (unsigned)((char*)(P) - (char*)shm) + (unsigned)wv * 1024u; \
        GLDS(_ab, aoff[h][0], _m0); GLDS(_ab + a_i, aoff[h][1], _m0 + 8192u); } while (0)
#define STAGE_B(P, h, kt) do { const char* _bb = (const char*)Bt + ((size_t)((h) * HALF) * ldb + (size_t)(kt) * BK) * 2; const unsigned _m0 = ldsb + (unsigned)((char*)(P) - (char*)shm) + (unsigned)wv * 1024u; \
        GLDS(_bb, boff, _m0); GLDS(_bb + (size_t)64 * ldb * 2, boff, _m0 + 8192u); } while (0)
#define LDFRAG(dst, base, row) do { const i32x4 _lo = *reinterpret_cast<const i32x4*>((char*)(base) + lds_byte((row), fq * 8)); \
        const i32x4 _hi = *reinterpret_cast<const i32x4*>((char*)(base) + lds_byte((row), 32 + fq * 8)); \
        dst = __builtin_shufflevector(_lo, _hi, 0, 1, 2, 3, 4, 5, 6, 7); } while (0)
#define LDA(dst, b, h) _Pragma("unroll") for (int m = 0; m < 4; ++m) LDFRAG(dst[m], SA(b, h), wr * 64 + m * 16 + fr)
#define LDB(dst, b, h) _Pragma("unroll") for (int n = 0; n < 2; ++n) LDFRAG(dst[n], SB(b, h), wc * 32 + n * 16 + fr)
#define MMA(ai, bj, Af, Bf) do { __builtin_amdgcn_s_setprio(1); \
        _Pragma("unroll") for (int m = 0; m < 4; ++m) _Pragma("unroll") for (int n = 0; n < 2; ++n) { \
            if (F8) acc[ai][bj][m][n] = __builtin_amdgcn_mfma_scale_f32_16x16x128_f8f6f4(Bf[n], Af[m], acc[ai][bj][m][n], 0, 0, 0, 0, 0, 0);     \
            else { acc[ai][bj][m][n] = __builtin_amdgcn_mfma_f32_16x16x32_bf16(__builtin_bit_cast(bf16x8, __builtin_shufflevector(Bf[n], Bf[n], 0, 1, 2, 3)), __builtin_bit_cast(bf16x8, __builtin_shufflevector(Af[m], Af[m], 0, 1, 2, 3)), acc[ai][bj][m][n], 0, 0, 0); \
                   acc[ai][bj][m][n] = __builtin_amdgcn_mfma_f32_16x16x32_bf16(__builtin_bit_cast(bf16x8, __builtin_shufflevector(Bf[n], Bf[n], 4, 5, 6, 7)), __builtin_bit_cast(bf16x8, __builtin_shufflevector(Af[m], Af[m], 4, 5, 6, 7)), acc[ai][bj][m][n], 0, 0, 0); } } \
        __builtin_amdgcn_s_setprio(0); } while (0)
#define WAIT_V(n) asm volatile("s_waitcnt vmcnt(" #n ")" ::: "memory")
#define WAIT_L(n) asm volatile("s_waitcnt lgkmcnt(" #n ")" ::: "memory")
#define BAR __builtin_amdgcn_s_barrier()
#define SCHED __builtin_amdgcn_sched_barrier(0)
    asm volatile("" : "+s"(wv));
    int tx = tid_fresh(wv);
    constexpr unsigned ldsb = 0u;
    {
        const size_t a_ = (size_t)A_in, b_ = (size_t)Bt_in;
        A = (const bf16_t*)(((size_t)(unsigned)__builtin_amdgcn_readfirstlane((int)(a_ >> 32)) << 32) | (size_t)(unsigned)__builtin_amdgcn_readfirstlane((int)a_));
        Bt = (const bf16_t*)(((size_t)(unsigned)__builtin_amdgcn_readfirstlane((int)(b_ >> 32)) << 32) | (size_t)(unsigned)__builtin_amdgcn_readfirstlane((int)b_));
    }
    int lane = tx & 63, wr = wv >> 2, wc = wv & 3, fr = lane & 15, fq = lane >> 4;
    unsigned aoff[2][2], boff;
    {
        int r0, c0; stage_rc(tx * 16, r0, c0);
        boff = (unsigned)(r0 * ldb + c0) * 2u;
        if (RowOff::PLAIN) { aoff[0][0] = (rowoff(r0) + (unsigned)c0) * 2u; aoff[0][1] = aoff[0][0]; aoff[1][0] = aoff[0][0]; aoff[1][1] = aoff[0][0]; }
        else {
            aoff[0][0] = (rowoff(r0) + (unsigned)c0) * 2u; aoff[0][1] = (rowoff(r0 + 64) + (unsigned)c0) * 2u;
            aoff[1][0] = (rowoff(HALF + r0) + (unsigned)c0) * 2u; aoff[1][1] = (rowoff(HALF + r0 + 64) + (unsigned)c0) * 2u;
        }
    }
    const size_t a_h = RowOff::PLAIN ? (size_t)rowoff.ld * HALF * 2 : 0, a_i = RowOff::PLAIN ? (size_t)rowoff.ld * 64 * 2 : 0;
    f32x4 acc[2][2][4][2] = {};
    v8i At[4] = {}, B0[2] = {}, B1[2] = {};
    const int nt = K / BK;
    STAGE_B(SB(0, 0), 0, 0); STAGE_A(SA(0, 0), 0, 0);
    STAGE_B(SB(0, 1), 1, 0); STAGE_A(SA(0, 1), 1, 0);
    if (wr == 1) BAR;
    WAIT_V(4); BAR;
    STAGE_B(SB(1, 0), 0, 1); STAGE_A(SA(1, 0), 0, 1); STAGE_B(SB(1, 1), 1, 1);
    WAIT_V(6); BAR;
    for (int t = 0; t < nt - 2; t += 2) {
        LDB(B0, 0, 0); SCHED; LDA(At, 0, 0); STAGE_A(SA(1, 1), 1, t + 1);
        WAIT_L(8); BAR; WAIT_L(0); MMA(0, 0, At, B0); BAR; SCHED;
        LDB(B1, 0, 1); STAGE_B(SB(0, 0), 0, t + 2);
        BAR; WAIT_L(0); MMA(0, 1, At, B1); BAR;
        LDA(At, 0, 1); STAGE_A(SA(0, 0), 0, t + 2);
        BAR; WAIT_L(0); MMA(1, 0, At, B0); BAR; SCHED;
        STAGE_B(SB(0, 1), 1, t + 2);
        WAIT_V(6); BAR; MMA(1, 1, At, B1); BAR;
        LDB(B0, 1, 0); SCHED; LDA(At, 1, 0); STAGE_A(SA(0, 1), 1, t + 2);
        WAIT_L(8); BAR; WAIT_L(0); MMA(0, 0, At, B0); BAR; SCHED;
        LDB(B1, 1, 1); STAGE_B(SB(1, 0), 0, t + 3);
        BAR; WAIT_L(0); MMA(0, 1, At, B1); BAR;
        LDA(At, 1, 1); STAGE_A(SA(1, 0), 0, t + 3);
        BAR; WAIT_L(0); MMA(1, 0, At, B0); BAR; SCHED;
        STAGE_B(SB(1, 1), 1, t + 3);
        WAIT_V(6); BAR; MMA(1, 1, At, B1); BAR;
    }
    { LDB(B0, 0, 0); WAIT_V(0); LDA(At, 0, 0); STAGE_A(SA(1, 1), 1, nt - 1);
      BAR; WAIT_L(0); MMA(0, 0, At, B0); BAR;
      LDB(B1, 0, 1); BAR; WAIT_L(0); MMA(0, 1, At, B1); BAR;
      LDA(At, 0, 1); WAIT_V(4); BAR; WAIT_L(0); MMA(1, 0, At, B0); MMA(1, 1, At, B1); BAR; }
    { LDB(B0, 1, 0); LDA(At, 1, 0); WAIT_V(2); BAR; WAIT_L(0); MMA(0, 0, At, B0); BAR;
      LDB(B1, 1, 1); WAIT_V(0); BAR; WAIT_L(0); MMA(0, 1, At, B1); BAR;
      LDA(At, 1, 1); BAR; WAIT_L(0); MMA(1, 0, At, B0); MMA(1, 1, At, B1); BAR; }
    if (wr == 0) BAR;
    int tz = tid_fresh(wv); lane = tz & 63; fr = lane & 15; fq = lane >> 4;
    Epi epi2 = epi; epi2.launder();
    epi2(acc, wr, wc, fr, fq);
#undef SA
#undef SB
#undef STAGE_A
#undef GLDS
#undef STAGE_B
#undef LDA
#undef LDFRAG
#undef LDB
#undef MMA
#undef WAIT_V
#undef WAIT_L
#undef BAR
#undef SCHED
}

__device__ __forceinline__ int unit_index(int k) { return (gridDim.x == 256) ? ((k * 8 + (int)(blockIdx.x & 7)) * 32 + (int)(blockIdx.x >> 3)) : (k * (int)gridDim.x + (int)blockIdx.x); }
__device__ __forceinline__ void dense_tile(int i, int nN, int& pm, int& pn) { const int g = i / (8 * nN), rem = i - g * 8 * nN; pn = rem >> 3; pm = g * 8 + (rem & 7); }
__device__ __forceinline__ int lauv(int v) { v = __builtin_amdgcn_readfirstlane(v); asm volatile("" : "+s"(v)); return v; }
template <class T> __device__ __forceinline__ T* lauv(T* p) { const size_t a_ = (size_t)p; unsigned lo = (unsigned)__builtin_amdgcn_readfirstlane((int)a_), hi = (unsigned)__builtin_amdgcn_readfirstlane((int)(a_ >> 32)); asm volatile("" : "+s"(lo), "+s"(hi)); return (T*)(((size_t)hi << 32) | lo); }
struct RowPlain { static constexpr bool PLAIN = true; unsigned base; unsigned ld; __device__ __forceinline__ unsigned operator()(int r) const { return base + (unsigned)r * ld; } };

typedef f32x4 AccT[2][2][4][2];

__device__ __forceinline__ void st_bf16x4(bf16_t* p, f32x4 v) { u32x2 o; o.x = cvt_pk_bf16(v[0], v[1]); o.y = cvt_pk_bf16(v[2], v[3]); *(GAS u32x2*)p = o; }

typedef float f32x2_t __attribute__((ext_vector_type(2)));
struct EpiIn0 {
    unsigned char* proj; const float2* rot; int pm, pn; LAS bf16_t* tl  ; int wv; float sc  ;
    __device__ __forceinline__ void launder() { proj = lauv(proj); rot = lauv(rot); pm = lauv(pm); pn = lauv(pn); }
    __device__ __forceinline__ void tile_out(bf16_t* gbase  ) const {
        __syncthreads();
        const int tid = tid_fresh(wv);
#pragma unroll
        for (int it = 0; it < 16; ++it) {
            const int c = tid + it * NT, d = c >> 5, ch = c & 31;
            *(GAS u32x4*)(gbase + (size_t)((ch >> 3) * 256 + d) * 64 + (ch & 7) * 8) = *(const LAS u32x4*)(tl + d * 264 + ch * 8);
        }
        __syncthreads();
    }
    __device__ __forceinline__ void operator()(const AccT& acc, int wr, int wc, int fr, int fq) const {
        const int row0 = pm * BM + wr * 64 + fr;
        if (pn < 4) {
            bf16_t* O = (bf16_t*)(proj + PJ_AB);
#pragma unroll
            for (int ai = 0; ai < 2; ++ai)
#pragma unroll
                for (int m = 0; m < 4; ++m) { bf16_t* rp = O + (size_t)(row0 + ai * HALF + m * 16) * 1024 + pn * 256 + wc * 32 + fq * 4;
#pragma unroll
                    for (int bj = 0; bj < 2; ++bj)
#pragma unroll
                        for (int n = 0; n < 2; ++n) st_bf16x4(rp + bj * HALF + n * 16, acc[ai][bj][m][n] * sc); }
        } else if (pn < 12) {
            bf16_t* O = (bf16_t*)(proj + PJ_U);
#pragma unroll
            for (int ai = 0; ai < 2; ++ai)
#pragma unroll
                for (int m = 0; m < 4; ++m) { bf16_t* rp = O + (size_t)(row0 + ai * HALF + m * 16) * 1024 + (pn - 4) * 128 + wc * 32 + fq * 4;
#pragma unroll
                    for (int n = 0; n < 2; ++n) st_bf16x4(rp + n * 16, acc[ai][0][m][n] * acc[ai][1][m][n] * (sc * sc)); }
        } else if (pn < 20) {
            const bool isk = pn >= 16; const int hh = (pn - 12) & 3;
            const float lg2 = log2f(1.0f - exp2f(-5.0f - (float)hh));
            bf16_t* O = (bf16_t*)(proj + (isk ? PJ_K : PJ_Q));
#pragma unroll
            for (int ai = 0; ai < 2; ++ai)
#pragma unroll
                for (int m = 0; m < 4; ++m) {
                    const int t = row0 + ai * HALF + m * 16, pos = t & (NS - 1), bb = t >> 11;
                    const int pc = pos & 63;
                    const float dsc = (isk ? 0.0625f * exp2f(-lg2 * (float)pc) : exp2f(lg2 * (float)pc)) * sc;
                    bf16_t* rp = O + (size_t)t * 1024 + hh * 256 + wc * 32 + fq * 4;
#pragma unroll
                    for (int n = 0; n < 2; ++n) {
                        const int f0 = wc * 32 + n * 16 + fq * 4;
                        f32x4 o1, o2;
#pragma unroll
                        for (int j = 0; j < 4; ++j) {
                            const f32x2_t csv = *(const GAS f32x2_t*)(rot + pos * 128 + f0 + j); const float2 cs = make_float2(csv[0], csv[1]);
                            const float x1 = acc[ai][0][m][n][j], x2 = acc[ai][1][m][n][j];
                            o1[j] = (x1 * cs.x - x2 * cs.y) * dsc; o2[j] = (x1 * cs.y + x2 * cs.x) * dsc;
                        }
                        st_bf16x4(rp + n * 16, o1); st_bf16x4(rp + HALF + n * 16, o2);
                    }
                }
        } else if (pn < 24) {
            const int hh = pn - 20; bf16_t* OT = (bf16_t*)(proj + PJ_VT);
#pragma unroll
            for (int ai = 0; ai < 2; ++ai)
#pragma unroll
                for (int m = 0; m < 4; ++m) {
                    const int t = row0 + ai * HALF + m * 16;
#pragma unroll
                    for (int bj = 0; bj < 2; ++bj)
#pragma unroll
                        for (int n = 0; n < 2; ++n) {
                            LAS bf16_t* tp = tl + (bj * HALF + wc * 32 + n * 16 + fq * 4) * 264 + (t & 255);
#pragma unroll
                            for (int j = 0; j < 4; ++j) tp[j * 264] = f2bf(acc[ai][bj][m][n][j] * sc);
                        }
                }
            tile_out(OT + ((size_t)((((pm * BM) >> 11) * 4 + hh) * 32 + (((pm * BM) & (NS - 1)) >> 6)) * 256) * 64);
        } else {
            bf16_t* O = (bf16_t*)(proj + PJ_SG);
#pragma unroll
            for (int ai = 0; ai < 2; ++ai)
#pragma unroll
                for (int m = 0; m < 4; ++m) { bf16_t* rp = O + (size_t)(row0 + ai * HALF + m * 16) * 1024 + (pn - 24) * 256 + wc * 32 + fq * 4;
#pragma unroll
                    for (int bj = 0; bj < 2; ++bj)
#pragma unroll
                        for (int n = 0; n < 2; ++n) { f32x4 v = acc[ai][bj][m][n];
#pragma unroll
                            for (int j = 0; j < 4; ++j) v[j] = silu_f(v[j] * sc);
                            st_bf16x4(rp + bj * HALF + n * 16, v); } }
        }
    }
};

template <bool ADD_TMP, bool XIN_F32>
struct EpiRes {
    const void* xin; const bf16_t* tmp; bf16_t* xout; const float* gate  ; int pm, pn; float sc;
    __device__ __forceinline__ void launder() { xin = lauv(xin); tmp = lauv(tmp); xout = lauv(xout); gate = lauv(gate); pm = lauv(pm); pn = lauv(pn); }
    __device__ __forceinline__ void operator()(const AccT& acc, int wr, int wc, int fr, int fq) const {
        const int row0 = pm * BM + wr * 64 + fr, col0 = pn * BM + wc * 32 + fq * 4;
        const int bb = (pm * BM) >> 11;
        f32x4 gv[2][2];
#pragma unroll
        for (int bj = 0; bj < 2; ++bj)
#pragma unroll
            for (int n = 0; n < 2; ++n) gv[bj][n] = *(const GAS f32x4*)(gate + (size_t)bb * 6144 + col0 + bj * HALF + n * 16);
#pragma unroll
        for (int ai = 0; ai < 2; ++ai)
#pragma unroll
            for (int m = 0; m < 4; ++m) {
                const size_t ro = (size_t)(row0 + ai * HALF + m * 16) * ND + col0;
#pragma unroll
                for (int bj = 0; bj < 2; ++bj)
#pragma unroll
                    for (int n = 0; n < 2; ++n) {
                        f32x4 xv = XIN_F32 ? *(const GAS f32x4*)((const float*)xin + ro + bj * HALF + n * 16) : ld_bf16x4((const bf16_t*)xin + ro + bj * HALF + n * 16);
                        if (ADD_TMP) xv += ld_bf16x4(tmp + ro + bj * HALF + n * 16);
                        st_bf16x4(xout + ro + bj * HALF + n * 16, xv + gv[bj][n] * (acc[ai][bj][m][n] * sc));
                    }
            }
    }
};

typedef short s16x4_t __attribute__((ext_vector_type(4)));
__device__ __forceinline__ void retention_phase(int wv, unsigned char* proj, bf16_t* __restrict__ Og, unsigned char* lds) {
    const int tid = tid_fresh(wv);
    bf16_t* P_lds = (bf16_t*)lds;
    bf16_t* St_lds = (bf16_t*)(lds + 9216);
    bf16_t* Q_lds = (bf16_t*)(lds + 9216 + 33792);
    bf16_t* K_lds = (bf16_t*)(lds + 9216 + 2 * 33792);
    bf16_t* V_lds = (bf16_t*)(lds + 9216 + 3 * 33792);
    const bf16_t* Qg = (const bf16_t*)(proj + PJ_Q); const bf16_t* Kg = (const bf16_t*)(proj + PJ_K);
    const bf16_t* KTg = (const bf16_t*)(proj + PJ_KT); const bf16_t* VTg = (const bf16_t*)(proj + PJ_VT);
    const int ti = wv >> 1, hf = wv & 1;
    for (int u0 = blockIdx.x; u0 < 256; u0 += gridDim.x) {
        int tu = tid; asm volatile("" : "+v"(tu));
        const int srow = tu >> 5, sc16 = tu & 31;
        const int vrow = tu >> 3, vc8 = tu & 7;
        const int fr = tu & 15, fq = (tu >> 4) & 3, w = wv;
        int u = u0;
        if (gridDim.x == 256) { const int xcd = u0 & 7, j = u0 >> 3; u = (((j >> 2) * 8 + xcd) << 2) | (j & 3); }
        const int b = u >> 4, hh = (u >> 2) & 3, es = u & 3;
        const float gam = 1.0f - exp2f(-5.0f - (float)hh);
        const float g63 = exp2f(63.0f * log2f(gam));
        const size_t hrow = (size_t)(b * 4 + hh) * 256;
        const bf16_t* qsp = Qg + ((size_t)b * NS + srow) * 1024 + hh * 256 + sc16 * 8;
        const bf16_t* ksp = Kg + ((size_t)b * NS + srow) * 1024 + hh * 256 + sc16 * 8;
        const bf16_t* vsp = VTg + (hrow * 32 + es * 64 + vrow) * 64 + vc8 * 8;
        u32x4 qr[2][4], kr[2][4], vr[2];
#pragma unroll
        for (int i = 0; i < 4; ++i) { qr[0][i] = *(const u32x4*)(qsp + (size_t)(16 * i) * 1024); kr[0][i] = *(const u32x4*)(ksp + (size_t)(16 * i) * 1024); }
        vr[0] = *(const u32x4*)vsp; vr[1] = *(const u32x4*)(vsp + 256 * 64);
        __syncthreads();
        for (int i = tid; i < 64 * 264 / 2; i += NT) ((unsigned*)St_lds)[i] = 0u;
#pragma unroll
        for (int i = 0; i < 4; ++i) { *(u32x4*)(Q_lds + (srow + 16 * i) * 264 + sc16 * 8) = qr[0][i]; *(u32x4*)(K_lds + (srow + 16 * i) * 264 + sc16 * 8) = kr[0][i]; }
#pragma unroll
        for (int i = 0; i < 4; ++i) { qr[1][i] = *(const u32x4*)(qsp + (size_t)(64 + 16 * i) * 1024); kr[1][i] = *(const u32x4*)(ksp + (size_t)(64 + 16 * i) * 1024); }
        f32x4 S[2][4];
#pragma unroll
        for (int dl = 0; dl < 2; ++dl)
#pragma unroll
            for (int et = 0; et < 4; ++et) S[dl][et] = (f32x4){0.f, 0.f, 0.f, 0.f};
        __syncthreads();
        for (int c2 = 0; c2 < 32; c2 += 2) {
#pragma unroll
          for (int e = 0; e < 2; ++e) {
            const int c = c2 + e;
            int tl = tid; asm volatile("" : "+v"(tl));
            const int fr = tl & 15, fq = (tl >> 4) & 3, srow = tl >> 5, sc16 = tl & 31, vrow = tl >> 3, vc8 = tl & 7, w = wv;
            const bf16_t* qsp = Qg + ((size_t)b * NS + srow) * 1024 + hh * 256 + sc16 * 8;
            const bf16_t* ksp = Kg + ((size_t)b * NS + srow) * 1024 + hh * 256 + sc16 * 8;
            const bf16_t* vsp = VTg + (hrow * 32 + es * 64 + vrow) * 64 + vc8 * 8;
            const int j0 = c * 64;
            const size_t trow = (size_t)b * NS + j0;
            *(u32x4*)(V_lds + vrow * 72 + vc8 * 8) = vr[e];
            {
                const int cn = (c + 2 < 32) ? c + 2 : 31;
#pragma unroll
                for (int i = 0; i < 4; ++i) { qr[e][i] = *(const u32x4*)(qsp + (size_t)(cn * 64 + 16 * i) * 1024); kr[e][i] = *(const u32x4*)(ksp + (size_t)(cn * 64 + 16 * i) * 1024); }
                vr[e] = *(const u32x4*)(vsp + (size_t)cn * (256 * 64));
            }
            bf16x8 ktf[2][2];
#pragma unroll
            for (int dl = 0; dl < 2; ++dl)
#pragma unroll
                for (int ks = 0; ks < 2; ++ks) {
                    const bf16_t* kp = K_lds + (ks * 32 + fq * 8 + (fr >> 2)) * 264 + (2 * w + dl) * 16 + (fr & 3) * 4;
                    const s16x4_t t0 = __builtin_amdgcn_ds_read_tr16_b64_v4i16((__attribute__((address_space(3))) s16x4_t*)(kp));
                    const s16x4_t t1 = __builtin_amdgcn_ds_read_tr16_b64_v4i16((__attribute__((address_space(3))) s16x4_t*)(kp + 4 * 264));
                    ktf[dl][ks] = __builtin_bit_cast(bf16x8, __builtin_shufflevector(t0, t1, 0, 1, 2, 3, 4, 5, 6, 7));
                }
            f32x4 pacc[2], oacc[2];
            pacc[0] = pacc[1] = oacc[0] = oacc[1] = (f32x4){0.f, 0.f, 0.f, 0.f};
            bf16x8 opA[5], opB[5];
#define RET_SB __builtin_amdgcn_sched_barrier(0);
#define RET_RD(buf, ks) { buf[4] = *(const bf16x8*)(Q_lds + (ti * 16 + fr) * 264 + (ks) * 32 + fq * 8); \
                buf[0] = *(const bf16x8*)(K_lds + ((hf * 2 + 0) * 16 + fr) * 264 + (ks) * 32 + fq * 8); buf[1] = *(const bf16x8*)(K_lds + ((hf * 2 + 1) * 16 + fr) * 264 + (ks) * 32 + fq * 8); \
                buf[2] = *(const bf16x8*)(St_lds + ((hf * 2 + 0) * 16 + fr) * 264 + (ks) * 32 + fq * 8); buf[3] = *(const bf16x8*)(St_lds + ((hf * 2 + 1) * 16 + fr) * 264 + (ks) * 32 + fq * 8); }
#define RET_MM(buf, ks) { \
                pacc[0] = __builtin_amdgcn_mfma_f32_16x16x32_bf16(buf[0], buf[4], pacc[0], 0, 0, 0); pacc[1] = __builtin_amdgcn_mfma_f32_16x16x32_bf16(buf[1], buf[4], pacc[1], 0, 0, 0); \
                oacc[0] = __builtin_amdgcn_mfma_f32_16x16x32_bf16(buf[2], buf[4], oacc[0], 0, 0, 0); oacc[1] = __builtin_amdgcn_mfma_f32_16x16x32_bf16(buf[3], buf[4], oacc[1], 0, 0, 0); }
            RET_RD(opA, 0) RET_RD(opB, 1) RET_SB
            RET_MM(opA, 0) RET_SB RET_RD(opA, 2) RET_SB RET_MM(opB, 1) RET_SB RET_RD(opB, 3) RET_SB
            RET_MM(opA, 2) RET_SB RET_RD(opA, 4) RET_SB RET_MM(opB, 3) RET_SB RET_RD(opB, 5) RET_SB
            RET_MM(opA, 4) RET_SB RET_RD(opA, 6) RET_SB RET_MM(opB, 5) RET_SB RET_RD(opB, 7) RET_SB
            RET_MM(opA, 6) RET_SB RET_MM(opB, 7) RET_SB
#undef RET_RD
#undef RET_MM
#pragma unroll
            for (int tt = 0; tt < 2; ++tt) {
                const int tj = hf * 2 + tt;
                { const int i = ti * 16 + fr, jc = tj * 16 + fq * 4; f32x4 pv = pacc[tt];
#pragma unroll
                  for (int j = 0; j < 4; ++j) pv[j] = (jc + j <= i) ? pv[j] : 0.f;
                  u32x2 o; o.x = cvt_pk_bf16(pv[0], pv[1]); o.y = cvt_pk_bf16(pv[2], pv[3]); *(u32x2*)(P_lds + i * 72 + jc) = o; }
            }
            __syncthreads();
#pragma unroll
            for (int i = 0; i < 4; ++i) { *(u32x4*)(Q_lds + (srow + 16 * i) * 264 + sc16 * 8) = qr[e ^ 1][i]; *(u32x4*)(K_lds + (srow + 16 * i) * 264 + sc16 * 8) = kr[e ^ 1][i]; }
            bf16x8 pf[2], vfo[2][2], vf[4][2];
#pragma unroll
            for (int ks = 0; ks < 2; ++ks) {
                pf[ks] = *(const bf16x8*)(P_lds + (ti * 16 + fr) * 72 + ks * 32 + fq * 8);
#pragma unroll
                for (int tt = 0; tt < 2; ++tt) vfo[tt][ks] = *(const bf16x8*)(V_lds + ((hf * 2 + tt) * 16 + fr) * 72 + ks * 32 + fq * 8);
#pragma unroll
                for (int et = 0; et < 4; ++et) vf[et][ks] = *(const bf16x8*)(V_lds + (et * 16 + fr) * 72 + ks * 32 + fq * 8);
            }
            oacc[0] *= gam; oacc[1] *= gam;
#pragma unroll
            for (int dl = 0; dl < 2; ++dl)
#pragma unroll
                for (int et = 0; et < 4; ++et) S[dl][et] *= gam;
            RET_SB
#pragma unroll
            for (int ks = 0; ks < 2; ++ks) {
                oacc[0] = __builtin_amdgcn_mfma_f32_16x16x32_bf16(vfo[0][ks], pf[ks], oacc[0], 0, 0, 0);
                oacc[1] = __builtin_amdgcn_mfma_f32_16x16x32_bf16(vfo[1][ks], pf[ks], oacc[1], 0, 0, 0);
#pragma unroll
                for (int dl = 0; dl < 2; ++dl)
#pragma unroll
                    for (int et = 0; et < 4; ++et) S[dl][et] = __builtin_amdgcn_mfma_f32_16x16x32_bf16(ktf[dl][ks], vf[et][ks], S[dl][et], 0, 0, 0);
            }
            RET_SB
#pragma unroll
            for (int tt = 0; tt < 2; ++tt) {
                const int te = hf * 2 + tt;
                st_bf16x4(Og + (trow + ti * 16 + fr) * 1024 + hh * 256 + es * 64 + te * 16 + fq * 4, oacc[tt]);
            }
#pragma unroll
            for (int dl = 0; dl < 2; ++dl)
#pragma unroll
                for (int et = 0; et < 4; ++et) {
                    const f32x4 sv = S[dl][et] * g63; S[dl][et] = sv;
                    u32x2 o; o.x = cvt_pk_bf16(sv[0], sv[1]); o.y = cvt_pk_bf16(sv[2], sv[3]);
                    *(u32x2*)(St_lds + (et * 16 + fr) * 264 + (2 * w + dl) * 16 + fq * 4) = o;
                }
#undef RET_SB
            __syncthreads();
          }
        }
    }
}

__device__ __forceinline__ void ycat_phase(int wv, const unsigned char* proj, const bf16_t* __restrict__ Og, const float* __restrict__ conv_w, const float* __restrict__ conv_b, bf16_t* __restrict__ Y) {
    const int tid = tid_fresh(wv), lane = tid & 63, wave = tid >> 6;
    const bf16_t* AB = (const bf16_t*)(proj + PJ_AB); const bf16_t* U = (const bf16_t*)(proj + PJ_U); const bf16_t* SG = (const bf16_t*)(proj + PJ_SG);
    const int ch0 = lane * 16;
    float cw0[16], cw1[16], cw2[16], cb[16];
#pragma unroll
    for (int i = 0; i < 16; ++i) { cw0[i] = conv_w[ch0 + i]; cw1[i] = conv_w[1024 + ch0 + i]; cw2[i] = conv_w[2048 + ch0 + i]; cb[i] = conv_b[ch0 + i]; }
    const int rows_per_wave = NTOK / ((int)gridDim.x * 8);
    const int row0 = (blockIdx.x * 8 + wave) * rows_per_wave;
    float u1[16], u2[16];
    auto load16 = [&](const bf16_t* p, float* f) {
        const u32x4 a = *(const u32x4*)p; const u32x4 c = *(const u32x4*)(p + 8);
        f[0] = bflo(a.x); f[1] = bfhi(a.x); f[2] = bflo(a.y); f[3] = bfhi(a.y); f[4] = bflo(a.z); f[5] = bfhi(a.z); f[6] = bflo(a.w); f[7] = bfhi(a.w);
        f[8] = bflo(c.x); f[9] = bfhi(c.x); f[10] = bflo(c.y); f[11] = bfhi(c.y); f[12] = bflo(c.z); f[13] = bfhi(c.z); f[14] = bflo(c.w); f[15] = bfhi(c.w);
    };
    auto store16 = [&](bf16_t* p, const float* f) {
        u32x4 a, c;
        a.x = cvt_pk_bf16(f[0], f[1]); a.y = cvt_pk_bf16(f[2], f[3]); a.z = cvt_pk_bf16(f[4], f[5]); a.w = cvt_pk_bf16(f[6], f[7]);
        c.x = cvt_pk_bf16(f[8], f[9]); c.y = cvt_pk_bf16(f[10], f[11]); c.z = cvt_pk_bf16(f[12], f[13]); c.w = cvt_pk_bf16(f[14], f[15]);
        *(u32x4*)p = a; *(u32x4*)(p + 8) = c;
    };
    auto store16f8 = [&](unsigned char* p, const float* f) {
        u32x4 a;
        a.x = pack_fp8x4(f[0] * Y8_SCALE, f[1] * Y8_SCALE, f[2] * Y8_SCALE, f[3] * Y8_SCALE); a.y = pack_fp8x4(f[4] * Y8_SCALE, f[5] * Y8_SCALE, f[6] * Y8_SCALE, f[7] * Y8_SCALE);
        a.z = pack_fp8x4(f[8] * Y8_SCALE, f[9] * Y8_SCALE, f[10] * Y8_SCALE, f[11] * Y8_SCALE); a.w = pack_fp8x4(f[12] * Y8_SCALE, f[13] * Y8_SCALE, f[14] * Y8_SCALE, f[15] * Y8_SCALE);
        *(u32x4*)p = a;
    };
    {
        const int pos = row0 & (NS - 1);
#pragma unroll
        for (int i = 0; i < 16; ++i) { u1[i] = 0.f; u2[i] = 0.f; }
        if (pos >= 1) load16(U + (size_t)(row0 - 1) * 1024 + ch0, u1);
        if (pos >= 2) load16(U + (size_t)(row0 - 2) * 1024 + ch0, u2);
    }
    for (int r = 0; r < rows_per_wave; ++r) {
        const int t = row0 + r;
        float ab[16], u0[16], y[16];
        load16(AB + (size_t)t * 1024 + ch0, ab); load16(U + (size_t)t * 1024 + ch0, u0);
        if ((t & (NS - 1)) == 0) {
#pragma unroll
            for (int i = 0; i < 16; ++i) { u1[i] = 0.f; u2[i] = 0.f; }
        }
#pragma unroll
        for (int i = 0; i < 16; ++i) { y[i] = ab[i] * (cb[i] + cw0[i] * u2[i] + cw1[i] * u1[i] + cw2[i] * u0[i]); u2[i] = u1[i]; u1[i] = u0[i]; }
        if (F8_P5) store16f8((unsigned char*)Y + (size_t)t * ND + ch0, y); else store16(Y + (size_t)t * ND + ch0, y);
        float o[16], sg[16];
        load16(Og + (size_t)t * 1024 + ch0, o); load16(SG + (size_t)t * 1024 + ch0, sg);
        float ss = 0.f;
#pragma unroll
        for (int i = 0; i < 16; ++i) ss += o[i] * o[i];
        ss += shx(ss, 1, lane); ss += shx(ss, 2, lane); ss += shx(ss, 4, lane); ss += shx(ss, 8, lane);
        const float rs = rsqrtf(ss * (1.0f / 256.0f) + RMS_EPS);
#pragma unroll
        for (int i = 0; i < 16; ++i) y[i] = o[i] * rs * sg[i];
        if (F8_P5) store16f8((unsigned char*)Y + (size_t)t * ND + 1024 + ch0, y); else store16(Y + (size_t)t * ND + 1024 + ch0, y);
    }
}

constexpr int MOE_TAB_OFF = 64;
__device__ __forceinline__ int moe_build_table(int wv, const unsigned* cntp, unsigned char* lds) {
    volatile LAS int* tab = (volatile LAS int*)(lds + LDS_MISC + MOE_TAB_OFF);
    __syncthreads();
    if (wv == 0) {
        const int lane = tid_fresh(wv) & 63;
        if (lane == 0) {
            int mt = 0;
            for (int e = 0; e < 16; ++e) {
                const int c = (int)__hip_atomic_load(cntp + e * 64, __ATOMIC_RELAXED, __HIP_MEMORY_SCOPE_AGENT);
                for (int lt = 0; lt * 256 < c; ++lt) { tab[4 + mt * 4 + 0] = e; tab[4 + mt * 4 + 1] = lt * 256; tab[4 + mt * 4 + 2] = c; ++mt; }
            }
            tab[0] = mt;
        }
    }
    __syncthreads();
    return __builtin_amdgcn_readfirstlane(tab[0]);
}
struct RowGather {
    static constexpr bool PLAIN = false; static constexpr unsigned ld = 0;
    const int* idx; int nvalid;
    __device__ __forceinline__ unsigned operator()(int r) const {
        const __amdgpu_buffer_rsrc_t rs = __builtin_amdgcn_make_buffer_rsrc((void*)idx, 0, 256 * 4, 0x00020000);
        const int v = (r < nvalid) ? (int)__builtin_amdgcn_raw_buffer_load_b32(rs, r * 4, 0, 0) : 0;
        return (unsigned)(v >> 1) * (unsigned)(ND / 2);
    }
};
struct EpiGate {
    bf16_t* act; int row0g  , colbase;
    __device__ __forceinline__ void launder() { act = lauv(act); row0g = lauv(row0g); colbase = lauv(colbase); }
    __device__ __forceinline__ void operator()(const AccT& acc, int wr, int wc, int fr, int fq) const {
        const int lo = fr * DEXP + fq * 4;
        const __amdgpu_buffer_rsrc_t rs = __builtin_amdgcn_make_buffer_rsrc((void*)((unsigned char*)act + (size_t)(row0g + wr * 64) * DEXP + colbase + wc * 32), 0, 256 * DEXP, 0x00020000);
#pragma unroll
        for (int ai = 0; ai < 2; ++ai)
#pragma unroll
            for (int m = 0; m < 4; ++m) {
#pragma unroll
                for (int n = 0; n < 2; ++n) { f32x4 v;
#pragma unroll
                    for (int j = 0; j < 4; ++j) v[j] = silu_f(acc[ai][0][m][n][j] * (1.0f / W8_SCALE)) * acc[ai][1][m][n][j] * (A8_SCALE / W8_SCALE);
                    __builtin_amdgcn_raw_buffer_store_b32(pack_fp8x4(v[0], v[1], v[2], v[3]), rs, lo + n * 16, (ai * HALF + m * 16) * DEXP, 0); } }
    }
};
constexpr float T8_SCALE = 16.0f;
struct EpiMoeOut {
    const int* idx; const float* gts; int nvalid; bf16_t* tmp1; bf16_t* tmp; const float* gate  ; int col0t; int tmp8  ;
    __device__ __forceinline__ void launder() { idx = lauv(idx); gts = lauv(gts); tmp1 = lauv(tmp1); tmp = lauv(tmp); gate = lauv(gate); nvalid = lauv(nvalid); col0t = lauv(col0t); tmp8 = lauv(tmp8); }
    __device__ __forceinline__ void operator()(const AccT& acc, int wr, int wc, int fr, int fq) const {
        const int colb = col0t + wc * 32 + fq * 4;
#pragma unroll
        for (int ai = 0; ai < 2; ++ai)
#pragma unroll
            for (int m = 0; m < 4; ++m) {
                const int r = ai * HALF + wr * 64 + m * 16 + fr;
                if (r < nvalid) {
                    const int v = ((const GAS int*)idx)[r]; const float g = ((const GAS float*)gts)[r];
                    const int tok = v >> 1;
                    const size_t ro = (size_t)tok * ND + colb;
#pragma unroll
                    for (int bj = 0; bj < 2; ++bj)
#pragma unroll
                        for (int n = 0; n < 2; ++n) {
                            const f32x4 y = acc[ai][bj][m][n] * (g * (1.0f / (W8_SCALE * A8_SCALE)));
                            *(GAS unsigned*)((unsigned char*)tmp + (size_t)(v & 1) * (64 * MiB) + ro + bj * HALF + n * 16) = pack_fp8x4(y[0] * T8_SCALE, y[1] * T8_SCALE, y[2] * T8_SCALE, y[3] * T8_SCALE);
                        }
                }
            }
    }
};

struct EpiGateLazy {
    int mt, nt;
    __device__ __forceinline__ void launder() { mt = lauv(mt); nt = lauv(nt); }
    __device__ __forceinline__ void operator()(const AccT& acc, int wr, int wc, int fr, int fq) const {
        const KA a; unsigned char* ws = a.ws();
        EpiGate E{(bf16_t*)(ws + WS_PROJ + PJ_ACT), mt * 256, nt * 128};
        E(acc, wr, wc, fr, fq);
    }
};
struct EpiMoeOutLazy {
    int e, r0, nvalid, layer, nt;
    __device__ __forceinline__ void launder() { e = lauv(e); r0 = lauv(r0); nvalid = lauv(nvalid); layer = lauv(layer); nt = lauv(nt); }
    __device__ __forceinline__ void operator()(const AccT& acc, int wr, int wc, int fr, int fq) const {
        const KA a; unsigned char* ws = a.ws();
        EpiMoeOut E{(const int*)(ws + WS_IDX) + e * 32768 + r0, (const float*)(ws + WS_GT) + e * 32768 + r0, nvalid, (bf16_t*)(ws + WS_TMP1), (bf16_t*)(ws + WS_TMP),
                    (const float*)(ws + WS_MOD) + (size_t)(2 * layer + 1) * 16 * 6144 + 4096, nt * 256, layer};
        E(acc, wr, wc, fr, fq);
    }
};
__device__ __forceinline__ void moe_phase1(int wv, unsigned char* ws0, int layer, unsigned char* lds) {
    const int nmt = moe_build_table(wv, (const unsigned*)(ws0 + WS_CTL + CTL_CNT + layer * 4096), lds);
    for (int k = 0, u = unit_index(0); u < nmt * 8; u = unit_index(++k)) {
        const KA a; unsigned char* ws = a.ws();
        const LAS int* tab = (const LAS int*)(lds + LDS_MISC + MOE_TAB_OFF);
        const int mt = u >> 3, nt = u & 7;
        const int e = __builtin_amdgcn_readfirstlane(tab[4 + mt * 4 + 0]), r0 = __builtin_amdgcn_readfirstlane(tab[4 + mt * 4 + 1]), cnt_e = __builtin_amdgcn_readfirstlane(tab[4 + mt * 4 + 2]);
        RowGather ro{(const int*)(ws + WS_IDX) + e * 32768 + r0, cnt_e - r0};
        EpiGateLazy E{mt, nt};
        gemm_unit<true>(wv, (bf16_t*)lds, (const bf16_t*)(ws + WS_H), ro, (const bf16_t*)(ws + WS_W13 + ((size_t)(layer * 16 + e) * 2048 + (size_t)nt * 256) * ND), ND / 2, ND / 2, E);
    }
}
__device__ __forceinline__ void moe_phase2(int wv, unsigned char* ws0, int layer, unsigned char* lds) {
    const int nmt = moe_build_table(wv, (const unsigned*)(ws0 + WS_CTL + CTL_CNT + layer * 4096), lds);
    for (int k = 0, u = unit_index(0); u < nmt * 8; u = unit_index(++k)) {
        const KA a; unsigned char* ws = a.ws();
        const LAS int* tab = (const LAS int*)(lds + LDS_MISC + MOE_TAB_OFF);
        const int mt = u >> 3, nt = u & 7;
        const int e = __builtin_amdgcn_readfirstlane(tab[4 + mt * 4 + 0]), r0 = __builtin_amdgcn_readfirstlane(tab[4 + mt * 4 + 1]), cnt_e = __builtin_amdgcn_readfirstlane(tab[4 + mt * 4 + 2]);
        RowPlain ro{(unsigned)(mt * 256) * (DEXP / 2), (unsigned)(DEXP / 2)};
        EpiMoeOutLazy E{e, r0, cnt_e - r0, layer, nt};
        gemm_unit<true>(wv, (bf16_t*)lds, (const bf16_t*)(ws + WS_PROJ + PJ_ACT), ro, (const bf16_t*)(ws + WS_W2 + ((size_t)(layer * 16 + e) * 2048 + (size_t)nt * 256) * DEXP), DEXP / 2, DEXP / 2, E);
    }
}

constexpr float Q8_SCALE = 8.0f;
struct EpiIn1 {
    unsigned char* proj; int pm, pn; float sc;
    __device__ __forceinline__ void launder() { proj = lauv(proj); pm = lauv(pm); pn = lauv(pn); }
    __device__ __forceinline__ void operator()(const AccT& acc, int wr, int wc, int fr, int fq) const {
        const int row0 = pm * BM + wr * 64 + fr;
        if (pn < 8 || (pn >= 9 && pn < 13)) {
            const bool isq = pn < 8;
            bf16_t* O = (bf16_t*)(proj + (isq ? PJ_Q1 : PJ_QI)); const int ld = isq ? 2048 : 1024, cb = (isq ? pn : pn - 9) * 256;
#pragma unroll
            for (int ai = 0; ai < 2; ++ai)
#pragma unroll
                for (int m = 0; m < 4; ++m) { bf16_t* rp = O + (size_t)(row0 + ai * HALF + m * 16) * ld + cb + wc * 32 + fq * 4;
                    unsigned char* rp8 = (unsigned char*)O + (size_t)(row0 + ai * HALF + m * 16) * 2048 + cb + wc * 32 + fq * 4;
#pragma unroll
                    for (int bj = 0; bj < 2; ++bj)
#pragma unroll
                        for (int n = 0; n < 2; ++n) {
                            if (isq) { const f32x4 v = acc[ai][bj][m][n] * (sc * Q8_SCALE); *(GAS unsigned*)(rp8 + bj * HALF + n * 16) = pack_fp8x4(v[0], v[1], v[2], v[3]); }
                            else st_bf16x4(rp + bj * HALF + n * 16, acc[ai][bj][m][n] * sc);
                        } }
        } else if (pn == 8) {
            bf16_t* KR = (bf16_t*)(proj + PJ_KR); bf16_t* VT = (bf16_t*)(proj + PJ_VT1);
#pragma unroll
            for (int ai = 0; ai < 2; ++ai)
#pragma unroll
                for (int m = 0; m < 4; ++m) {
                    const int t = row0 + ai * HALF + m * 16, pos = t & (NS - 1), bb = t >> 11;
#pragma unroll
                    for (int n = 0; n < 2; ++n) {
                        st_bf16x4(KR + (size_t)t * 128 + wc * 32 + n * 16 + fq * 4, acc[ai][0][m][n] * sc);
                        st_bf16x4(VT + (size_t)t * 128 + wc * 32 + n * 16 + fq * 4, acc[ai][1][m][n] * sc);
                    }
                }
        } else {
            bf16_t* KI = (bf16_t*)(proj + PJ_KI); float* WI = (float*)(proj + PJ_WI);
#pragma unroll
            for (int ai = 0; ai < 2; ++ai)
#pragma unroll
                for (int m = 0; m < 4; ++m) {
                    const int t = row0 + ai * HALF + m * 16;
                    if (wc < 2) {
#pragma unroll
                        for (int n = 0; n < 2; ++n) st_bf16x4(KI + (size_t)t * 64 + wc * 32 + n * 16 + fq * 4, acc[ai][0][m][n] * sc);
                    } else if (wc == 2) {
                        *(GAS f32x4*)(WI + (size_t)t * 16 + fq * 4) = acc[ai][0][m][0] * sc;
                    }
                }
        }
    }
};

constexpr float ATT_KS = 16.0f, ATT_QS = 64.0f;
__device__ __forceinline__ void knorm_phase(int wv, const unsigned char* proj, const float* __restrict__ k_norm, bf16_t* __restrict__ Kn) {
    const int tid = tid_fresh(wv), lane = tid & 63;
    const bf16_t* KR = (const bf16_t*)(proj + PJ_KR);
    const int sub = tid & 15;
    float kw[8];
#pragma unroll
    for (int i = 0; i < 8; ++i) kw[i] = k_norm[sub * 8 + i];
    for (int t = (blockIdx.x * NT + tid) >> 4; t < NTOK; t += (gridDim.x * NT) >> 4) {
        const u32x4 v = *(const u32x4*)(KR + (size_t)t * 128 + sub * 8);
        float f[8] = {bflo(v.x), bfhi(v.x), bflo(v.y), bfhi(v.y), bflo(v.z), bfhi(v.z), bflo(v.w), bfhi(v.w)};
        float ss = 0.f;
#pragma unroll
        for (int i = 0; i < 8; ++i) ss += f[i] * f[i];
        ss += shx(ss, 1, lane); ss += shx(ss, 2, lane); ss += shx(ss, 4, lane); ss += shx(ss, 8, lane);
        const float rs = rsqrtf(ss * (1.0f / 128.0f) + RMS_EPS);
        u32x2 o; o.x = pack_fp8x4(f[0] * rs * kw[0] * ATT_KS, f[1] * rs * kw[1] * ATT_KS, f[2] * rs * kw[2] * ATT_KS, f[3] * rs * kw[3] * ATT_KS);
        o.y = pack_fp8x4(f[4] * rs * kw[4] * ATT_KS, f[5] * rs * kw[5] * ATT_KS, f[6] * rs * kw[6] * ATT_KS, f[7] * rs * kw[7] * ATT_KS);
        *(u32x2*)((unsigned char*)Kn + (size_t)t * 128 + sub * 8) = o;
    }
}

__device__ __forceinline__ unsigned f2sort(float f) { const unsigned u = __float_as_uint(f); return (u & 0x80000000u) ? ~u : (u | 0x80000000u); }
constexpr int IDX_SC_BYTES = 8 * 2 * 2048 * 4;
constexpr int IDX_KT_BYTES = 64 * 144;
#define WRLANE2(word, lo, hi, lane_idx) asm("s_nop 1\n\tv_writelane_b32 %0, %1, " #lane_idx "\n\tv_writelane_b32 %0, %2, " #lane_idx "+1" : "+v"(word) : "s"(lo), "s"(hi))
typedef short s16x2_t __attribute__((ext_vector_type(2)));
__device__ __forceinline__ unsigned relu_bf16x2(unsigned v) { const s16x2_t z = {0, 0}; return __builtin_bit_cast(unsigned, __builtin_elementwise_max(__builtin_bit_cast(s16x2_t, v), z)); }
__device__ __forceinline__ void indexer_phase(int wv, const unsigned char* proj, unsigned* __restrict__ MASK, unsigned char* lds) {
    const int tid = tid_fresh(wv), lane = tid & 63, fr = lane & 15, fq = lane >> 4;
    const bf16_t* QI = (const bf16_t*)(proj + PJ_QI); const bf16_t* KI = (const bf16_t*)(proj + PJ_KI); const float* WI = (const float*)(proj + PJ_WI);
    float* scl = (float*)lds + (size_t)wv * 2 * 2048;
    unsigned char* ktl = lds + IDX_SC_BYTES;
    const int nunits = NB * 128;
    for (int uu = blockIdx.x; uu < nunits; uu += gridDim.x) {
        int b, q16;
        if (gridDim.x == 256) { b = blockIdx.x >> 4; const int r = blockIdx.x & 15, k = (uu - blockIdx.x) / 256; q16 = (k & 1) ? (k >> 1) * 32 + 31 - r : (k >> 1) * 32 + r; }
        else { b = uu >> 7; q16 = uu & 127; }
        const int p0 = q16 * 16, pw = p0 + 2 * wv;
        const size_t t0 = (size_t)b * NS + pw;
        bf16x8 qa[2][2], wa;
#pragma unroll
        for (int tk = 0; tk < 2; ++tk)
#pragma unroll
            for (int ks = 0; ks < 2; ++ks) qa[tk][ks] = *(const bf16x8*)(QI + (t0 + tk) * 1024 + fr * 64 + ks * 32 + fq * 8);
        {
            const f32x4 w0 = *(const f32x4*)(WI + (t0 + 0) * 16 + fq * 4), w1 = *(const f32x4*)(WI + (t0 + 1) * 16 + fq * 4);
            u32x4 wp = (u32x4){0u, 0u, 0u, 0u};
            if (fr == 0) { wp.x = cvt_pk_bf16(w0[0], w0[1]); wp.y = cvt_pk_bf16(w0[2], w0[3]); }
            if (fr == 1) { wp.z = cvt_pk_bf16(w1[0], w1[1]); wp.w = cvt_pk_bf16(w1[2], w1[3]); }
            wa = __builtin_bit_cast(bf16x8, wp);
        }
        const int nkt = (p0 >> 6) + 1;
        const int krow = tid >> 3, kch = tid & 7;
        const bf16_t* kgp = KI + ((size_t)b * NS + krow) * 64 + kch * 8;
        const int klast = nkt - 1;
#define IDX_LD(x) (*(const u32x4*)(kgp + (size_t)((x) < klast ? (x) : klast) * (64 * 64)))
        u32x4 kr0 = IDX_LD(0), kr1 = IDX_LD(1), kr2 = IDX_LD(2), kr3 = IDX_LD(3);
        __syncthreads();
        *(u32x4*)(ktl + krow * 144 + kch * 16) = kr0;
        kr0 = IDX_LD(4);
        __syncthreads();
#define IDX_SB __builtin_amdgcn_sched_barrier(0);
#define IDX_TILE(KT, KRN) { \
            const int kt_ = (KT); \
            const unsigned char* kc = ktl + (kt_ & 1) * IDX_KT_BYTES; \
            bf16x8 kf[4][2]; \
            _Pragma("unroll") \
            for (int st = 0; st < 4; ++st) { kf[st][0] = *(const bf16x8*)(kc + (st * 16 + fr) * 144 + fq * 16); kf[st][1] = *(const bf16x8*)(kc + (st * 16 + fr) * 144 + 64 + fq * 16); } \
            f32x4 dd[4][2]; \
            IDX_SB \
            _Pragma("unroll") \
            for (int st = 0; st < 4; ++st) { \
                _Pragma("unroll") \
                for (int tk = 0; tk < 2; ++tk) dd[st][tk] = __builtin_amdgcn_mfma_f32_16x16x32_bf16(qa[tk][0], kf[st][0], (f32x4){0.f, 0.f, 0.f, 0.f}, 0, 0, 0); } \
            IDX_SB \
            _Pragma("unroll") \
            for (int st = 0; st < 4; ++st) { \
                _Pragma("unroll") \
                for (int tk = 0; tk < 2; ++tk) dd[st][tk] = __builtin_amdgcn_mfma_f32_16x16x32_bf16(qa[tk][1], kf[st][1], dd[st][tk], 0, 0, 0); } \
            IDX_SB \
            u32x4 rb[4]; \
            _Pragma("unroll") \
            for (int st = 0; st < 4; ++st) { \
                rb[st].x = relu_bf16x2(cvt_pk_bf16(dd[st][0][0], dd[st][0][1])); rb[st].y = relu_bf16x2(cvt_pk_bf16(dd[st][0][2], dd[st][0][3])); \
                rb[st].z = relu_bf16x2(cvt_pk_bf16(dd[st][1][0], dd[st][1][1])); rb[st].w = relu_bf16x2(cvt_pk_bf16(dd[st][1][2], dd[st][1][3])); } \
            IDX_SB \
            f32x4 sc[4]; \
            _Pragma("unroll") \
            for (int st = 0; st < 4; ++st) sc[st] = __builtin_amdgcn_mfma_f32_16x16x32_bf16(wa, __builtin_bit_cast(bf16x8, rb[st]), (f32x4){0.f, 0.f, 0.f, 0.f}, 0, 0, 0); \
            IDX_SB \
            if (kt_ == klast) { \
                _Pragma("unroll") \
                for (int st = 0; st < 4; ++st) { \
                    const int s = kt_ * 64 + st * 16 + fr; \
                    float v0 = sc[st][0], v1 = sc[st][1]; \
                    if (s > pw) v0 = -__builtin_inff(); \
                    if (s > pw + 1) v1 = -__builtin_inff(); \
                    if (fq == 0) { scl[s] = v0; scl[2048 + s] = v1; } \
                } \
            } else { \
                _Pragma("unroll") \
                for (int st = 0; st < 4; ++st) if (fq == 0) { scl[kt_ * 64 + st * 16 + fr] = sc[st][0]; scl[2048 + kt_ * 64 + st * 16 + fr] = sc[st][1]; } \
            } \
            if (kt_ + 1 < nkt) *(u32x4*)(ktl + ((kt_ + 1) & 1) * IDX_KT_BYTES + krow * 144 + kch * 16) = KRN; \
            KRN = IDX_LD(kt_ + 5); \
            __syncthreads(); }
        for (int kt = 0; kt < nkt; kt += 4) {
            IDX_TILE(kt, kr1)
            if (kt + 1 >= nkt) break;
            IDX_TILE(kt + 1, kr2)
            if (kt + 2 >= nkt) break;
            IDX_TILE(kt + 2, kr3)
            if (kt + 3 >= nkt) break;
            IDX_TILE(kt + 3, kr0)
        }
#undef IDX_TILE
#undef IDX_LD
        const int kbmax = klast;
#pragma unroll
        for (int tk = 0; tk < 2; ++tk) {
            const int p = pw + tk;
            unsigned u[32];
#pragma unroll
            for (int kb = 0; kb < 32; ++kb) u[kb] = (kb <= kbmax) ? f2sort(scl[tk * 2048 + kb * 64 + lane]) : 0u;
            unsigned thr = 0x00800000u;
            if (p + 1 > 256) {
                unsigned t = 0u;
                for (int bit = 31; bit >= 0; --bit) {
                    const unsigned cand = t | (1u << bit);
                    int n = 0;
#pragma unroll
                    for (int g8 = 0; g8 < 4; ++g8) {
                        if (g8 * 8 <= kbmax) {
#pragma unroll
                            for (int h4 = 0; h4 < 2; ++h4) {
                                unsigned long long m[4];
#pragma unroll
                                for (int kk = 0; kk < 4; ++kk) m[kk] = __ballot(u[g8 * 8 + h4 * 4 + kk] >= cand);
                                IDX_SB
#pragma unroll
                                for (int kk = 0; kk < 4; ++kk) n += __builtin_popcountll(m[kk]);
                                IDX_SB
                            }
                        }
                    }
                    if (n >= 256) t = cand;
                    if (n == 256) break;
                }
                thr = t;
            }
            int word = 0;
#define IDX_W(kb) { const unsigned long long bm = __ballot(u[kb] >= thr); const int lo_ = (int)(unsigned)bm, hi_ = (int)(unsigned)(bm >> 32); WRLANE2(word, lo_, hi_, (kb) * 2); }
            IDX_W(0) IDX_W(1) IDX_W(2) IDX_W(3) IDX_W(4) IDX_W(5) IDX_W(6) IDX_W(7) IDX_W(8) IDX_W(9) IDX_W(10) IDX_W(11) IDX_W(12) IDX_W(13) IDX_W(14) IDX_W(15)
            IDX_W(16) IDX_W(17) IDX_W(18) IDX_W(19) IDX_W(20) IDX_W(21) IDX_W(22) IDX_W(23) IDX_W(24) IDX_W(25) IDX_W(26) IDX_W(27) IDX_W(28) IDX_W(29) IDX_W(30) IDX_W(31)
#undef IDX_W
            MASK[(t0 + tk) * 64 + lane] = (unsigned)word;
        }
#undef IDX_SB
    }
    __syncthreads();
}

constexpr int CV_ZONE = 81920;
__device__ __forceinline__ void cv_issue(int wv, int q) {
    static_assert(F8_L1, "the deferred tiles are fp8");
    const WTile d = wt_decode(wt_l1_tile(q));
    int l; asm volatile("v_mbcnt_lo_u32_b32 %0, -1, 0\n\tv_mbcnt_hi_u32_b32 %0, -1, %0" : "=v"(l));
    const float* sb = lauv(d.src);
    const int ldn = lauv(d.ldn), k0 = lauv(d.k0), n0 = lauv(d.n0), nmax = lauv(d.N) - 4;
#pragma unroll
    for (int j = 0; j < 8; ++j) {
        const int slot = j * 8 + wv, row = slot * 2 + (l >> 5), p = l & 31, c = p ^ ((row >> 4) & 7);
        int col = n0 + c * 4; col = col < nmax ? col : nmax;
        const unsigned voff = (unsigned)((k0 + row) * ldn + col) * 4u;
        const unsigned m0v = (unsigned)(CV_ZONE + slot * 1024);
        unsigned keep;
        asm volatile("s_mov_b32 %0, m0\n\ts_mov_b32 m0, %3\n\ts_nop 0\n\tglobal_load_lds_dwordx4 %1, %2\n\ts_mov_b32 m0, %0" : "=&s"(keep) : "v"(voff), "s"(sb), "s"(m0v) : "memory");
    }
}
__device__ __forceinline__ void cv_consume(int wv, int q, unsigned char* lds) {
    asm volatile("s_waitcnt vmcnt(0)" ::: "memory");
    __syncthreads();
    const WTile d = wt_decode(wt_l1_tile(q));
    const int tid = tid_fresh(wv);
    const float* zone = (const float*)(lds + CV_ZONE);
#pragma unroll
    for (int rep = 0; rep < 2; ++rep) {
        const int item = tid + rep * NT, nl = item >> 3, kc = item & 7, n = d.n0 + nl;
        if (n < d.N) {
            float f[16];
#pragma unroll
            for (int j = 0; j < 16; ++j) f[j] = zone[(kc * 16 + j) * 128 + ((nl >> 2) ^ kc) * 4 + (nl & 3)];
            const int row = wt_row(d, n);
            u32x4 o;
            o.x = pack_fp8x4(f[0] * W8_SCALE, f[1] * W8_SCALE, f[2] * W8_SCALE, f[3] * W8_SCALE); o.y = pack_fp8x4(f[4] * W8_SCALE, f[5] * W8_SCALE, f[6] * W8_SCALE, f[7] * W8_SCALE);
            o.z = pack_fp8x4(f[8] * W8_SCALE, f[9] * W8_SCALE, f[10] * W8_SCALE, f[11] * W8_SCALE); o.w = pack_fp8x4(f[12] * W8_SCALE, f[13] * W8_SCALE, f[14] * W8_SCALE, f[15] * W8_SCALE);
            *(GAS u32x4*)(d.dst + (size_t)row * d.ldk + d.k0 + kc * 16) = o;
        }
    }
    __syncthreads();
}
__device__ __forceinline__ void attn_phase(int wv, const unsigned char* proj, const unsigned* __restrict__ MASK, const float* __restrict__ q_norm, const float* __restrict__ k_norm, const float* __restrict__ rel_bias,
                           bf16_t* __restrict__ AO, unsigned char* lds) {
    const int tid = tid_fresh(wv), lane = tid & 63, w = wv  , fr = lane & 15, fq = lane >> 4;
    int vz = 0; asm volatile("" : "+v"(vz));
    const bf16_t* Q1 = (const bf16_t*)(proj + PJ_Q1); const bf16_t* Kn = (const bf16_t*)(proj + PJ_KN); const bf16_t* VT = (const bf16_t*)(proj + PJ_VT1);
    constexpr int ATT_BUF = 17408 + 18432;
    bf16_t* K_lds = (bf16_t*)lds;
    bf16_t* V_lds = (bf16_t*)(lds + 17408);
    float* bt = (float*)(lds + 2 * ATT_BUF);
    const float LOG2E = 1.4426950408889634f;
    float mq = 0.f, mk = 0.f;
    for (int i = 0; i < 128; ++i) { mq = fmaxf(mq, fabsf(q_norm[i])); mk = fmaxf(mk, fabsf(k_norm[i])); }
    const float Mb2 = 11.313708499f * mq * mk * LOG2E;
    __syncthreads();
    for (int i = tid; i < 128 * 16; i += NT) {
        const int d = i >> 4, h = i & 15;
        int bk = d;
        if (d >= 16) { bk = 16 + (int)(logf((float)d / 16.0f) / 2.0794415416798357f * 16.0f); bk = bk > 31 ? 31 : bk; }
        bt[i] = (rel_bias[bk * 16 + h] - rel_bias[31 * 16 + h]) * LOG2E;
    }
    __syncthreads();
    const int nunits = NB * 128;
    int cvq = blockIdx.x, cvcur = -1;
#define CV_STEP do { if (cvcur >= 0) { cv_consume(wv, cvcur, lds); cvcur = -1; } if (cvq < WT_L1) { cv_issue(wv, cvq); cvcur = cvq; cvq += (int)gridDim.x; } } while (0)
    for (int uu = blockIdx.x; uu < nunits; uu += gridDim.x) {
        int b, q16;
        if (gridDim.x == 256) { b = blockIdx.x >> 4; const int r = blockIdx.x & 15, k = (uu - blockIdx.x) / 256; q16 = (k & 1) ? (k >> 1) * 32 + 31 - r : (k >> 1) * 32 + r; }
        else { b = uu >> 7; q16 = uu & 127; }
        const int p0 = q16 * 16;
        const size_t tb = (size_t)b * NS;
        CV_STEP;
        v8i qf[2];
#pragma unroll
        for (int tk = 0; tk < 2; ++tk) {
            const size_t t = tb + p0 + 2 * w + tk;
            float f[32]; float ss = 0.f;
#pragma unroll
            for (int i = 0; i < 2; ++i) {
                const u32x4 v = *(const u32x4*)((const unsigned char*)Q1 + t * 2048 + fr * 128 + fq * 32 + i * 16);
                const int wds[4] = {(int)v.x, (int)v.y, (int)v.z, (int)v.w};
#pragma unroll
                for (int q4 = 0; q4 < 4; ++q4) {
                    f[i * 16 + q4 * 4 + 0] = __builtin_amdgcn_cvt_f32_fp8(wds[q4], 0); f[i * 16 + q4 * 4 + 1] = __builtin_amdgcn_cvt_f32_fp8(wds[q4], 1);
                    f[i * 16 + q4 * 4 + 2] = __builtin_amdgcn_cvt_f32_fp8(wds[q4], 2); f[i * 16 + q4 * 4 + 3] = __builtin_amdgcn_cvt_f32_fp8(wds[q4], 3);
                }
            }
#pragma unroll
            for (int i = 0; i < 32; ++i) ss += f[i] * f[i];
            ss += shx(ss, 16, lane); ss += shx(ss, 32, lane);
            const float rs = rsqrtf(ss * (1.0f / (128.0f * Q8_SCALE * Q8_SCALE)) + RMS_EPS) * (0.08838834764831845f * LOG2E * ATT_QS / Q8_SCALE);
            const float* qn = q_norm + fq * 32;
#pragma unroll
            for (int i = 0; i < 8; ++i) qf[tk][i] = (int)pack_fp8x4(f[i * 4 + 0] * rs * qn[i * 4 + 0], f[i * 4 + 1] * rs * qn[i * 4 + 1], f[i * 4 + 2] * rs * qn[i * 4 + 2], f[i * 4 + 3] * rs * qn[i * 4 + 3]);
        }
        f32x4 oacc[2][8];
#pragma unroll
        for (int tk = 0; tk < 2; ++tk)
#pragma unroll
            for (int dt = 0; dt < 8; ++dt) oacc[tk][dt] = (f32x4){0.f, 0.f, 0.f, 0.f};
        float lsum[2] = {0.f, 0.f};
        const int nkt = (p0 >> 6) + 1;
        const int kr0 = tid >> 3, kc0 = tid & 7, vr0 = tid >> 4, vc0 = tid & 15;
        const unsigned char* kgp = (const unsigned char*)Kn + (tb + kr0) * 128 + kc0 * 16;
        const bf16_t* vgp = VT + (tb + vr0) * 128 + vc0 * 8;
        const unsigned* mp0 = MASK + (tb + p0 + 2 * w) * 64 + vz;
        u32x4 kreg, vreg[2]; unsigned mreg[2][2];
        kreg = *(const u32x4*)(kgp);
        vreg[0] = *(const u32x4*)(vgp); vreg[1] = *(const u32x4*)(vgp + 32 * 128);
        mreg[0][0] = mp0[0]; mreg[0][1] = mp0[1]; mreg[1][0] = mp0[64]; mreg[1][1] = mp0[65];
        __syncthreads();
        *(u32x4*)((unsigned char*)K_lds + kr0 * 144 + kc0 * 16) = kreg;
        *(u32x4*)(V_lds + vr0 * 144 + vc0 * 8) = vreg[0]; *(u32x4*)(V_lds + (vr0 + 32) * 144 + vc0 * 8) = vreg[1];
        __syncthreads();
        for (int kt = 0; kt < nkt; ++kt) {
            const int s0 = kt * 64;
            const bf16_t* Kc = K_lds + (kt & 1) * (ATT_BUF / 2); const bf16_t* Vc = V_lds + (kt & 1) * (ATT_BUF / 2);
            const unsigned m00 = mreg[0][0], m01 = mreg[0][1], m10 = mreg[1][0], m11 = mreg[1][1];
            if (kt + 1 < nkt) {
                kreg = *(const u32x4*)(kgp + (size_t)(s0 + 64) * 128);
                vreg[0] = *(const u32x4*)(vgp + (size_t)(s0 + 64) * 128); vreg[1] = *(const u32x4*)(vgp + (size_t)(s0 + 64 + 32) * 128);
                mreg[0][0] = mp0[2 * kt + 2]; mreg[0][1] = mp0[2 * kt + 3]; mreg[1][0] = mp0[64 + 2 * kt + 2]; mreg[1][1] = mp0[64 + 2 * kt + 3];
            }
            const bool use_bias = (s0 + 63 + 128 > p0);
            f32x4 dA[2], dB[2]; unsigned pk[4][2][2];
            auto s_sub = [&](int sub, f32x4 (&d)[2]) {
                const unsigned char* kp = (const unsigned char*)Kc + (sub * 16 + fr) * 144 + fq * 32;
                const i32x4 klo = *(const i32x4*)kp, khi = *(const i32x4*)(kp + 16);
                const v8i kf = __builtin_shufflevector(klo, khi, 0, 1, 2, 3, 4, 5, 6, 7);
#pragma unroll
                for (int tk = 0; tk < 2; ++tk) {
                    d[tk] = (f32x4){-Mb2 * (ATT_QS * ATT_KS), -Mb2 * (ATT_QS * ATT_KS), -Mb2 * (ATT_QS * ATT_KS), -Mb2 * (ATT_QS * ATT_KS)};
                    d[tk] = __builtin_amdgcn_mfma_scale_f32_16x16x128_f8f6f4(kf, qf[tk], d[tk], 0, 0, 0, 0, 0, 0);
                }
            };
            auto soft = [&](int sub, const f32x4 (&d)[2]) {
#pragma unroll
                for (int tk = 0; tk < 2; ++tk) {
                    const int p = p0 + 2 * w + tk;
                    const unsigned mw = (sub < 2) ? (tk ? m10 : m00) : (tk ? m11 : m01);
                    const unsigned nib = (mw >> ((sub & 1) * 16 + fq * 4)) & 15u;
                    float pv[4];
                    f32x4 xx = d[tk] * (1.0f / (ATT_QS * ATT_KS));
                    if (use_bias) {
#pragma unroll
                        for (int j = 0; j < 4; ++j) { const int dd = p - (s0 + sub * 16 + fq * 4 + j); if (dd >= 0 && dd < 128) xx[j] += bt[dd * 16 + fr]; }
                    }
#pragma unroll
                    for (int j = 0; j < 4; ++j) {
                        const float x = xx[j];
                        float e = __builtin_amdgcn_exp2f(x);
                        e = ((nib >> j) & 1u) ? e : 0.f;
                        lsum[tk] += e; pv[j] = e;
                    }
                    pk[sub][tk][0] = cvt_pk_bf16(pv[0], pv[1]); pk[sub][tk][1] = cvt_pk_bf16(pv[2], pv[3]);
                }
            };
            auto pv_pair = [&](int kk) {
                bf16x8 pfr[2];
#pragma unroll
                for (int tk = 0; tk < 2; ++tk) { u32x4 a0; a0.x = pk[2 * kk][tk][0]; a0.y = pk[2 * kk][tk][1]; a0.z = pk[2 * kk + 1][tk][0]; a0.w = pk[2 * kk + 1][tk][1]; pfr[tk] = __builtin_bit_cast(bf16x8, a0); }
#pragma unroll
                for (int dt = 0; dt < 8; ++dt) {
                    const bf16_t* vp = Vc + ((2 * kk) * 16 + fq * 4 + (fr >> 2)) * 144 + dt * 16 + (fr & 3) * 4;
                    const s16x4_t va = __builtin_amdgcn_ds_read_tr16_b64_v4i16((__attribute__((address_space(3))) s16x4_t*)(vp));
                    const s16x4_t vb = __builtin_amdgcn_ds_read_tr16_b64_v4i16((__attribute__((address_space(3))) s16x4_t*)(vp + 16 * 144));
                    const bf16x8 vf = __builtin_bit_cast(bf16x8, __builtin_shufflevector(va, vb, 0, 1, 2, 3, 4, 5, 6, 7));
#pragma unroll
                    for (int tk = 0; tk < 2; ++tk) oacc[tk][dt] = __builtin_amdgcn_mfma_f32_16x16x32_bf16(vf, pfr[tk], oacc[tk][dt], 0, 0, 0);
                }
            };
            s_sub(0, dA);
            __builtin_amdgcn_sched_barrier(0);
            s_sub(1, dB); soft(0, dA);
            __builtin_amdgcn_sched_barrier(0);
            s_sub(2, dA); soft(1, dB); pv_pair(0);
            __builtin_amdgcn_sched_barrier(0);
            s_sub(3, dB); soft(2, dA);
            __builtin_amdgcn_sched_barrier(0);
            soft(3, dB); pv_pair(1);
            __builtin_amdgcn_sched_barrier(0);
            if (kt + 1 < nkt) {
                bf16_t* Kn_ = K_lds + ((kt + 1) & 1) * (ATT_BUF / 2); bf16_t* Vn_ = V_lds + ((kt + 1) & 1) * (ATT_BUF / 2);
                *(u32x4*)((unsigned char*)Kn_ + kr0 * 144 + kc0 * 16) = kreg;
                *(u32x4*)(Vn_ + vr0 * 144 + vc0 * 8) = vreg[0]; *(u32x4*)(Vn_ + (vr0 + 32) * 144 + vc0 * 8) = vreg[1];
            }
            __syncthreads();
            if ((kt & 3) == 3) CV_STEP;
        }
#pragma unroll
        for (int tk = 0; tk < 2; ++tk) {
            float l = lsum[tk];
            l += shx(l, 16, lane); l += shx(l, 32, lane);
            const float il = 1.0f / l;
            const size_t ob = (tb + p0 + 2 * w + tk) * 2048 + fr * 128 + fq * 4;
#pragma unroll
            for (int dt = 0; dt < 8; ++dt) {
                const f32x4 o = oacc[tk][dt] * il;
                if (F8_L1) *(unsigned*)((unsigned char*)AO + ob + dt * 16) = pack_fp8x4(o[0] * Y8_SCALE, o[1] * Y8_SCALE, o[2] * Y8_SCALE, o[3] * Y8_SCALE);
                else st_bf16x4(AO + ob + dt * 16, o);
            }
        }
    }
    while (cvcur >= 0 || cvq < WT_L1) CV_STEP;
#undef CV_STEP
    __syncthreads();
}

#ifndef DUPMASK
#define DUPMASK 0
#endif
#define REPS(k) (((DUPMASK >> (k)) & 1) ? 2 : 1)

__device__ __forceinline__ unsigned char* opq(unsigned char* p) { asm volatile("" : "+s"(p)); return p; }

__global__ void __launch_bounds__(NT, 2) fwd(Args a_unused) {
    extern __shared__ __attribute__((aligned(16))) unsigned char lds[];
    volatile LAS unsigned* misc = (volatile LAS unsigned*)(lds + LDS_MISC);
    const int wv = __builtin_amdgcn_readfirstlane((int)(threadIdx.x >> 6));
    { const int t0 = tid_fresh(wv); if (t0 < 4) misc[t0] = 0u; }
    __syncthreads();
    XcdBarrier bar = xcd_barrier_post((unsigned*)(KA().ws() + WS_CTL), misc, wv);
    const int G = gridDim.x, bx = blockIdx.x;

    for (int rep = 0; rep < REPS(0); ++rep) { p0_prologue(wv, lds); xcd_barrier(bar); }

    for (int rep = 0; rep < REPS(1); ++rep) {
        const KA a; unsigned char* ws = a.ws();
        norm_phase<false, false, F8_P2, false, F8_P2_MIX>(wv, a.in(I_X), nullptr, a.in(I_NORM_MIX), (const float*)(ws + WS_MOD) + 0 * 16 * 6144, (bf16_t*)(ws + WS_H), lds, nullptr, nullptr, nullptr, nullptr, nullptr);
        xcd_barrier(bar);
    }
    for (int rep = 0; rep < REPS(2); ++rep) {
        const KA a; unsigned char* ws = a.ws();
        const int nM = NTOK / BM, nN = N_IN0 / BM;
        for (int k = 0, u = unit_index(0); u < nM * nN; u = unit_index(++k)) {
            int pm, pn; dense_tile(u, nN, pm, pn);
            RowPlain ro{(unsigned)(pm * BM) * ND, (unsigned)ND};
            const bool t8 = F8_P2 || (((unsigned)F8_P2_TILES >> pn) & 1u) != 0u;
            EpiIn0 E{ws + WS_PROJ, (const float2*)(ws + WS_ROT), pm, pn, (LAS bf16_t*)lds, wv, t8 ? 1.0f / W8_SCALE : 1.0f};
            if (t8) { RowPlain r8{(unsigned)(pm * BM) * (ND / 2), (unsigned)(ND / 2)};
                      gemm_unit<true>(wv, (bf16_t*)lds, (const bf16_t*)(F8_P2 ? ws + WS_H : ws + WS_H8), r8, (const bf16_t*)(ws + WS_WIN0F8 + (size_t)pn * BM * ND), ND / 2, ND / 2, E); }
            else gemm_unit<false>(wv, (bf16_t*)lds, (const bf16_t*)(ws + WS_H), ro, (const bf16_t*)(ws + WS_WIN0) + (size_t)pn * BM * ND, ND, ND, E);
        }
        xcd_barrier(bar);
    }
    for (int rep = 0; rep < REPS(3); ++rep) { const KA a; unsigned char* ws = a.ws(); retention_phase(wv, ws + WS_PROJ, (bf16_t*)(ws + WS_O), lds); xcd_barrier(bar); }
    for (int rep = 0; rep < REPS(4); ++rep) { const KA a; unsigned char* ws = a.ws(); ycat_phase(wv, ws + WS_PROJ, (const bf16_t*)(ws + WS_O), a.in(I_CONVW), a.in(I_CONVB), (bf16_t*)(ws + WS_H)); xcd_barrier(bar); }
    for (int rep = 0; rep < REPS(5); ++rep) {
        const KA a; unsigned char* ws = a.ws();
        const int nM = NTOK / BM, nN = ND / BM;
        for (int k = 0, u = unit_index(0); u < nM * nN; u = unit_index(++k)) {
            int pm, pn; dense_tile(u, nN, pm, pn);
            RowPlain ro{(unsigned)(pm * BM) * ND, (unsigned)ND};
            EpiRes<false, true> E{a.in(I_X), nullptr, (bf16_t*)(ws + WS_XB), (const float*)(ws + WS_MOD) + 0 * 16 * 6144 + 4096, pm, pn, F8_P5 ? 1.0f / (W8_SCALE * Y8_SCALE) : 1.0f};
            if (F8_P5) { RowPlain r8{(unsigned)(pm * BM) * (ND / 2), (unsigned)(ND / 2)}; gemm_unit<true>(wv, (bf16_t*)lds, (const bf16_t*)(ws + WS_H), r8, (const bf16_t*)(ws + WS_WOUT0 + (size_t)pn * BM * ND), ND / 2, ND / 2, E); }
            else gemm_unit<false>(wv, (bf16_t*)lds, (const bf16_t*)(ws + WS_H), ro, (const bf16_t*)(ws + WS_WOUT0) + (size_t)pn * BM * ND, ND, ND, E);
        }
        xcd_barrier(bar);
    }
    {
        const KA a; unsigned char* ws = a.ws();
        route_phase(wv, (const bf16_t*)(ws + WS_XB), a.in(I_NORM_FFN), (const float*)(ws + WS_MOD) + 1 * 16 * 6144, ws + WS_H, lds, a.in(I_WR), a.in(I_BR), (unsigned*)(ws + WS_CTL + CTL_CNT + 0 * 4096), (int*)(ws + WS_IDX), (float*)(ws + WS_GT));
        xcd_barrier(bar);
    }
    for (int rep = 0; rep < REPS(7); ++rep) { moe_phase1(wv, KA().ws(), 0, lds); xcd_barrier(bar); }
    { moe_phase2(wv, KA().ws(), 0, lds); xcd_barrier(bar); }

    for (int rep = 0; rep < REPS(9); ++rep) {
        const KA a; unsigned char* ws = a.ws();
        norm_phase<true, false, F8_L1 != 0, true, false, true>(wv, ws + WS_XB, (const bf16_t*)(ws + WS_TMP), a.in(I_NORM_MIX) + ND, (const float*)(ws + WS_MOD) + 2 * 16 * 6144, (bf16_t*)(ws + WS_H), lds, nullptr, nullptr, nullptr, nullptr, nullptr, (const bf16_t*)(ws + WS_TMP + 64 * MiB), (const float*)(ws + WS_MOD) + 1 * 16 * 6144 + 4096);
        xcd_barrier(bar);
    }
    for (int rep = 0; rep < REPS(10); ++rep) {
        const int nM = NTOK / BM, nN = N_IN1P / BM;
        for (int k = 0, u = unit_index(0); u < nM * nN; u = unit_index(++k)) {
            const KA a; unsigned char* ws = a.ws();
            int pm, pn; dense_tile(u, nN, pm, pn);
            RowPlain ro{(unsigned)(pm * BM) * ND, (unsigned)ND};
            EpiIn1 E{ws + WS_PROJ, pm, pn, F8_L1 ? 1.0f / W8_SCALE : 1.0f};
            if (F8_L1) { RowPlain r8{(unsigned)(pm * BM) * (ND / 2), (unsigned)(ND / 2)}; gemm_unit<true>(wv, (bf16_t*)lds, (const bf16_t*)(ws + WS_H), r8, (const bf16_t*)(ws + WS_WIN1 + (size_t)pn * BM * ND), ND / 2, ND / 2, E); }
            else gemm_unit<false>(wv, (bf16_t*)lds, (const bf16_t*)(ws + WS_H), ro, (const bf16_t*)(ws + WS_WIN1) + (size_t)pn * BM * ND, ND, ND, E);
        }
        xcd_barrier(bar);
    }
    for (int rep = 0; rep < REPS(11); ++rep) {
        const KA a; unsigned char* ws = a.ws();
        knorm_phase(wv, ws + WS_PROJ, a.in(I_KN), (bf16_t*)(ws + WS_PROJ + PJ_KN));
        indexer_phase(wv, ws + WS_PROJ, (unsigned*)(ws + WS_MASK), lds);
        xcd_barrier(bar);
    }
    for (int rep = 0; rep < REPS(12); ++rep) { const KA a; unsigned char* ws = a.ws(); attn_phase(wv, ws + WS_PROJ, (const unsigned*)(ws + WS_MASK), a.in(I_QN), a.in(I_KN), a.in(I_RELB), (bf16_t*)(ws + WS_H), lds); xcd_barrier(bar); }
    {
        const KA a; unsigned char* ws = a.ws();
        const int nM = NTOK / BM, nN = ND / BM;
        for (int k = 0, u = unit_index(0); u < nM * nN; u = unit_index(++k)) {
            int pm, pn; dense_tile(u, nN, pm, pn);
            RowPlain ro{(unsigned)(pm * BM) * ND, (unsigned)ND};
            EpiRes<false, false> E{ws + WS_XB, nullptr, (bf16_t*)(ws + WS_XB), (const float*)(ws + WS_MOD) + 2 * 16 * 6144 + 4096, pm, pn, F8_L1 ? 1.0f / (W8_SCALE * Y8_SCALE) : 1.0f};
            if (F8_L1) { RowPlain r8{(unsigned)(pm * BM) * (ND / 2), (unsigned)(ND / 2)}; gemm_unit<true>(wv, (bf16_t*)lds, (const bf16_t*)(ws + WS_H), r8, (const bf16_t*)(ws + WS_WOUT1 + (size_t)pn * BM * ND), ND / 2, ND / 2, E); }
            else gemm_unit<false>(wv, (bf16_t*)lds, (const bf16_t*)(ws + WS_H), ro, (const bf16_t*)(ws + WS_WOUT1) + (size_t)pn * BM * ND, ND, ND, E);
        }
        xcd_barrier(bar);
    }
    {
        const KA a; unsigned char* ws = a.ws();
        route_phase(wv, (const bf16_t*)(ws + WS_XB), a.in(I_NORM_FFN) + ND, (const float*)(ws + WS_MOD) + 3 * 16 * 6144, ws + WS_H, lds, a.in(I_WR), a.in(I_BR), (unsigned*)(ws + WS_CTL + CTL_CNT + 1 * 4096), (int*)(ws + WS_IDX), (float*)(ws + WS_GT));
        xcd_barrier(bar);
    }
    { moe_phase1(wv, KA().ws(), 1, lds); xcd_barrier(bar); }
    { moe_phase2(wv, KA().ws(), 1, lds); xcd_barrier(bar); }
    {
        const KA a; unsigned char* ws = a.ws();
        const bf16_t* tp = (const bf16_t*)(ws + WS_TMP); const bf16_t* xp = (const bf16_t*)(ws + WS_XB); f32x4* op = (f32x4*)a.out();
        const unsigned char* tp8 = (const unsigned char*)tp;
        for (size_t i = (size_t)bx * NT + tid_fresh(wv); i < (size_t)NTOK * ND / 8; i += (size_t)G * NT) {
            const u32x4 xv = *(const u32x4*)(xp + i * 8); const u32x2 tv = *(const u32x2*)(tp8 + i * 8), tw = *(const u32x2*)(tp8 + 64 * MiB + i * 8);
            const float* gp = (const float*)(ws + WS_MOD) + 3 * 16 * 6144 + 4096 + (size_t)((i * 8) >> 22) * 6144 + ((i * 8) & 2047);
            const f32x4 g0 = *(const f32x4*)gp * (1.0f / T8_SCALE), g1 = *(const f32x4*)(gp + 4) * (1.0f / T8_SCALE);
            f32x4 a0, a1;
            a0[0] = bflo(xv.x) + (__builtin_amdgcn_cvt_f32_fp8((int)tv.x, 0) + __builtin_amdgcn_cvt_f32_fp8((int)tw.x, 0)) * g0[0]; a0[1] = bfhi(xv.x) + (__builtin_amdgcn_cvt_f32_fp8((int)tv.x, 1) + __builtin_amdgcn_cvt_f32_fp8((int)tw.x, 1)) * g0[1];
            a0[2] = bflo(xv.y) + (__builtin_amdgcn_cvt_f32_fp8((int)tv.x, 2) + __builtin_amdgcn_cvt_f32_fp8((int)tw.x, 2)) * g0[2]; a0[3] = bfhi(xv.y) + (__builtin_amdgcn_cvt_f32_fp8((int)tv.x, 3) + __builtin_amdgcn_cvt_f32_fp8((int)tw.x, 3)) * g0[3];
            a1[0] = bflo(xv.z) + (__builtin_amdgcn_cvt_f32_fp8((int)tv.y, 0) + __builtin_amdgcn_cvt_f32_fp8((int)tw.y, 0)) * g1[0]; a1[1] = bfhi(xv.z) + (__builtin_amdgcn_cvt_f32_fp8((int)tv.y, 1) + __builtin_amdgcn_cvt_f32_fp8((int)tw.y, 1)) * g1[1];
            a1[2] = bflo(xv.w) + (__builtin_amdgcn_cvt_f32_fp8((int)tv.y, 2) + __builtin_amdgcn_cvt_f32_fp8((int)tw.y, 2)) * g1[2]; a1[3] = bfhi(xv.w) + (__builtin_amdgcn_cvt_f32_fp8((int)tv.y, 3) + __builtin_amdgcn_cvt_f32_fp8((int)tw.y, 3)) * g1[3];
            op[i * 2] = a0; op[i * 2 + 1] = a1;
        }
    }
}

extern "C" void kernel_launch(void* const* d_in, const int* in_sizes, int n_in, void* d_out, int out_size, void* d_ws, size_t ws_size, hipStream_t stream) {
    static int grid = 0;
    if (grid == 0) {
        int dev = 0, cus = 0, per_cu = 0;
        if (n_in != 22 || ws_size < WS_END) { fprintf(stderr, "kernel_launch: unexpected n_in %d / ws_size %zu (need %zu)\n", n_in, ws_size, (size_t)WS_END); grid = -1; return; }
        (void)hipGetDevice(&dev);
        (void)hipDeviceGetAttribute(&cus, hipDeviceAttributeMultiprocessorCount, dev);
        if (hipFuncSetAttribute((const void*)fwd, hipFuncAttributeMaxDynamicSharedMemorySize, LDS_BYTES) != hipSuccess) { fprintf(stderr, "kernel_launch: hipFuncSetAttribute failed\n"); grid = -1; return; }
        (void)hipOccupancyMaxActiveBlocksPerMultiprocessor(&per_cu, (const void*)fwd, NT, LDS_BYTES);
        (void)hipGetLastError();
        if (per_cu < 1) fprintf(stderr, "kernel_launch: occupancy query reports %d\n", per_cu);
        grid = cus;
    }
    if (grid < 0) return;
    (void)hipMemsetAsync((char*)d_ws + WS_CTL, 0, 65536 + 4 * 16 * 6144 * 4, stream);
    Args a{};
    for (int i = 0; i < 22; ++i) a.in[i] = (const float*)d_in[i];
    a.out = (float*)d_out; a.ws = (unsigned char*)d_ws;
    hipLaunchKernelGGL(fwd, dim3(grid), dim3(NT), LDS_BYTES, stream, a);
}
```

```cpp
#include <hip/hip_runtime.h>
#include <stdint.h>
#include <stdio.h>

#define XB_TMO      128
#define XB_XCNT(j)  (256  + 64 * (j))
#define XB_XSUB(j)  (1280 + 64 * (j))
#define XB_XGEN(j)  (2304 + 64 * (j))
#define XB_TOP      3328
#define XB_TOPGEN   3392
#define XCD_BAR_WORDS 3456
#define XB_SPIN_CAP (1u << 18)
#define LAS __attribute__((address_space(3)))
#define GAS __attribute__((address_space(1)))

__device__ __forceinline__ unsigned xb_ld(unsigned* p)              { return __hip_atomic_load(p, __ATOMIC_RELAXED, __HIP_MEMORY_SCOPE_AGENT); }
__device__ __forceinline__ unsigned xb_add(unsigned* p, unsigned v) { return __hip_atomic_fetch_add(p, v, __ATOMIC_RELAXED, __HIP_MEMORY_SCOPE_AGENT); }
__device__ __forceinline__ unsigned xb_xcc_id() { return (unsigned)__builtin_amdgcn_s_getreg((3 << 11) | 20) & 0xFu; }
#define XB_SPIN(cond, bar) do { unsigned _sp = 0; while (cond) { __builtin_amdgcn_s_sleep(1); \
    if ((++_sp & 255u) == 0u) { if (xb_ld(&(bar)[XB_TMO])) break; if (_sp > XB_SPIN_CAP) { atomicAdd(&(bar)[XB_TMO], 1u); break; } } } } while (0)

struct XcdBarrier { unsigned* bar; unsigned x; volatile LAS unsigned* st; int wv; };
__device__ __forceinline__ bool xb_thread0(int wv) { int l; asm volatile("v_mbcnt_lo_u32_b32 %0, -1, 0\n\tv_mbcnt_hi_u32_b32 %0, -1, %0" : "=v"(l)); return wv == 0 && l == 0; }

__device__ __forceinline__ XcdBarrier xcd_barrier_post(unsigned* bar, volatile LAS unsigned* st, int wv) {
    XcdBarrier b; b.bar = bar; b.x = xb_xcc_id(); b.st = st; b.wv = wv;
    if (xb_thread0(wv)) (void)xb_add(&bar[XB_XCNT(b.x)], 1u);
    return b;
}
__device__ __forceinline__ void xcd_barrier_complete(unsigned* bar, unsigned x, unsigned& nloc, unsigned& nx) {
    const unsigned G = gridDim.x * gridDim.y * gridDim.z;
    unsigned sum, cnt, mine, sp = 0u;
    for (;;) {
        sum = 0u; cnt = 0u; mine = 0u;
#pragma unroll
        for (unsigned j = 0; j < 16; ++j) { const unsigned c = xb_ld(&bar[XB_XCNT(j)]); sum += c; cnt += (c > 0u) ? 1u : 0u; mine = (j == x) ? c : mine; }
        if (sum == G) break;
        __builtin_amdgcn_s_sleep(1);
        if ((++sp & 255u) == 0u) { if (xb_ld(&bar[XB_TMO])) break; if (sp > XB_SPIN_CAP) { atomicAdd(&bar[XB_TMO], 1u); break; } }
    }
    nloc = mine > 0u ? mine : 1u; nx = cnt > 0u ? cnt : 1u;
}
__device__ __forceinline__ void xcd_barrier(const XcdBarrier& b) {
    asm volatile("s_waitcnt vmcnt(0)" ::: "memory");
    __syncthreads();
    if (xb_thread0(b.wv)) {
        unsigned* bar = b.bar; asm volatile("" : "+s"(bar));
        __builtin_amdgcn_s_waitcnt(0);
        unsigned nloc = b.st[0], nx = b.st[1];
        if (nloc == 0u) { xcd_barrier_complete(bar, b.x, nloc, nx); b.st[0] = nloc; b.st[1] = nx; }
        const unsigned old = xb_add(&bar[XB_XSUB(b.x)], 1u);
        const unsigned gen = old / nloc;
        if (old + 1u == (gen + 1u) * nloc) {
            __builtin_amdgcn_fence(__ATOMIC_RELEASE, "agent");
            asm volatile("s_waitcnt vmcnt(0)" ::: "memory");
            const unsigned og = xb_add(&bar[XB_TOP], 1u);
            const unsigned tg = og / nx;
            if (og + 1u == (tg + 1u) * nx) xb_add(&bar[XB_TOPGEN], 1u);
            else XB_SPIN(xb_ld(&bar[XB_TOPGEN]) == tg, bar);
            __builtin_amdgcn_fence(__ATOMIC_ACQUIRE, "agent");
            xb_add(&bar[XB_XGEN(b.x)], 1u);
            asm volatile("s_waitcnt vmcnt(0)" ::: "memory");
        } else {
            XB_SPIN(xb_ld(&bar[XB_XGEN(b.x)]) == gen, bar);
            __builtin_amdgcn_fence(__ATOMIC_ACQUIRE, "agent");
            asm volatile("s_waitcnt vmcnt(0)" ::: "memory");
        }
    }
    __syncthreads();
}

typedef unsigned short bf16_t;
typedef short bf16x8 __attribute__((ext_vector_type(8)));
typedef float f32x4 __attribute__((ext_vector_type(4)));
typedef unsigned u32x4 __attribute__((ext_vector_type(4)));
typedef unsigned u32x2 __attribute__((ext_vector_type(2)));

constexpr int NT = 512;
constexpr int NB = 16, NS = 2048, ND = 2048, NTOK = NB * NS;
constexpr int NE = 16, DEXP = 1024;
constexpr int N_IN0 = 7168, N_IN1 = 3408, N_IN1P = 3584;
constexpr float RMS_EPS = 1e-6f;
constexpr int LDS_MISC = 131072 + 2 * 64 * 144;
constexpr int LDS_BYTES = LDS_MISC + 8192;

constexpr size_t MiB = 1024ull * 1024ull;
constexpr size_t WS_CTL   = 0;
constexpr size_t CTL_CNT  = 16384;
constexpr size_t WS_MOD   = 64 * 1024;
constexpr size_t WS_ROT   = WS_MOD + 4ull * 16 * 6144 * 4;
constexpr size_t WS_IDX   = WS_ROT + 2048ull * 128 * 8;
constexpr size_t WS_GT    = WS_IDX + 16ull * 32768 * 4;
constexpr size_t WS_MASK  = WS_GT + 16ull * 32768 * 4;
constexpr size_t WS_WIN0  = 16 * MiB;
constexpr size_t WS_WOUT0 = WS_WIN0 + 28 * MiB;
constexpr size_t WS_WIN1  = WS_WOUT0 + 8 * MiB;
constexpr size_t WS_WOUT1 = WS_WIN1 + 14 * MiB;
constexpr size_t WS_W13   = WS_WOUT1 + 8 * MiB;
constexpr size_t WS_XB    = WS_W13 + 128 * MiB;
constexpr size_t WS_W2    = WS_W13 + 256 * MiB;
constexpr size_t WS_H     = WS_W2 + 128 * MiB;
constexpr size_t WS_O     = WS_H + 128 * MiB;
constexpr size_t WS_TMP   = WS_O + 64 * MiB;
constexpr size_t WS_PROJ  = WS_TMP + 128 * MiB;
constexpr size_t WS_END   = WS_PROJ + 448 * MiB;
constexpr size_t WS_TMP1  = WS_PROJ + 128 * MiB;
constexpr size_t WS_H8    = WS_O;
constexpr size_t WS_WIN0F8 = WS_W2 + 64 * MiB;
constexpr size_t PJ_AB = 0, PJ_U = 64 * MiB, PJ_Q = 128 * MiB, PJ_K = 192 * MiB, PJ_KT = 256 * MiB, PJ_VT = 320 * MiB, PJ_SG = 384 * MiB;
constexpr size_t PJ_Q1 = 0, PJ_QI = 128 * MiB, PJ_KR = 192 * MiB, PJ_VT1 = 200 * MiB, PJ_KI = 208 * MiB, PJ_WI = 212 * MiB, PJ_KN = 216 * MiB;
constexpr size_t PJ_ACT = 0;

struct Args { const float* in[22]; float* out; unsigned char* ws; };
#define CAS __attribute__((address_space(4)))
struct KA {
    const CAS unsigned char* kp;
    __device__ __forceinline__ KA() { kp = (const CAS unsigned char*)__builtin_amdgcn_kernarg_segment_ptr(); asm volatile("" : "+s"(kp)); }
    __device__ __forceinline__ const float* in(int i) const { return *(const float* const CAS*)(kp + 8 * i); }
    __device__ __forceinline__ float* out() const { return *(float* const CAS*)(kp + 8 * 22); }
    __device__ __forceinline__ unsigned char* ws() const { return *(unsigned char* const CAS*)(kp + 8 * 23); }
};
enum { I_X = 0, I_C, I_RELB, I_WR, I_BR, I_NORM_MIX, I_ADAW_MIX, I_ADAB_MIX, I_NORM_FFN, I_ADAW_FFN, I_ADAB_FFN, I_AB_WIN, I_CONVW, I_CONVB, I_AB_WOUT,
       I_C_WIN, I_QN, I_KN, I_C_WOUT, I_W1, I_W3, I_W2 };

typedef __bf16 bf16x2_t __attribute__((ext_vector_type(2)));
__device__ __forceinline__ unsigned cvt_pk_bf16(float lo, float hi) { bf16x2_t v = {(__bf16)lo, (__bf16)hi}; return __builtin_bit_cast(unsigned, v); }
__device__ __forceinline__ float bflo(unsigned u) { return __uint_as_float(u << 16); }
__device__ __forceinline__ float bfhi(unsigned u) { return __uint_as_float(u & 0xffff0000u); }
__device__ __forceinline__ f32x4 ld_bf16x4(const bf16_t* p) { const u32x2 t = *(const GAS u32x2*)p; return (f32x4){bflo(t.x), bfhi(t.x), bflo(t.y), bfhi(t.y)}; }
__device__ __forceinline__ float bf2f(bf16_t h) { return __uint_as_float((unsigned)h << 16); }
__device__ __forceinline__ bf16_t f2bf(float f) { return (bf16_t)(cvt_pk_bf16(f, 0.f) & 0xffffu); }
__device__ __forceinline__ float silu_f(float v) { return v * __builtin_amdgcn_rcpf(1.f + __builtin_amdgcn_exp2f(-1.4426950408889634f * v)); }
__device__ __forceinline__ int tid_fresh(int wv) {
    int l; asm volatile("v_mbcnt_lo_u32_b32 %0, -1, 0\n\tv_mbcnt_hi_u32_b32 %0, -1, %0" : "=v"(l));
    return wv * 64 + l;
}
__device__ __forceinline__ float shx(float v, int o, int lane) { return __int_as_float(__builtin_amdgcn_ds_bpermute((lane ^ o) << 2, __float_as_int(v))); }
__device__ __forceinline__ float shi(float v, int src) { return __int_as_float(__builtin_amdgcn_ds_bpermute(src << 2, __float_as_int(v))); }
__device__ __forceinline__ float wave_sum(float v, int lane) {
#pragma unroll
    for (int o = 32; o >= 1; o >>= 1) v += shx(v, o, lane);
    return v;
}

#ifndef F8_L1
#define F8_L1 1
#endif
#ifndef F8_P2_TILES
#define F8_P2_TILES 0xFFFFFFFu
#endif
#define F8_P2 ((F8_P2_TILES) == 0xFFFFFFFu)
#define F8_P2_MIX ((F8_P2_TILES) != 0u && (F8_P2_TILES) != 0xFFFFFFFu)

#ifndef F8_P5
#define F8_P5 1
#endif
constexpr float Y8_SCALE = 4.0f;
constexpr float W8_SCALE = 64.0f, A8_SCALE = 8.0f;
__device__ __forceinline__ float clamp8(float v) { return fminf(fmaxf(v, -448.0f), 448.0f); }
__device__ __forceinline__ unsigned pack_fp8x4(float a, float b, float c, float d) { int w; asm volatile("" : "=v"(w));     w = __builtin_amdgcn_cvt_pk_fp8_f32(clamp8(a), clamp8(b), w, false); w = __builtin_amdgcn_cvt_pk_fp8_f32(clamp8(c), clamp8(d), w, true); return (unsigned)w; }
template <bool FP8OUT>
__device__ __forceinline__ void tr_tile(int wv, const float* __restrict__ src, int ldn, int N, int k0, int n0, float* tile, bf16_t* dstbase, int ldk, int rowmap_kind) {
    const int tid = tid_fresh(wv);
#pragma unroll
    for (int it = 0; it < 2; ++it) {
        const int i = tid + it * NT, k = i >> 4, q = i & 15, n = n0 + q * 4;
        float4 v = make_float4(0.f, 0.f, 0.f, 0.f);
        if (n < N) v = *(const float4*)(src + (size_t)(k0 + k) * ldn + n);
        float* tp = tile + k * 65 + q * 4;
        tp[0] = v.x; tp[1] = v.y; tp[2] = v.z; tp[3] = v.w;
    }
    __syncthreads();
    {
        const int nl = tid >> 3, kc = tid & 7, n = n0 + nl;
        if (n < N) {
            float f[8];
#pragma unroll
            for (int j = 0; j < 8; ++j) f[j] = tile[(kc * 8 + j) * 65 + nl];
            int row = n;
            if (rowmap_kind == 1) {
                const int s = n >> 10, c = n & 1023;
                if (s == 1) row = 1024 + (c >> 7) * 256 + (c & 127);
                else if (s == 2) row = 1024 + (c >> 7) * 256 + 128 + (c & 127);
            } else if (rowmap_kind == 2) {
                row = (n >> 7) * 256 + (n & 127);
            } else if (rowmap_kind == 3) {
                row = (n >> 7) * 256 + 128 + (n & 127);
            }
            if (FP8OUT) {
                u32x2 o; o.x = pack_fp8x4(f[0] * W8_SCALE, f[1] * W8_SCALE, f[2] * W8_SCALE, f[3] * W8_SCALE); o.y = pack_fp8x4(f[4] * W8_SCALE, f[5] * W8_SCALE, f[6] * W8_SCALE, f[7] * W8_SCALE);
                *(u32x2*)((unsigned char*)dstbase + (size_t)row * ldk + k0 + kc * 8) = o;
            } else {
                u32x4 o; o.x = cvt_pk_bf16(f[0], f[1]); o.y = cvt_pk_bf16(f[2], f[3]); o.z = cvt_pk_bf16(f[4], f[5]); o.w = cvt_pk_bf16(f[6], f[7]);
                *(u32x4*)(dstbase + (size_t)row * ldk + k0 + kc * 8) = o;
            }
        }
    }
    __syncthreads();
}

constexpr int WT0 = 16 * 56, WT1 = WT0 + 256, WT2 = WT1 + 16 * 27, WT3 = WT2 + 256, WT4 = WT3 + 4096, WT5 = WT4 + 4096, WT6 = WT5 + 4096;
struct WTile { const float* src; unsigned char* dst; int ldn, N, k0, n0, ldk, kind, f8; };
__device__ __forceinline__ WTile wt_decode(int t) {
    const KA a; unsigned char* ws = a.ws();
    WTile d;
    if (t < WT0) { const int kt = t / 56, nt = t % 56;
        const int n = nt * 128, sct = n >> 10, c = n & 1023; const int row = (sct == 0) ? c : (sct == 1) ? 1024 + (c >> 7) * 256 + (c & 127) : (sct == 2) ? 1024 + (c >> 7) * 256 + 128 + (c & 127) : n;
        const int f8 = (int)(((unsigned)F8_P2_TILES >> (row >> 8)) & 1u);
        d = WTile{a.in(I_AB_WIN), f8 ? ws + WS_WIN0F8 : ws + WS_WIN0, 7168, 7168, kt * 128, nt * 128, 2048, 1, f8}; }
    else if (t < WT1) { const int u = t - WT0, kt = u / 16, nt = u % 16; d = WTile{a.in(I_AB_WOUT), ws + WS_WOUT0, 2048, 2048, kt * 128, nt * 128, 2048, 0, F8_P5}; }
    else if (t < WT2) { const int u = t - WT1, kt = u / 27, nt = u % 27; d = WTile{a.in(I_C_WIN), ws + WS_WIN1, N_IN1, N_IN1, kt * 128, nt * 128, 2048, 0, F8_L1}; }
    else if (t < WT3) { const int u = t - WT2, kt = u / 16, nt = u % 16; d = WTile{a.in(I_C_WOUT), ws + WS_WOUT1, 2048, 2048, kt * 128, nt * 128, 2048, 0, F8_L1}; }
    else if (t < WT5) { const bool is3 = t >= WT4; const int u = t - (is3 ? WT4 : WT3), mat = u / 128, v = u % 128, kt = v / 8, nt = v % 8;
        d = WTile{(is3 ? a.in(I_W3) : a.in(I_W1)) + (size_t)mat * 2048 * 1024, ws + WS_W13 + (size_t)mat * 2048 * 2048, 1024, 1024, kt * 128, nt * 128, 2048, is3 ? 3 : 2, 1}; }
    else { const int u = t - WT5, mat = u / 128, v = u % 128, kt = v / 16, nt = v % 16;
        d = WTile{a.in(I_W2) + (size_t)mat * 1024 * 2048, ws + WS_W2 + (size_t)mat * 2048 * 1024, 2048, 2048, kt * 128, nt * 128, 1024, 0, 1}; }
    return d;
}
constexpr int WT_L0 = WT2 + 3 * 2048, WT_L1 = (WT3 - WT2) + 3 * 2048;
__device__ __forceinline__ int wt_l0_tile(int p) { return p < WT2 ? p : p < WT2 + 2048 ? WT3 + (p - WT2) : p < WT2 + 4096 ? WT4 + (p - WT2 - 2048) : WT5 + (p - WT2 - 4096); }
__device__ __forceinline__ int wt_l1_tile(int q) { const int nd = WT3 - WT2; return q < nd ? WT2 + q : q < nd + 2048 ? WT3 + 2048 + (q - nd) : q < nd + 4096 ? WT4 + 2048 + (q - nd - 2048) : WT5 + 2048 + (q - nd - 4096); }
__device__ __forceinline__ int wt_row(const WTile& d, int n) {
    int row = n;
    if (d.kind == 1) { const int sct = n >> 10, c = n & 1023; if (sct == 1) row = 1024 + (c >> 7) * 256 + (c & 127); else if (sct == 2) row = 1024 + (c >> 7) * 256 + 128 + (c & 127); }
    else if (d.kind == 2) row = (n >> 7) * 256 + (n & 127);
    else if (d.kind == 3) row = (n >> 7) * 256 + 128 + (n & 127);
    return row;
}
__device__ __forceinline__ void p0_prologue(int wv, unsigned char* lds) {
    const int tid = tid_fresh(wv), G = gridDim.x, bx = blockIdx.x;
    const KA a; unsigned char* ws = a.ws();
    {
        float2* rot = (float2*)(ws + WS_ROT);
        for (int i = bx * NT + tid; i < 2048 * 128; i += G * NT) {
            const int pos = i >> 7, j = i & 127;
            const float inv = 1.0f / powf(10000.0f, (float)j / 127.0f);
            const float ang = (float)pos * inv;
            float s, c; sincosf(ang, &s, &c);
            rot[i] = make_float2(c, s);
        }
    }
    {
        constexpr int esz = F8_L1 ? 1 : 2;
        u32x4* z = (u32x4*)(ws + WS_WIN1 + (size_t)N_IN1 * 2048 * esz);
        const int n16 = (N_IN1P - N_IN1) * 2048 * esz / 16;
        for (int i = bx * NT + tid; i < n16; i += G * NT) z[i] = (u32x4){0u, 0u, 0u, 0u};
    }
    {
        float* sc = (float*)lds;
        float* red = (float*)(lds + 65536);
        float* mod = (float*)(ws + WS_MOD);
        const int lane = tid & 63, wave = tid >> 6;
        const int q = lane & 15, kg = (lane >> 4) + wave * 4;
        int cur_half = -1;
        for (int item = bx; item < 2 * 4 * 96; item += G) {
            const int half = item / (4 * 96), it2 = item % (4 * 96);
            const int w = it2 / 96, col0 = (it2 % 96) * 64;
            const float* adaw = (w & 1) ? a.in(I_ADAW_FFN) : a.in(I_ADAW_MIX);
            const float* adab = (w & 1) ? a.in(I_ADAB_FFN) : a.in(I_ADAB_MIX);
            const int layer = w >> 1;
            adaw += (size_t)layer * 2048 * 6144; adab += (size_t)layer * 6144;
            if (half != cur_half) {
                __syncthreads();
                for (int i = tid; i < 1024 * 16; i += NT) { const int k = i >> 4, b = i & 15; sc[i] = silu_f(a.in(I_C)[b * 2048 + half * 1024 + k]); }
                cur_half = half;
                __syncthreads();
            }
            float acc[16][4];
#pragma unroll
            for (int b = 0; b < 16; ++b) { acc[b][0] = 0.f; acc[b][1] = 0.f; acc[b][2] = 0.f; acc[b][3] = 0.f; }
            const float* wp = adaw + (size_t)(half * 1024 + kg * 32) * 6144 + col0 + q * 4;
            for (int kk0 = 0; kk0 < 32; kk0 += 4) {
                float4 wv8[4];
#pragma unroll
                for (int j = 0; j < 4; ++j) wv8[j] = *(const float4*)(wp + (size_t)(kk0 + j) * 6144);
#pragma unroll
                for (int j = 0; j < 4; ++j) {
                    const float4* sp = (const float4*)(sc + (kg * 32 + kk0 + j) * 16);
#pragma unroll
                    for (int b4 = 0; b4 < 4; ++b4) {
                        const float4 s4 = sp[b4];
                        const float sv[4] = {s4.x, s4.y, s4.z, s4.w};
#pragma unroll
                        for (int bb = 0; bb < 4; ++bb) {
                            acc[b4 * 4 + bb][0] += sv[bb] * wv8[j].x; acc[b4 * 4 + bb][1] += sv[bb] * wv8[j].y;
                            acc[b4 * 4 + bb][2] += sv[bb] * wv8[j].z; acc[b4 * 4 + bb][3] += sv[bb] * wv8[j].w;
                        }
                    }
                }
            }
#pragma unroll
            for (int b = 0; b < 16; ++b)
#pragma unroll
                for (int j = 0; j < 4; ++j) { float v = acc[b][j]; v += shx(v, 16, lane); v += shx(v, 32, lane); acc[b][j] = v; }
            __syncthreads();
            if (lane < 16) {
#pragma unroll
                for (int b = 0; b < 16; ++b) *(float4*)(red + (wave * 16 + b) * 64 + q * 4) = make_float4(acc[b][0], acc[b][1], acc[b][2], acc[b][3]);
            }
            __syncthreads();
            for (int i = tid; i < 1024; i += NT) {
                const int b = i >> 6, cidx = i & 63;
                float sm = (half == 0) ? adab[col0 + cidx] : 0.f;
#pragma unroll
                for (int wvi = 0; wvi < 8; ++wvi) sm += red[(wvi * 16 + b) * 64 + cidx];
                atomicAdd(mod + ((size_t)w * 16 + b) * 6144 + col0 + cidx, sm);
            }
        }
        __syncthreads();
    }
    {
        constexpr int T6 = WT_L0; typedef WTile TD;
        auto decode = [&](int p) { return wt_decode(wt_l0_tile(p)); };
        auto load8 = [&](const TD& d, float4 (&v)[8]) {
#pragma unroll
            for (int it = 0; it < 8; ++it) {
                const int i = tid + it * NT, k = i >> 5, q = i & 31, n = d.n0 + q * 4;
                v[it] = (n < d.N) ? *(const float4*)(d.src + (size_t)(d.k0 + k) * d.ldn + n) : make_float4(0.f, 0.f, 0.f, 0.f);
            }
        };
        float4 cur[8], nx1[8], nx2[8];
        int t = bx, buf = 0;
        TD d = decode(t < T6 ? t : 0), d1 = decode(t + G < T6 ? t + G : 0);
        if (t < T6) load8(d, cur);
        if (t + G < T6) load8(d1, nx1);
        __syncthreads();
        for (; t < T6; t += G) {
            float* tile = (float*)lds + buf * (128 * 129);
#pragma unroll
            for (int it = 0; it < 8; ++it) {
                const int i = tid + it * NT, k = i >> 5, q = i & 31;
                float* tp = tile + k * 129 + q * 4;
                tp[0] = cur[it].x; tp[1] = cur[it].y; tp[2] = cur[it].z; tp[3] = cur[it].w;
            }
            const TD d2 = decode(t + 2 * G < T6 ? t + 2 * G : t);
            if (t + 2 * G < T6) load8(d2, nx2);
            __syncthreads();
#pragma unroll
            for (int rep = 0; rep < 2; ++rep) {
                const int item = tid + rep * NT, nl = item >> 3, kc = item & 7, n = d.n0 + nl;
                if (n < d.N) {
                    float f[16];
#pragma unroll
                    for (int j = 0; j < 16; ++j) f[j] = tile[(kc * 16 + j) * 129 + nl];
                    int row = n;
                    if (d.kind == 1) { const int sct = n >> 10, c = n & 1023; if (sct == 1) row = 1024 + (c >> 7) * 256 + (c & 127); else if (sct == 2) row = 1024 + (c >> 7) * 256 + 128 + (c & 127); }
                    else if (d.kind == 2) row = (n >> 7) * 256 + (n & 127);
                    else if (d.kind == 3) row = (n >> 7) * 256 + 128 + (n & 127);
                    if (d.f8) {
                        u32x4 o;
                        o.x = pack_fp8x4(f[0] * W8_SCALE, f[1] * W8_SCALE, f[2] * W8_SCALE, f[3] * W8_SCALE); o.y = pack_fp8x4(f[4] * W8_SCALE, f[5] * W8_SCALE, f[6] * W8_SCALE, f[7] * W8_SCALE);
                        o.z = pack_fp8x4(f[8] * W8_SCALE, f[9] * W8_SCALE, f[10] * W8_SCALE, f[11] * W8_SCALE); o.w = pack_fp8x4(f[12] * W8_SCALE, f[13] * W8_SCALE, f[14] * W8_SCALE, f[15] * W8_SCALE);
                        *(u32x4*)(d.dst + (size_t)row * d.ldk + d.k0 + kc * 16) = o;
                    } else {
                        u32x4 o0, o1;
                        o0.x = cvt_pk_bf16(f[0], f[1]); o0.y = cvt_pk_bf16(f[2], f[3]); o0.z = cvt_pk_bf16(f[4], f[5]); o0.w = cvt_pk_bf16(f[6], f[7]);
                        o1.x = cvt_pk_bf16(f[8], f[9]); o1.y = cvt_pk_bf16(f[10], f[11]); o1.z = cvt_pk_bf16(f[12], f[13]); o1.w = cvt_pk_bf16(f[14], f[15]);
                        u32x4* op = (u32x4*)(d.dst + ((size_t)row * d.ldk + d.k0 + kc * 16) * 2);
                        op[0] = o0; op[1] = o1;
                    }
                }
            }
            d = d1; d1 = d2;
#pragma unroll
            for (int it = 0; it < 8; ++it) { cur[it] = nx1[it]; nx1[it] = nx2[it]; }
            buf ^= 1;
        }
        __syncthreads();
    }
}

template <bool ADD_TMP, bool ROUTE, bool OUT8, bool XBF, bool DUAL = false, bool WB = false>
__device__ __forceinline__ void norm_phase(int wv, const void* xsrc_, const bf16_t* __restrict__ tmp, const float* __restrict__ normw, const float* __restrict__ mod  ,
                           bf16_t* __restrict__ H, unsigned char* lds, const float* __restrict__ w_router, const float* __restrict__ b_router,
                           unsigned* __restrict__ cnt  , int* __restrict__ idx, float* __restrict__ gts, const bf16_t* __restrict__ tmp2 = nullptr, const float* __restrict__ gatev = nullptr  ) {
    const int tid = tid_fresh(wv), lane = tid & 63, wave = tid >> 6;
    float* wr_lds = (float*)lds;
    int* rt_e = (int*)(lds + 131072 + 64);
    (void)rt_e;
    if (ROUTE) {
        for (int i = tid; i < 2048 * 16; i += NT) { const int k = i >> 4, e = i & 15; wr_lds[e * 2048 + k] = w_router[i]; }
        __syncthreads();
    }
    float br[16];
    if (ROUTE) {
#pragma unroll
        for (int e = 0; e < 16; ++e) br[e] = b_router[e];
    }
    const int rows_per_block = NTOK / (int)gridDim.x;
    const int rows_per_wave = rows_per_block / 8;
    const int row0 = blockIdx.x * rows_per_block + wave * rows_per_wave;
    const int b = row0 / NS;
    float g[32], sh[32];
#pragma unroll
    for (int i = 0; i < 8; ++i) {
        const int c = i * 256 + lane * 4;
        const float4 nw = *(const float4*)(normw + c);
        const float4 s4 = *(const float4*)(mod + (size_t)b * 6144 + c);
        const float4 c4 = *(const float4*)(mod + (size_t)b * 6144 + 2048 + c);
        g[i * 4 + 0] = nw.x * (1.f + c4.x); g[i * 4 + 1] = nw.y * (1.f + c4.y); g[i * 4 + 2] = nw.z * (1.f + c4.z); g[i * 4 + 3] = nw.w * (1.f + c4.w);
        sh[i * 4 + 0] = s4.x; sh[i * 4 + 1] = s4.y; sh[i * 4 + 2] = s4.z; sh[i * 4 + 3] = s4.w;
    }
    float gt[32];
    if (WB) {
#pragma unroll
        for (int i = 0; i < 8; ++i) { const float4 g4 = *(const float4*)(gatev + (size_t)b * 6144 + i * 256 + lane * 4); gt[i * 4 + 0] = g4.x * (1.0f / 16.0f); gt[i * 4 + 1] = g4.y * (1.0f / 16.0f); gt[i * 4 + 2] = g4.z * (1.0f / 16.0f); gt[i * 4 + 3] = g4.w * (1.0f / 16.0f); }
    }
    for (int r = 0; r < rows_per_wave; ++r) {
        const int t = row0 + r;
        float v[32];
        float ss = 0.f;
#pragma unroll
        for (int i = 0; i < 8; ++i) {
            const int c = i * 256 + lane * 4;
            float4 x4;
            if (XBF) { const f32x4 xb = ld_bf16x4((const bf16_t*)xsrc_ + (size_t)t * ND + c); x4 = make_float4(xb[0], xb[1], xb[2], xb[3]); }
            else x4 = *(const float4*)((const float*)xsrc_ + (size_t)t * ND + c);
            if (ADD_TMP && !WB) {
                const u32x2 tv = *(const u32x2*)(tmp + (size_t)t * ND + c);
                x4.x += bflo(tv.x); x4.y += bfhi(tv.x); x4.z += bflo(tv.y); x4.w += bfhi(tv.y);
            }
            if (WB) {
                const int tv = *(const int*)((const unsigned char*)tmp + (size_t)t * ND + c), tw = *(const int*)((const unsigned char*)tmp2 + (size_t)t * ND + c);
                x4.x += (__builtin_amdgcn_cvt_f32_fp8(tv, 0) + __builtin_amdgcn_cvt_f32_fp8(tw, 0)) * gt[i * 4 + 0]; x4.y += (__builtin_amdgcn_cvt_f32_fp8(tv, 1) + __builtin_amdgcn_cvt_f32_fp8(tw, 1)) * gt[i * 4 + 1];
                x4.z += (__builtin_amdgcn_cvt_f32_fp8(tv, 2) + __builtin_amdgcn_cvt_f32_fp8(tw, 2)) * gt[i * 4 + 2]; x4.w += (__builtin_amdgcn_cvt_f32_fp8(tv, 3) + __builtin_amdgcn_cvt_f32_fp8(tw, 3)) * gt[i * 4 + 3];
                u32x2 o; o.x = cvt_pk_bf16(x4.x, x4.y); o.y = cvt_pk_bf16(x4.z, x4.w);
                *(u32x2*)((bf16_t*)xsrc_ + (size_t)t * ND + c) = o;
            }
            v[i * 4 + 0] = x4.x; v[i * 4 + 1] = x4.y; v[i * 4 + 2] = x4.z; v[i * 4 + 3] = x4.w;
            ss += x4.x * x4.x + x4.y * x4.y + x4.z * x4.z + x4.w * x4.w;
        }
        ss = wave_sum(ss, lane);
        const float rs = rsqrtf(ss * (1.0f / ND) + RMS_EPS);
#pragma unroll
        for (int i = 0; i < 32; ++i) v[i] = v[i] * rs * g[i] + sh[i];
#pragma unroll
        for (int i = 0; i < 8; ++i) {
            const int c = i * 256 + lane * 4;
            if (DUAL) *(unsigned*)((unsigned char*)H + (size_t)(WS_H8 - WS_H) + (size_t)t * ND + c) = pack_fp8x4(v[i * 4 + 0], v[i * 4 + 1], v[i * 4 + 2], v[i * 4 + 3]);
            if (OUT8) {
                *(unsigned*)((unsigned char*)H + (size_t)t * ND + c) = pack_fp8x4(v[i * 4 + 0], v[i * 4 + 1], v[i * 4 + 2], v[i * 4 + 3]);
            } else {
                u32x2 o; o.x = cvt_pk_bf16(v[i * 4 + 0], v[i * 4 + 1]); o.y = cvt_pk_bf16(v[i * 4 + 2], v[i * 4 + 3]);
                *(u32x2*)(H + (size_t)t * ND + c) = o;
            }
        }
        if (ROUTE) {
            float lg[16];
            int lo = lane * 4; asm volatile("" : "+v"(lo));
#pragma unroll
            for (int e = 0; e < 16; ++e) {
                float s = 0.f;
#pragma unroll
                for (int i = 0; i < 8; ++i) {
                    const float4 w4 = *(const float4*)(wr_lds + e * 2048 + i * 256 + lo);
                    s += v[i * 4 + 0] * w4.x + v[i * 4 + 1] * w4.y + v[i * 4 + 2] * w4.z + v[i * 4 + 3] * w4.w;
                }
                lg[e] = wave_sum(s, lane);
            }
            float mx = lg[0];
#pragma unroll
            for (int e = 1; e < 16; ++e) mx = fmaxf(mx, lg[e]);
            float p[16], sum = 0.f;
#pragma unroll
            for (int e = 0; e < 16; ++e) { p[e] = __expf(lg[e] - mx); sum += p[e]; }
            const float isum = 1.f / sum;
            float sel[16];
#pragma unroll
            for (int e = 0; e < 16; ++e) { p[e] *= isum; sel[e] = p[e] + br[e]; }
            int grp = 0; float best = -1e30f;
#pragma unroll
            for (int gI = 0; gI < 4; ++gI) {
                float m1 = -1e30f, m2 = -1e30f;
#pragma unroll
                for (int j = 0; j < 4; ++j) { const float s = sel[gI * 4 + j]; if (s > m1) { m2 = m1; m1 = s; } else if (s > m2) { m2 = s; } }
                const float gs = m1 + m2;
                if (gs > best) { best = gs; grp = gI; }
            }
            float s4[4], p4[4];
#pragma unroll
            for (int j = 0; j < 4; ++j) { s4[j] = 0.f; p4[j] = 0.f; }
#pragma unroll
            for (int gI = 0; gI < 4; ++gI)
#pragma unroll
                for (int j = 0; j < 4; ++j) if (grp == gI) { s4[j] = sel[gI * 4 + j]; p4[j] = p[gI * 4 + j]; }
            int i1 = 0; float v1 = s4[0];
#pragma unroll
            for (int j = 1; j < 4; ++j) if (s4[j] > v1) { v1 = s4[j]; i1 = j; }
            int i2 = -1; float v2 = -1e30f;
#pragma unroll
            for (int j = 0; j < 4; ++j) if (j != i1 && s4[j] > v2) { v2 = s4[j]; i2 = j; }
            float pa = 0.f, pb = 0.f;
#pragma unroll
            for (int j = 0; j < 4; ++j) { if (j == i1) pa = p4[j]; if (j == i2) pb = p4[j]; }
            const float inv = 1.f / (pa + pb);
            if (lane == 0) {
                const int e0 = grp * 4 + i1, e1 = grp * 4 + i2;
                const unsigned p0 = atomicAdd(cnt + e0 * 64, 1u);
                const unsigned p1 = atomicAdd(cnt + e1 * 64, 1u);
                idx[e0 * 32768 + p0] = t * 2 + 0; gts[e0 * 32768 + p0] = pa * inv;
                idx[e1 * 32768 + p1] = t * 2 + 1; gts[e1 * 32768 + p1] = pb * inv;
            }
        }
    }
    __syncthreads();
}

#define DPP_ADD(v, CTRL) ((v) + __int_as_float(__builtin_amdgcn_update_dpp(0, __float_as_int(v), (CTRL), 0xf, 0xf, false)))
#define DPP_GET(v, CTRL) __int_as_float(__builtin_amdgcn_update_dpp(0, __float_as_int(v), (CTRL), 0xf, 0xf, false))
__device__ __forceinline__ float swap32_sum(float a, float b) {
    const auto r = __builtin_amdgcn_permlane32_swap(__float_as_uint(a), __float_as_uint(b), false, false);
    return __uint_as_float(r[0]) + __uint_as_float(r[1]);
}
__device__ __forceinline__ float swap16_sum(float a, float b) {
    const auto r = __builtin_amdgcn_permlane16_swap(__float_as_uint(a), __float_as_uint(b), false, false);
    return __uint_as_float(r[0]) + __uint_as_float(r[1]);
}
__device__ __forceinline__ float bfly16(const float (&pl)[16], int lane) {
    float a8[8], a4[4], a2[2], a1;
#pragma unroll
    for (int i = 0; i < 8; ++i) a8[i] = swap32_sum(pl[i], pl[8 + i]);
#pragma unroll
    for (int i = 0; i < 4; ++i) a4[i] = swap16_sum(a8[i], a8[4 + i]);
    { const bool hi = (lane & 2) != 0;
#pragma unroll
      for (int i = 0; i < 2; ++i) { const float keep = hi ? a4[2 + i] : a4[i], send = hi ? a4[i] : a4[2 + i]; a2[i] = keep + DPP_GET(send, 0x4e  ); } }
    { const bool hi = (lane & 1) != 0; const float keep = hi ? a2[1] : a2[0], send = hi ? a2[0] : a2[1]; a1 = keep + DPP_GET(send, 0xb1  ); }
    return a1 + DPP_GET(a1, 0x124) + DPP_GET(a1, 0x128) + DPP_GET(a1, 0x12c);
}
__device__ __forceinline__ int bfly16_slot(int lane) { return ((lane >> 5) & 1) * 8 + ((lane >> 4) & 1) * 4 + (lane & 3); }
__device__ __forceinline__ float wave_total(float v) {
    v = swap32_sum(v, v); v = swap16_sum(v, v);
    v = v + DPP_GET(v, 0x124) + DPP_GET(v, 0x128) + DPP_GET(v, 0x12c);
    v = DPP_ADD(v, 0x4e); v = DPP_ADD(v, 0xb1);
    return v;
}
__device__ __forceinline__ void route_phase(int wv, const bf16_t* __restrict__ XB, const float* __restrict__ normw, const float* __restrict__ mod, unsigned char* __restrict__ H8, unsigned char* lds,
                                            const float* __restrict__ w_router, const float* __restrict__ b_router, unsigned* __restrict__ cnt, int* __restrict__ idx, float* __restrict__ gts) {
    const int tid = tid_fresh(wv), lane = tid & 63, w = tid >> 6, fr = lane & 15, fq = lane >> 4;
    constexpr int RB = 128;
    constexpr int GWP = 2048 + 8;
    bf16_t* gwh = (bf16_t*)lds;
    bf16_t* gwl = gwh + 16 * GWP;
    float* part = (float*)(gwl + 16 * GWP);
    float* part_c = part + RB * 17;
    float* rs_lds = part_c + 128;
    unsigned* lcnt = (unsigned*)(rs_lds + RB);
    const int row0 = blockIdx.x * RB;
    const int st = w & 3, rh = w >> 2;
    const int b = row0 / NS, col0 = st * 512 + lane * 8;
    float gg[8], shv[8];
#pragma unroll
    for (int h4 = 0; h4 < 2; ++h4) {
        const float4 nw = *(const float4*)(normw + col0 + h4 * 4);
        const float4 s4 = *(const float4*)(mod + (size_t)b * 6144 + col0 + h4 * 4);
        const float4 c4 = *(const float4*)(mod + (size_t)b * 6144 + 2048 + col0 + h4 * 4);
        gg[h4 * 4 + 0] = nw.x * (1.f + c4.x); gg[h4 * 4 + 1] = nw.y * (1.f + c4.y); gg[h4 * 4 + 2] = nw.z * (1.f + c4.z); gg[h4 * 4 + 3] = nw.w * (1.f + c4.w);
        shv[h4 * 4 + 0] = s4.x; shv[h4 * 4 + 1] = s4.y; shv[h4 * 4 + 2] = s4.z; shv[h4 * 4 + 3] = s4.w;
    }
    __syncthreads();
    {
        const int k0 = tid * 4;
        const float4 nw = *(const float4*)(normw + k0);
        const float4 s4 = *(const float4*)(mod + (size_t)b * 6144 + k0);
        const float4 c4 = *(const float4*)(mod + (size_t)b * 6144 + 2048 + k0);
        const float gk[4] = {nw.x * (1.f + c4.x), nw.y * (1.f + c4.y), nw.z * (1.f + c4.z), nw.w * (1.f + c4.w)};
        const float sk[4] = {s4.x, s4.y, s4.z, s4.w};
        float ce[16];
#pragma unroll
        for (int e = 0; e < 16; ++e) ce[e] = 0.f;
        float wk[4][16];
#pragma unroll
        for (int j = 0; j < 4; ++j)
#pragma unroll
            for (int e4 = 0; e4 < 4; ++e4) {
                const float4 wr = *(const float4*)(w_router + (size_t)(k0 + j) * 16 + e4 * 4);
                wk[j][e4 * 4 + 0] = wr.x; wk[j][e4 * 4 + 1] = wr.y; wk[j][e4 * 4 + 2] = wr.z; wk[j][e4 * 4 + 3] = wr.w;
            }
#pragma unroll
        for (int e = 0; e < 16; ++e) {
            float hi[4], lo[4];
#pragma unroll
            for (int j = 0; j < 4; ++j) { const float v = gk[j] * wk[j][e]; ce[e] += sk[j] * wk[j][e]; hi[j] = bf2f(f2bf(v)); lo[j] = v - hi[j]; }
            u32x2 oh, ol; oh.x = cvt_pk_bf16(hi[0], hi[1]); oh.y = cvt_pk_bf16(hi[2], hi[3]); ol.x = cvt_pk_bf16(lo[0], lo[1]); ol.y = cvt_pk_bf16(lo[2], lo[3]);
            *(u32x2*)(gwh + e * GWP + k0) = oh; *(u32x2*)(gwl + e * GWP + k0) = ol;
        }
        const float ct = bfly16(ce, lane);
        if ((lane & 12) == 0) part_c[w * 16 + bfly16_slot(lane)] = ct;
        if (tid < 16) lcnt[tid] = 0u;
    }
    __syncthreads();
    {
        const bf16_t* xp = XB + (size_t)(row0 + w * 16 + fr) * ND + fq * 8;
        const bf16_t* hp = gwh + fr * GWP + fq * 8;
        const bf16_t* lp = gwl + fr * GWP + fq * 8;
        f32x4 ah[2], al[2], sq[2];
        ah[0] = ah[1] = al[0] = al[1] = sq[0] = sq[1] = (f32x4){0.f, 0.f, 0.f, 0.f};
        bf16x8 xa[8], xn[8];
#pragma unroll
        for (int i = 0; i < 8; ++i) xa[i] = *(const bf16x8*)(xp + i * 32);
        for (int kb = 0; kb < 64; kb += 8) {
            const int kn = (kb + 8 < 64) ? kb + 8 : kb;
#pragma unroll
            for (int i = 0; i < 8; ++i) xn[i] = *(const bf16x8*)(xp + (kn + i) * 32);
#pragma unroll
            for (int i = 0; i < 8; ++i) {
                const bf16x8 bh = *(const bf16x8*)(hp + (kb + i) * 32), bl = *(const bf16x8*)(lp + (kb + i) * 32);
                ah[i & 1] = __builtin_amdgcn_mfma_f32_16x16x32_bf16(xa[i], bh, ah[i & 1], 0, 0, 0);
                al[i & 1] = __builtin_amdgcn_mfma_f32_16x16x32_bf16(xa[i], bl, al[i & 1], 0, 0, 0);
                sq[i & 1] = __builtin_amdgcn_mfma_f32_16x16x32_bf16(xa[i], xa[i], sq[i & 1], 0, 0, 0);
            }
#pragma unroll
            for (int i = 0; i < 8; ++i) xa[i] = xn[i];
        }
#pragma unroll
        for (int j = 0; j < 4; ++j) {
            float* pr = part + (size_t)(w * 16 + fq * 4 + j) * 17;
            pr[fr] = (ah[0][j] + ah[1][j]) + (al[0][j] + al[1][j]);
            if (fr == fq * 4 + j) pr[16] = sq[0][j] + sq[1][j];
        }
    }
    __syncthreads();
    int re0 = 0, re1 = 0; unsigned rp0 = 0, rp1 = 0; float rg0 = 0.f, rg1 = 0.f;
    if (tid < RB) {
        float lg[16], ss = 0.f;
#pragma unroll
        for (int e = 0; e < 16; ++e) lg[e] = 0.f;
        {
            const float* pr = part + (size_t)tid * 17;
#pragma unroll
            for (int e = 0; e < 16; ++e) lg[e] += pr[e];
            ss += pr[16];
        }
        const float rs = rsqrtf(ss * (1.0f / ND) + RMS_EPS);
        rs_lds[tid] = rs;
#pragma unroll
        for (int e = 0; e < 16; ++e) {
            float c = 0.f;
#pragma unroll
            for (int ww = 0; ww < 8; ++ww) c += part_c[ww * 16 + e];
            lg[e] = lg[e] * rs + c;
        }
        float mx = lg[0];
#pragma unroll
        for (int e = 1; e < 16; ++e) mx = fmaxf(mx, lg[e]);
        float p[16], sum = 0.f;
#pragma unroll
        for (int e = 0; e < 16; ++e) { p[e] = __expf(lg[e] - mx); sum += p[e]; }
        const float isum = 1.f / sum;
        float sel[16];
#pragma unroll
        for (int e = 0; e < 16; ++e) { p[e] *= isum; sel[e] = p[e] + b_router[e]; }
        int grp = 0; float best = -1e30f;
#pragma unroll
        for (int gI = 0; gI < 4; ++gI) {
            float m1 = -1e30f, m2 = -1e30f;
#pragma unroll
            for (int j = 0; j < 4; ++j) { const float sv = sel[gI * 4 + j]; if (sv > m1) { m2 = m1; m1 = sv; } else if (sv > m2) { m2 = sv; } }
            const float gs = m1 + m2;
            if (gs > best) { best = gs; grp = gI; }
        }
        float s4[4], p4[4];
#pragma unroll
        for (int j = 0; j < 4; ++j) { s4[j] = 0.f; p4[j] = 0.f; }
#pragma unroll
        for (int gI = 0; gI < 4; ++gI)
#pragma unroll
            for (int j = 0; j < 4; ++j) if (grp == gI) { s4[j] = sel[gI * 4 + j]; p4[j] = p[gI * 4 + j]; }
        int i1 = 0; float v1 = s4[0];
#pragma unroll
        for (int j = 1; j < 4; ++j) if (s4[j] > v1) { v1 = s4[j]; i1 = j; }
        int i2 = -1; float v2 = -1e30f;
#pragma unroll
        for (int j = 0; j < 4; ++j) if (j != i1 && s4[j] > v2) { v2 = s4[j]; i2 = j; }
        float pa = 0.f, pb = 0.f;
#pragma unroll
        for (int j = 0; j < 4; ++j) { if (j == i1) pa = p4[j]; if (j == i2) pb = p4[j]; }
        const float inv = 1.f / (pa + pb);
        re0 = grp * 4 + i1; re1 = grp * 4 + i2; rg0 = pa * inv; rg1 = pb * inv;
        rp0 = atomicAdd(&lcnt[re0], 1u);
        rp1 = atomicAdd(&lcnt[re1], 1u);
    }
    __syncthreads();
    if (tid < 16) lcnt[16 + tid] = atomicAdd(cnt + tid * 64, lcnt[tid]);
    __syncthreads();
    if (tid < RB) {
        const int t = row0 + tid;
        const unsigned p0 = lcnt[16 + re0] + rp0, p1 = lcnt[16 + re1] + rp1;
        idx[re0 * 32768 + p0] = t * 2 + 0; gts[re0 * 32768 + p0] = rg0;
        idx[re1 * 32768 + p1] = t * 2 + 1; gts[re1 * 32768 + p1] = rg1;
    }
    for (int rb = 0; rb < 64; rb += 8) {
        u32x4 xr[8];
#pragma unroll
        for (int q = 0; q < 8; ++q) xr[q] = *(const u32x4*)(XB + (size_t)(row0 + rh * 64 + rb + q) * ND + col0);
#pragma unroll
        for (int q = 0; q < 8; ++q) {
            const float rs = rs_lds[rh * 64 + rb + q];
            u32x2 o;
            o.x = pack_fp8x4(bflo(xr[q].x) * rs * gg[0] + shv[0], bfhi(xr[q].x) * rs * gg[1] + shv[1], bflo(xr[q].y) * rs * gg[2] + shv[2], bfhi(xr[q].y) * rs * gg[3] + shv[3]);
            o.y = pack_fp8x4(bflo(xr[q].z) * rs * gg[4] + shv[4], bfhi(xr[q].z) * rs * gg[5] + shv[5], bflo(xr[q].w) * rs * gg[6] + shv[6], bfhi(xr[q].w) * rs * gg[7] + shv[7]);
            *(u32x2*)(H8 + (size_t)(row0 + rh * 64 + rb + q) * ND + col0) = o;
        }
    }
    __syncthreads();
}

constexpr int BM = 256, BK = 64, HALF = 128, HT = HALF * BK;
__device__ __forceinline__ int lds_byte(int r, int c) {
    const int st = (r >> 4) * 2 + (c >> 5), rr = r & 15, cc = c & 31, ob = rr * 64 + cc * 2;
    return st * 1024 + (ob ^ (((ob >> 9) & 1) << 5));
}
__device__ __forceinline__ void stage_rc(int b, int& R, int& C) {
    const int st = b / 1024, sb = b % 1024, swz = sb ^ (((sb >> 9) & 1) << 5);
    R = (st >> 1) * 16 + swz / 64; C = (st & 1) * 32 + (swz % 64) / 2;
}

typedef int v8i __attribute__((ext_vector_type(8)));
typedef int i32x4 __attribute__((ext_vector_type(4)));
template <bool F8, class RowOff, class Epi>
__device__ __forceinline__ void gemm_unit(int wv, bf16_t* shm, const bf16_t* __restrict__ A_in, const RowOff& rowoff, const bf16_t* __restrict__ Bt_in, int ldb, int K, const Epi& epi) {
    const bf16_t* A; const bf16_t* Bt;
#define SA(b, h) (shm + ((b) * 2 + (h)) * HT)
#define SB(b, h) (shm + (4 + (b) * 2 + (h)) * HT)
#define GLDS(sbase, voff, m0v) do { unsigned _keep; asm volatile("s_mov_b32 %0, m0\n\ts_mov_b32 m0, %3\n\ts_nop 0\n\tglobal_load_lds_dwordx4 %1, %2\n\ts_mov_b32 m0, %0" \
        : "=&s"(_keep) : "v"(voff), "s"(sbase), "s"(m0v) : "memory"); } while (0)
#define STAGE_A(P, h, kt) do { const char* _ab = (const char*)A + (size_t)(kt) * (BK * 2) + (h) * a_h; const unsigned _m0 = ldsb + (unsigned)((char*)(P) - (char*)shm) + (unsigned)wv * 1024u; \
        GLDS(_ab, aoff[h][0], _m0); GLDS(_ab + a_i, aoff[h][1], _m0 + 8192u); } while (0)
#define STAGE_B(P, h, kt) do { const char* _bb = (const char*)Bt + ((size_t)((h) * HALF) * ldb + (size_t)(kt) * BK) * 2; const unsigned _m0 = ldsb + (unsigned)((char*)(P) - (char*)shm) + (unsigned)wv * 1024u; \
        GLDS(_bb, boff, _m0); GLDS(_bb + (size_t)64 * ldb * 2, boff, _m0 + 8192u); } while (0)
#define LDFRAG(dst, base, row) do { const i32x4 _lo = *reinterpret_cast<const i32x4*>((char*)(base) + lds_byte((row), fq * 8)); \
        const i32x4 _hi = *reinterpret_cast<const i32x4*>((char*)(base) + lds_byte((row), 32 + fq * 8)); \
        dst = __builtin_shufflevector(_lo, _hi, 0, 1, 2, 3, 4, 5, 6, 7); } while (0)
#define LDA(dst, b, h) _Pragma("unroll") for (int m = 0; m < 4; ++m) LDFRAG(dst[m], SA(b, h), wr * 64 + m * 16 + fr)
#define LDB(dst, b, h) _Pragma("unroll") for (int n = 0; n < 2; ++n) LDFRAG(dst[n], SB(b, h), wc * 32 + n * 16 + fr)
#define MMA(ai, bj, Af, Bf) do { __builtin_amdgcn_s_setprio(1); \
        _Pragma("unroll") for (int m = 0; m < 4; ++m) _Pragma("unroll") for (int n = 0; n < 2; ++n) { \
            if (F8) acc[ai][bj][m][n] = __builtin_amdgcn_mfma_scale_f32_16x16x128_f8f6f4(Bf[n], Af[m], acc[ai][bj][m][n], 0, 0, 0, 0, 0, 0);     \
            else { acc[ai][bj][m][n] = __builtin_amdgcn_mfma_f32_16x16x32_bf16(__builtin_bit_cast(bf16x8, __builtin_shufflevector(Bf[n], Bf[n], 0, 1, 2, 3)), __builtin_bit_cast(bf16x8, __builtin_shufflevector(Af[m], Af[m], 0, 1, 2, 3)), acc[ai][bj][m][n], 0, 0, 0); \
                   acc[ai][bj][m][n] = __builtin_amdgcn_mfma_f32_16x16x32_bf16(__builtin_bit_cast(bf16x8, __builtin_shufflevector(Bf[n], Bf[n], 4, 5, 6, 7)), __builtin_bit_cast(bf16x8, __builtin_shufflevector(Af[m], Af[m], 4, 5, 6, 7)), acc[ai][bj][m][n], 0, 0, 0); } } \
        __builtin_amdgcn_s_setprio(0); } while (0)
#define WAIT_V(n) asm volatile("s_waitcnt vmcnt(" #n ")" ::: "memory")
#define WAIT_L(n) asm volatile("s_waitcnt lgkmcnt(" #n ")" ::: "memory")
#define BAR __builtin_amdgcn_s_barrier()
#define SCHED __builtin_amdgcn_sched_barrier(0)
    asm volatile("" : "+s"(wv));
    int tx = tid_fresh(wv);
    constexpr unsigned ldsb = 0u;
    {
        const size_t a_ = (size_t)A_in, b_ = (size_t)Bt_in;
        A = (const bf16_t*)(((size_t)(unsigned)__builtin_amdgcn_readfirstlane((int)(a_ >> 32)) << 32) | (size_t)(unsigned)__builtin_amdgcn_readfirstlane((int)a_));
        Bt = (const bf16_t*)(((size_t)(unsigned)__builtin_amdgcn_readfirstlane((int)(b_ >> 32)) << 32) | (size_t)(unsigned)__builtin_amdgcn_readfirstlane((int)b_));
    }
    int lane = tx & 63, wr = wv >> 2, wc = wv & 3, fr = lane & 15, fq = lane >> 4;
    unsigned aoff[2][2], boff;
    {
        int r0, c0; stage_rc(tx * 16, r0, c0);
        boff = (unsigned)(r0 * ldb + c0) * 2u;
        if (RowOff::PLAIN) { aoff[0][0] = (rowoff(r0) + (unsigned)c0) * 2u; aoff[0][1] = aoff[0][0]; aoff[1][0] = aoff[0][0]; aoff[1][1] = aoff[0][0]; }
        else {
            aoff[0][0] = (rowoff(r0) + (unsigned)c0) * 2u; aoff[0][1] = (rowoff(r0 + 64) + (unsigned)c0) * 2u;
            aoff[1][0] = (rowoff(HALF + r0) + (unsigned)c0) * 2u; aoff[1][1] = (rowoff(HALF + r0 + 64) + (unsigned)c0) * 2u;
        }
    }
    const size_t a_h = RowOff::PLAIN ? (size_t)rowoff.ld * HALF * 2 : 0, a_i = RowOff::PLAIN ? (size_t)rowoff.ld * 64 * 2 : 0;
    f32x4 acc[2][2][4][2] = {};
    v8i At[4] = {}, B0[2] = {}, B1[2] = {};
    const int nt = K / BK;
    STAGE_B(SB(0, 0), 0, 0); STAGE_A(SA(0, 0), 0, 0);
    STAGE_B(SB(0, 1), 1, 0); STAGE_A(SA(0, 1), 1, 0);
    if (wr == 1) BAR;
    WAIT_V(4); BAR;
    STAGE_B(SB(1, 0), 0, 1); STAGE_A(SA(1, 0), 0, 1); STAGE_B(SB(1, 1), 1, 1);
    WAIT_V(6); BAR;
    for (int t = 0; t < nt - 2; t += 2) {
        LDB(B0, 0, 0); SCHED; LDA(At, 0, 0); STAGE_A(SA(1, 1), 1, t + 1);
        WAIT_L(8); BAR; WAIT_L(0); MMA(0, 0, At, B0); BAR; SCHED;
        LDB(B1, 0, 1); STAGE_B(SB(0, 0), 0, t + 2);
        BAR; WAIT_L(0); MMA(0, 1, At, B1); BAR;
        LDA(At, 0, 1); STAGE_A(SA(0, 0), 0, t + 2);
        BAR; WAIT_L(0); MMA(1, 0, At, B0); BAR; SCHED;
        STAGE_B(SB(0, 1), 1, t + 2);
        WAIT_V(6); BAR; MMA(1, 1, At, B1); BAR;
        LDB(B0, 1, 0); SCHED; LDA(At, 1, 0); STAGE_A(SA(0, 1), 1, t + 2);
        WAIT_L(8); BAR; WAIT_L(0); MMA(0, 0, At, B0); BAR; SCHED;
        LDB(B1, 1, 1); STAGE_B(SB(1, 0), 0, t + 3);
        BAR; WAIT_L(0); MMA(0, 1, At, B1); BAR;
        LDA(At, 1, 1); STAGE_A(SA(1, 0), 0, t + 3);
        BAR; WAIT_L(0); MMA(1, 0, At, B0); BAR; SCHED;
        STAGE_B(SB(1, 1), 1, t + 3);
        WAIT_V(6); BAR; MMA(1, 1, At, B1); BAR;
    }
    { LDB(B0, 0, 0); WAIT_V(0); LDA(At, 0, 0); STAGE_A(SA(1, 1), 1, nt - 1);
      BAR; WAIT_L(0); MMA(0, 0, At, B0); BAR;
      LDB(B1, 0, 1); BAR; WAIT_L(0); MMA(0, 1, At, B1); BAR;
      LDA(At, 0, 1); WAIT_V(4); BAR; WAIT_L(0); MMA(1, 0, At, B0); MMA(1, 1, At, B1); BAR; }
    { LDB(B0, 1, 0); LDA(At, 1, 0); WAIT_V(2); BAR; WAIT_L(0); MMA(0, 0, At, B0); BAR;
      LDB(B1, 1, 1); WAIT_V(0); BAR; WAIT_L(0); MMA(0, 1, At, B1); BAR;
      LDA(At, 1, 1); BAR; WAIT_L(0); MMA(1, 0, At, B0); MMA(1, 1, At, B1); BAR; }
    if (wr == 0) BAR;
    int tz = tid_fresh(wv); lane = tz & 63; fr = lane & 15; fq = lane >> 4;
    Epi epi2 = epi; epi2.launder();
    epi2(acc, wr, wc, fr, fq);
#undef SA
#undef SB
#undef STAGE_A
#undef GLDS
#undef STAGE_B
#undef LDA
#undef LDFRAG
#undef LDB
#undef MMA
#undef WAIT_V
#undef WAIT_L
#undef BAR
#undef SCHED
}

__device__ __forceinline__ int unit_index(int k) { return (gridDim.x == 256) ? ((k * 8 + (int)(blockIdx.x & 7)) * 32 + (int)(blockIdx.x >> 3)) : (k * (int)gridDim.x + (int)blockIdx.x); }
__device__ __forceinline__ void dense_tile(int i, int nN, int& pm, int& pn) { const int g = i / (8 * nN), rem = i - g * 8 * nN; pn = rem >> 3; pm = g * 8 + (rem & 7); }
__device__ __forceinline__ int lauv(int v) { v = __builtin_amdgcn_readfirstlane(v); asm volatile("" : "+s"(v)); return v; }
template <class T> __device__ __forceinline__ T* lauv(T* p) { const size_t a_ = (size_t)p; unsigned lo = (unsigned)__builtin_amdgcn_readfirstlane((int)a_), hi = (unsigned)__builtin_amdgcn_readfirstlane((int)(a_ >> 32)); asm volatile("" : "+s"(lo), "+s"(hi)); return (T*)(((size_t)hi << 32) | lo); }
struct RowPlain { static constexpr bool PLAIN = true; unsigned base; unsigned ld; __device__ __forceinline__ unsigned operator()(int r) const { return base + (unsigned)r * ld; } };

typedef f32x4 AccT[2][2][4][2];

__device__ __forceinline__ void st_bf16x4(bf16_t* p, f32x4 v) { u32x2 o; o.x = cvt_pk_bf16(v[0], v[1]); o.y = cvt_pk_bf16(v[2], v[3]); *(GAS u32x2*)p = o; }

typedef float f32x2_t __attribute__((ext_vector_type(2)));
struct EpiIn0 {
    unsigned char* proj; const float2* rot; int pm, pn; LAS bf16_t* tl  ; int wv; float sc  ;
    __device__ __forceinline__ void launder() { proj = lauv(proj); rot = lauv(rot); pm = lauv(pm); pn = lauv(pn); }
    __device__ __forceinline__ void tile_out(bf16_t* gbase  ) const {
        __syncthreads();
        const int tid = tid_fresh(wv);
#pragma unroll
        for (int it = 0; it < 16; ++it) {
            const int c = tid + it * NT, d = c >> 5, ch = c & 31;
            *(GAS u32x4*)(gbase + (size_t)((ch >> 3) * 256 + d) * 64 + (ch & 7) * 8) = *(const LAS u32x4*)(tl + d * 264 + ch * 8);
        }
        __syncthreads();
    }
    __device__ __forceinline__ void operator()(const AccT& acc, int wr, int wc, int fr, int fq) const {
        const int row0 = pm * BM + wr * 64 + fr;
        if (pn < 4) {
            bf16_t* O = (bf16_t*)(proj + PJ_AB);
#pragma unroll
            for (int ai = 0; ai < 2; ++ai)
#pragma unroll
                for (int m = 0; m < 4; ++m) { bf16_t* rp = O + (size_t)(row0 + ai * HALF + m * 16) * 1024 + pn * 256 + wc * 32 + fq * 4;
#pragma unroll
                    for (int bj = 0; bj < 2; ++bj)
#pragma unroll
                        for (int n = 0; n < 2; ++n) st_bf16x4(rp + bj * HALF + n * 16, acc[ai][bj][m][n] * sc); }
        } else if (pn < 12) {
            bf16_t* O = (bf16_t*)(proj + PJ_U);
#pragma unroll
            for (int ai = 0; ai < 2; ++ai)
#pragma unroll
                for (int m = 0; m < 4; ++m) { bf16_t* rp = O + (size_t)(row0 + ai * HALF + m * 16) * 1024 + (pn - 4) * 128 + wc * 32 + fq * 4;
#pragma unroll
                    for (int n = 0; n < 2; ++n) st_bf16x4(rp + n * 16, acc[ai][0][m][n] * acc[ai][1][m][n] * (sc * sc)); }
        } else if (pn < 20) {
            const bool isk = pn >= 16; const int hh = (pn - 12) & 3;
            const float lg2 = log2f(1.0f - exp2f(-5.0f - (float)hh));
            bf16_t* O = (bf16_t*)(proj + (isk ? PJ_K : PJ_Q));
            __builtin_assume_separate_storage((const void*)rot, (const void*)O);
#pragma unroll
            for (int ai = 0; ai < 2; ++ai)
#pragma unroll
                for (int m = 0; m < 4; ++m) {
                    const int t = row0 + ai * HALF + m * 16, pos = t & (NS - 1);
                    f32x4 csr[2][2];
#pragma unroll
                    for (int n = 0; n < 2; ++n) {
                        const GAS f32x4* cp = (const GAS f32x4*)(rot + pos * 128 + wc * 32 + n * 16 + fq * 4);
                        csr[n][0] = cp[0]; csr[n][1] = cp[1];
                    }
                    const int pc = pos & 63;
                    const float dsc = __builtin_amdgcn_exp2f((isk ? -lg2 : lg2) * (float)pc) * (isk ? 0.0625f * sc : sc);
                    bf16_t* rp = O + (size_t)t * 1024 + hh * 256 + wc * 32 + fq * 4;
                    f32x4 o1[2], o2[2];
#pragma unroll
                    for (int n = 0; n < 2; ++n)
#pragma unroll
                        for (int j = 0; j < 4; ++j) {
                            const float cx = csr[n][j >> 1][(j & 1) * 2], cy = csr[n][j >> 1][(j & 1) * 2 + 1];
                            const float x1 = acc[ai][0][m][n][j], x2 = acc[ai][1][m][n][j];
                            o1[n][j] = (x1 * cx - x2 * cy) * dsc; o2[n][j] = (x1 * cy + x2 * cx) * dsc;
                        }
#pragma unroll
                    for (int n = 0; n < 2; ++n) { st_bf16x4(rp + n * 16, o1[n]); st_bf16x4(rp + HALF + n * 16, o2[n]); }
                }
        } else if (pn < 24) {
            const int hh = pn - 20; bf16_t* OT = (bf16_t*)(proj + PJ_VT);
#pragma unroll
            for (int ai = 0; ai < 2; ++ai)
#pragma unroll
                for (int m = 0; m < 4; ++m) {
                    const int t = row0 + ai * HALF + m * 16;
#pragma unroll
                    for (int bj = 0; bj < 2; ++bj)
#pragma unroll
                        for (int n = 0; n < 2; ++n) {
                            LAS bf16_t* tp = tl + (bj * HALF + wc * 32 + n * 16 + fq * 4) * 264 + (t & 255);
#pragma unroll
                            for (int j = 0; j < 4; ++j) tp[j * 264] = f2bf(acc[ai][bj][m][n][j] * sc);
                        }
                }
            tile_out(OT + ((size_t)((((pm * BM) >> 11) * 4 + hh) * 32 + (((pm * BM) & (NS - 1)) >> 6)) * 256) * 64);
        } else {
            bf16_t* O = (bf16_t*)(proj + PJ_SG);
#pragma unroll
            for (int ai = 0; ai < 2; ++ai)
#pragma unroll
                for (int m = 0; m < 4; ++m) { bf16_t* rp = O + (size_t)(row0 + ai * HALF + m * 16) * 1024 + (pn - 24) * 256 + wc * 32 + fq * 4;
#pragma unroll
                    for (int bj = 0; bj < 2; ++bj)
#pragma unroll
                        for (int n = 0; n < 2; ++n) { f32x4 v = acc[ai][bj][m][n];
#pragma unroll
                            for (int j = 0; j < 4; ++j) v[j] = silu_f(v[j] * sc);
                            st_bf16x4(rp + bj * HALF + n * 16, v); } }
        }
    }
};

template <bool ADD_TMP, bool XIN_F32>
struct EpiRes {
    const void* xin; const bf16_t* tmp; bf16_t* xout; const float* gate  ; int pm, pn; float sc;
    __device__ __forceinline__ void launder() { xin = lauv(xin); tmp = lauv(tmp); xout = lauv(xout); gate = lauv(gate); pm = lauv(pm); pn = lauv(pn); }
    __device__ __forceinline__ void operator()(const AccT& acc, int wr, int wc, int fr, int fq) const {
        const int row0 = pm * BM + wr * 64 + fr, col0 = pn * BM + wc * 32 + fq * 4;
        const int bb = (pm * BM) >> 11;
        f32x4 gv[2][2];
#pragma unroll
        for (int bj = 0; bj < 2; ++bj)
#pragma unroll
            for (int n = 0; n < 2; ++n) gv[bj][n] = *(const GAS f32x4*)(gate + (size_t)bb * 6144 + col0 + bj * HALF + n * 16);
        constexpr int MB = XIN_F32 ? 2 : 4;
        constexpr int SP = 528;
        LAS unsigned char* st = (LAS unsigned char*)(unsigned)0;
#pragma unroll
        for (int ai = 0; ai < 2; ++ai)
#pragma unroll
            for (int m0 = 0; m0 < 4; m0 += MB) {
                f32x4 xv[MB][2][2];
#pragma unroll
                for (int mm = 0; mm < MB; ++mm) {
                    const size_t ro = (size_t)(row0 + ai * HALF + (m0 + mm) * 16) * ND + col0;
#pragma unroll
                    for (int bj = 0; bj < 2; ++bj)
#pragma unroll
                        for (int n = 0; n < 2; ++n) {
                            xv[mm][bj][n] = XIN_F32 ? *(const GAS f32x4*)((const float*)xin + ro + bj * HALF + n * 16) : ld_bf16x4((const bf16_t*)xin + ro + bj * HALF + n * 16);
                            if (ADD_TMP) xv[mm][bj][n] += ld_bf16x4(tmp + ro + bj * HALF + n * 16);
                        }
                }
#pragma unroll
                for (int mm = 0; mm < MB; ++mm) {
                    const int rl = wr * 64 + fr + ai * HALF + (m0 + mm) * 16;
#pragma unroll
                    for (int bj = 0; bj < 2; ++bj)
#pragma unroll
                        for (int n = 0; n < 2; ++n) {
                            const f32x4 v = xv[mm][bj][n] + gv[bj][n] * (acc[ai][bj][m0 + mm][n] * sc);
                            u32x2 o; o.x = cvt_pk_bf16(v[0], v[1]); o.y = cvt_pk_bf16(v[2], v[3]);
                            *(LAS u32x2*)(st + rl * SP + (wc * 32 + fq * 4 + bj * HALF + n * 16) * 2) = o;
                        }
                }
            }
        __syncthreads();
        {
            const int tid = (wr * 4 + wc) * 64 + fq * 16 + fr;
            bf16_t* ob = xout + (size_t)(pm * BM) * ND + pn * BM;
#pragma unroll
            for (int it = 0; it < 16; ++it) {
                const int i = tid + it * NT, r = i >> 5, ch = i & 31;
                *(GAS u32x4*)(ob + (size_t)r * ND + ch * 8) = *(const LAS u32x4*)(st + r * SP + ch * 16);
            }
        }
        __syncthreads();
    }
};

typedef short s16x4_t __attribute__((ext_vector_type(4)));
__device__ __forceinline__ void retention_phase(int wv, unsigned char* proj, bf16_t* __restrict__ Og, unsigned char* lds) {
    const int tid = tid_fresh(wv);
    bf16_t* P_lds = (bf16_t*)lds;
    bf16_t* St_lds = (bf16_t*)(lds + 9216);
    bf16_t* Q_lds = (bf16_t*)(lds + 9216 + 33792);
    bf16_t* K_lds = (bf16_t*)(lds + 9216 + 2 * 33792);
    bf16_t* V_lds = (bf16_t*)(lds + 9216 + 3 * 33792);
    const bf16_t* Qg = (const bf16_t*)(proj + PJ_Q); const bf16_t* Kg = (const bf16_t*)(proj + PJ_K);
    const bf16_t* KTg = (const bf16_t*)(proj + PJ_KT); const bf16_t* VTg = (const bf16_t*)(proj + PJ_VT);
    const int ti = wv >> 1, hf = wv & 1;
    for (int u0 = blockIdx.x; u0 < 256; u0 += gridDim.x) {
        int tu = tid; asm volatile("" : "+v"(tu));
        const int srow = tu >> 5, sc16 = tu & 31;
        const int vrow = tu >> 3, vc8 = tu & 7;
        const int fr = tu & 15, fq = (tu >> 4) & 3, w = wv;
        int u = u0;
        if (gridDim.x == 256) { const int xcd = u0 & 7, j = u0 >> 3; u = (((j >> 2) * 8 + xcd) << 2) | (j & 3); }
        const int b = u >> 4, hh = (u >> 2) & 3, es = u & 3;
        const float gam = 1.0f - exp2f(-5.0f - (float)hh);
        const float g63 = exp2f(63.0f * log2f(gam));
        const size_t hrow = (size_t)(b * 4 + hh) * 256;
        const bf16_t* qsp = Qg + ((size_t)b * NS + srow) * 1024 + hh * 256 + sc16 * 8;
        const bf16_t* ksp = Kg + ((size_t)b * NS + srow) * 1024 + hh * 256 + sc16 * 8;
        const bf16_t* vsp = VTg + (hrow * 32 + es * 64 + vrow) * 64 + vc8 * 8;
        u32x4 qr[2][4], kr[2][4], vr[2];
#pragma unroll
        for (int i = 0; i < 4; ++i) { qr[0][i] = *(const u32x4*)(qsp + (size_t)(16 * i) * 1024); kr[0][i] = *(const u32x4*)(ksp + (size_t)(16 * i) * 1024); }
        vr[0] = *(const u32x4*)vsp; vr[1] = *(const u32x4*)(vsp + 256 * 64);
        __syncthreads();
        for (int i = tid; i < 64 * 264 / 2; i += NT) ((unsigned*)St_lds)[i] = 0u;
#pragma unroll
        for (int i = 0; i < 4; ++i) { *(u32x4*)(Q_lds + (srow + 16 * i) * 264 + sc16 * 8) = qr[0][i]; *(u32x4*)(K_lds + (srow + 16 * i) * 264 + sc16 * 8) = kr[0][i]; }
#pragma unroll
        for (int i = 0; i < 4; ++i) { qr[1][i] = *(const u32x4*)(qsp + (size_t)(64 + 16 * i) * 1024); kr[1][i] = *(const u32x4*)(ksp + (size_t)(64 + 16 * i) * 1024); }
        f32x4 S[2][4];
#pragma unroll
        for (int dl = 0; dl < 2; ++dl)
#pragma unroll
            for (int et = 0; et < 4; ++et) S[dl][et] = (f32x4){0.f, 0.f, 0.f, 0.f};
        __syncthreads();
        for (int c2 = 0; c2 < 32; c2 += 2) {
#pragma unroll
          for (int e = 0; e < 2; ++e) {
            const int c = c2 + e;
            int tl = tid; asm volatile("" : "+v"(tl));
            const int fr = tl & 15, fq = (tl >> 4) & 3, srow = tl >> 5, sc16 = tl & 31, vrow = tl >> 3, vc8 = tl & 7, w = wv;
            const bf16_t* qsp = Qg + ((size_t)b * NS + srow) * 1024 + hh * 256 + sc16 * 8;
            const bf16_t* ksp = Kg + ((size_t)b * NS + srow) * 1024 + hh * 256 + sc16 * 8;
            const bf16_t* vsp = VTg + (hrow * 32 + es * 64 + vrow) * 64 + vc8 * 8;
            const int j0 = c * 64;
            const size_t trow = (size_t)b * NS + j0;
            *(u32x4*)(V_lds + vrow * 72 + vc8 * 8) = vr[e];
            {
                const int cn = (c + 2 < 32) ? c + 2 : 31;
#pragma unroll
                for (int i = 0; i < 4; ++i) { qr[e][i] = *(const u32x4*)(qsp + (size_t)(cn * 64 + 16 * i) * 1024); kr[e][i] = *(const u32x4*)(ksp + (size_t)(cn * 64 + 16 * i) * 1024); }
                vr[e] = *(const u32x4*)(vsp + (size_t)cn * (256 * 64));
            }
            bf16x8 ktf[2][2];
#pragma unroll
            for (int dl = 0; dl < 2; ++dl)
#pragma unroll
                for (int ks = 0; ks < 2; ++ks) {
                    const bf16_t* kp = K_lds + (ks * 32 + fq * 8 + (fr >> 2)) * 264 + (2 * w + dl) * 16 + (fr & 3) * 4;
                    const s16x4_t t0 = __builtin_amdgcn_ds_read_tr16_b64_v4i16((__attribute__((address_space(3))) s16x4_t*)(kp));
                    const s16x4_t t1 = __builtin_amdgcn_ds_read_tr16_b64_v4i16((__attribute__((address_space(3))) s16x4_t*)(kp + 4 * 264));
                    ktf[dl][ks] = __builtin_bit_cast(bf16x8, __builtin_shufflevector(t0, t1, 0, 1, 2, 3, 4, 5, 6, 7));
                }
            f32x4 pacc[2], oacc[2];
            pacc[0] = pacc[1] = oacc[0] = oacc[1] = (f32x4){0.f, 0.f, 0.f, 0.f};
            bf16x8 opA[5], opB[5];
#define RET_SB __builtin_amdgcn_sched_barrier(0);
#define RET_RD(buf, ks) { buf[4] = *(const bf16x8*)(Q_lds + (ti * 16 + fr) * 264 + (ks) * 32 + fq * 8); \
                buf[0] = *(const bf16x8*)(K_lds + ((hf * 2 + 0) * 16 + fr) * 264 + (ks) * 32 + fq * 8); buf[1] = *(const bf16x8*)(K_lds + ((hf * 2 + 1) * 16 + fr) * 264 + (ks) * 32 + fq * 8); \
                buf[2] = *(const bf16x8*)(St_lds + ((hf * 2 + 0) * 16 + fr) * 264 + (ks) * 32 + fq * 8); buf[3] = *(const bf16x8*)(St_lds + ((hf * 2 + 1) * 16 + fr) * 264 + (ks) * 32 + fq * 8); }
#define RET_MM(buf, ks) { \
                pacc[0] = __builtin_amdgcn_mfma_f32_16x16x32_bf16(buf[0], buf[4], pacc[0], 0, 0, 0); pacc[1] = __builtin_amdgcn_mfma_f32_16x16x32_bf16(buf[1], buf[4], pacc[1], 0, 0, 0); \
                oacc[0] = __builtin_amdgcn_mfma_f32_16x16x32_bf16(buf[2], buf[4], oacc[0], 0, 0, 0); oacc[1] = __builtin_amdgcn_mfma_f32_16x16x32_bf16(buf[3], buf[4], oacc[1], 0, 0, 0); }
            RET_RD(opA, 0) RET_RD(opB, 1) RET_SB
            RET_MM(opA, 0) RET_SB RET_RD(opA, 2) RET_SB RET_MM(opB, 1) RET_SB RET_RD(opB, 3) RET_SB
            RET_MM(opA, 2) RET_SB RET_RD(opA, 4) RET_SB RET_MM(opB, 3) RET_SB RET_RD(opB, 5) RET_SB
            RET_MM(opA, 4) RET_SB RET_RD(opA, 6) RET_SB RET_MM(opB, 5) RET_SB RET_RD(opB, 7) RET_SB
            RET_MM(opA, 6) RET_SB RET_MM(opB, 7) RET_SB
#undef RET_RD
#undef RET_MM
#pragma unroll
            for (int tt = 0; tt < 2; ++tt) {
                const int tj = hf * 2 + tt;
                { const int i = ti * 16 + fr, jc = tj * 16 + fq * 4; f32x4 pv = pacc[tt];
#pragma unroll
                  for (int j = 0; j < 4; ++j) pv[j] = (jc + j <= i) ? pv[j] : 0.f;
                  u32x2 o; o.x = cvt_pk_bf16(pv[0], pv[1]); o.y = cvt_pk_bf16(pv[2], pv[3]); *(u32x2*)(P_lds + i * 72 + jc) = o; }
            }
            __syncthreads();
#pragma unroll
            for (int i = 0; i < 4; ++i) { *(u32x4*)(Q_lds + (srow + 16 * i) * 264 + sc16 * 8) = qr[e ^ 1][i]; *(u32x4*)(K_lds + (srow + 16 * i) * 264 + sc16 * 8) = kr[e ^ 1][i]; }
            bf16x8 pf[2], vfo[2][2], vf[4][2];
#pragma unroll
            for (int ks = 0; ks < 2; ++ks) {
                pf[ks] = *(const bf16x8*)(P_lds + (ti * 16 + fr) * 72 + ks * 32 + fq * 8);
#pragma unroll
                for (int tt = 0; tt < 2; ++tt) vfo[tt][ks] = *(const bf16x8*)(V_lds + ((hf * 2 + tt) * 16 + fr) * 72 + ks * 32 + fq * 8);
#pragma unroll
                for (int et = 0; et < 4; ++et) vf[et][ks] = *(const bf16x8*)(V_lds + (et * 16 + fr) * 72 + ks * 32 + fq * 8);
            }
            oacc[0] *= gam; oacc[1] *= gam;
#pragma unroll
            for (int dl = 0; dl < 2; ++dl)
#pragma unroll
                for (int et = 0; et < 4; ++et) S[dl][et] *= gam;
            RET_SB
#pragma unroll
            for (int ks = 0; ks < 2; ++ks) {
                oacc[0] = __builtin_amdgcn_mfma_f32_16x16x32_bf16(vfo[0][ks], pf[ks], oacc[0], 0, 0, 0);
                oacc[1] = __builtin_amdgcn_mfma_f32_16x16x32_bf16(vfo[1][ks], pf[ks], oacc[1], 0, 0, 0);
#pragma unroll
                for (int dl = 0; dl < 2; ++dl)
#pragma unroll
                    for (int et = 0; et < 4; ++et) S[dl][et] = __builtin_amdgcn_mfma_f32_16x16x32_bf16(ktf[dl][ks], vf[et][ks], S[dl][et], 0, 0, 0);
            }
            RET_SB
#pragma unroll
            for (int tt = 0; tt < 2; ++tt) {
                const int te = hf * 2 + tt;
                st_bf16x4(Og + (trow + ti * 16 + fr) * 1024 + hh * 256 + es * 64 + te * 16 + fq * 4, oacc[tt]);
            }
#pragma unroll
            for (int dl = 0; dl < 2; ++dl)
#pragma unroll
                for (int et = 0; et < 4; ++et) {
                    const f32x4 sv = S[dl][et] * g63; S[dl][et] = sv;
                    u32x2 o; o.x = cvt_pk_bf16(sv[0], sv[1]); o.y = cvt_pk_bf16(sv[2], sv[3]);
                    *(u32x2*)(St_lds + (et * 16 + fr) * 264 + (2 * w + dl) * 16 + fq * 4) = o;
                }
#undef RET_SB
            __syncthreads();
          }
        }
    }
}

__device__ __forceinline__ void ycat_phase(int wv, const unsigned char* proj, const bf16_t* __restrict__ Og, const float* __restrict__ conv_w, const float* __restrict__ conv_b, bf16_t* __restrict__ Y) {
    const int tid = tid_fresh(wv), lane = tid & 63, wave = tid >> 6;
    const bf16_t* AB = (const bf16_t*)(proj + PJ_AB); const bf16_t* U = (const bf16_t*)(proj + PJ_U); const bf16_t* SG = (const bf16_t*)(proj + PJ_SG);
    const int ch0 = lane * 16;
    float cw0[16], cw1[16], cw2[16], cb[16];
#pragma unroll
    for (int i = 0; i < 16; ++i) { cw0[i] = conv_w[ch0 + i]; cw1[i] = conv_w[1024 + ch0 + i]; cw2[i] = conv_w[2048 + ch0 + i]; cb[i] = conv_b[ch0 + i]; }
    const int rows_per_wave = NTOK / ((int)gridDim.x * 8);
    const int row0 = (blockIdx.x * 8 + wave) * rows_per_wave;
    float u1[16], u2[16];
    auto load16 = [&](const bf16_t* p, float* f) {
        const u32x4 a = *(const u32x4*)p; const u32x4 c = *(const u32x4*)(p + 8);
        f[0] = bflo(a.x); f[1] = bfhi(a.x); f[2] = bflo(a.y); f[3] = bfhi(a.y); f[4] = bflo(a.z); f[5] = bfhi(a.z); f[6] = bflo(a.w); f[7] = bfhi(a.w);
        f[8] = bflo(c.x); f[9] = bfhi(c.x); f[10] = bflo(c.y); f[11] = bfhi(c.y); f[12] = bflo(c.z); f[13] = bfhi(c.z); f[14] = bflo(c.w); f[15] = bfhi(c.w);
    };
    auto store16 = [&](bf16_t* p, const float* f) {
        u32x4 a, c;
        a.x = cvt_pk_bf16(f[0], f[1]); a.y = cvt_pk_bf16(f[2], f[3]); a.z = cvt_pk_bf16(f[4], f[5]); a.w = cvt_pk_bf16(f[6], f[7]);
        c.x = cvt_pk_bf16(f[8], f[9]); c.y = cvt_pk_bf16(f[10], f[11]); c.z = cvt_pk_bf16(f[12], f[13]); c.w = cvt_pk_bf16(f[14], f[15]);
        *(u32x4*)p = a; *(u32x4*)(p + 8) = c;
    };
    auto store16f8 = [&](unsigned char* p, const float* f) {
        u32x4 a;
        a.x = pack_fp8x4(f[0] * Y8_SCALE, f[1] * Y8_SCALE, f[2] * Y8_SCALE, f[3] * Y8_SCALE); a.y = pack_fp8x4(f[4] * Y8_SCALE, f[5] * Y8_SCALE, f[6] * Y8_SCALE, f[7] * Y8_SCALE);
        a.z = pack_fp8x4(f[8] * Y8_SCALE, f[9] * Y8_SCALE, f[10] * Y8_SCALE, f[11] * Y8_SCALE); a.w = pack_fp8x4(f[12] * Y8_SCALE, f[13] * Y8_SCALE, f[14] * Y8_SCALE, f[15] * Y8_SCALE);
        *(u32x4*)p = a;
    };
    {
        const int pos = row0 & (NS - 1);
#pragma unroll
        for (int i = 0; i < 16; ++i) { u1[i] = 0.f; u2[i] = 0.f; }
        if (pos >= 1) load16(U + (size_t)(row0 - 1) * 1024 + ch0, u1);
        if (pos >= 2) load16(U + (size_t)(row0 - 2) * 1024 + ch0, u2);
    }
    for (int r = 0; r < rows_per_wave; ++r) {
        const int t = row0 + r;
        float ab[16], u0[16], y[16];
        load16(AB + (size_t)t * 1024 + ch0, ab); load16(U + (size_t)t * 1024 + ch0, u0);
        if ((t & (NS - 1)) == 0) {
#pragma unroll
            for (int i = 0; i < 16; ++i) { u1[i] = 0.f; u2[i] = 0.f; }
        }
#pragma unroll
        for (int i = 0; i < 16; ++i) { y[i] = ab[i] * (cb[i] + cw0[i] * u2[i] + cw1[i] * u1[i] + cw2[i] * u0[i]); u2[i] = u1[i]; u1[i] = u0[i]; }
        if (F8_P5) store16f8((unsigned char*)Y + (size_t)t * ND + ch0, y); else store16(Y + (size_t)t * ND + ch0, y);
        float o[16], sg[16];
        load16(Og + (size_t)t * 1024 + ch0, o); load16(SG + (size_t)t * 1024 + ch0, sg);
        float ss = 0.f;
#pragma unroll
        for (int i = 0; i < 16; ++i) ss += o[i] * o[i];
        ss += shx(ss, 1, lane); ss += shx(ss, 2, lane); ss += shx(ss, 4, lane); ss += shx(ss, 8, lane);
        const float rs = rsqrtf(ss * (1.0f / 256.0f) + RMS_EPS);
#pragma unroll
        for (int i = 0; i < 16; ++i) y[i] = o[i] * rs * sg[i];
        if (F8_P5) store16f8((unsigned char*)Y + (size_t)t * ND + 1024 + ch0, y); else store16(Y + (size_t)t * ND + 1024 + ch0, y);
    }
}

constexpr int MOE_TAB_OFF = 64;
__device__ __forceinline__ int moe_build_table(int wv, const unsigned* cntp, unsigned char* lds) {
    volatile LAS int* tab = (volatile LAS int*)(lds + LDS_MISC + MOE_TAB_OFF);
    __syncthreads();
    if (wv == 0) {
        const int lane = tid_fresh(wv) & 63;
        const int c = lane < 16 ? (int)__hip_atomic_load(cntp + lane * 64, __ATOMIC_RELAXED, __HIP_MEMORY_SCOPE_AGENT) : 0;
        const int ntl = (c + 255) >> 8;
        int base = 0, total = 0;
#pragma unroll
        for (int e = 0; e < 16; ++e) { const int ne = __builtin_amdgcn_readlane(ntl, e); base += (lane > e) ? ne : 0; total += ne; }
        for (int lt = 0; lt < ntl; ++lt) { const int mt = base + lt; tab[4 + mt * 4 + 0] = lane; tab[4 + mt * 4 + 1] = lt * 256; tab[4 + mt * 4 + 2] = c; }
        if (lane == 0) tab[0] = total;
    }
    __syncthreads();
    return __builtin_amdgcn_readfirstlane(tab[0]);
}
struct RowGather {
    static constexpr bool PLAIN = false; static constexpr unsigned ld = 0;
    const int* idx; int nvalid;
    __device__ __forceinline__ unsigned operator()(int r) const {
        const __amdgpu_buffer_rsrc_t rs = __builtin_amdgcn_make_buffer_rsrc((void*)idx, 0, 256 * 4, 0x00020000);
        const int v = (r < nvalid) ? (int)__builtin_amdgcn_raw_buffer_load_b32(rs, r * 4, 0, 0) : 0;
        return (unsigned)(v >> 1) * (unsigned)(ND / 2);
    }
};
struct EpiGate {
    bf16_t* act; int row0g  , colbase;
    __device__ __forceinline__ void launder() { act = lauv(act); row0g = lauv(row0g); colbase = lauv(colbase); }
    __device__ __forceinline__ void operator()(const AccT& acc, int wr, int wc, int fr, int fq) const {
        const int lo = fr * DEXP + fq * 4;
        const __amdgpu_buffer_rsrc_t rs = __builtin_amdgcn_make_buffer_rsrc((void*)((unsigned char*)act + (size_t)(row0g + wr * 64) * DEXP + colbase + wc * 32), 0, 256 * DEXP, 0x00020000);
#pragma unroll
        for (int ai = 0; ai < 2; ++ai)
#pragma unroll
            for (int m = 0; m < 4; ++m) {
#pragma unroll
                for (int n = 0; n < 2; ++n) { f32x4 v;
#pragma unroll
                    for (int j = 0; j < 4; ++j) v[j] = silu_f(acc[ai][0][m][n][j] * (1.0f / W8_SCALE)) * acc[ai][1][m][n][j] * (A8_SCALE / W8_SCALE);
                    __builtin_amdgcn_raw_buffer_store_b32(pack_fp8x4(v[0], v[1], v[2], v[3]), rs, lo + n * 16, (ai * HALF + m * 16) * DEXP, 0); } }
    }
};
constexpr float T8_SCALE = 16.0f;
struct EpiMoeOut {
    const int* idx; const float* gts; int nvalid; bf16_t* tmp1; bf16_t* tmp; const float* gate  ; int col0t; int tmp8  ;
    __device__ __forceinline__ void launder() { idx = lauv(idx); gts = lauv(gts); tmp1 = lauv(tmp1); tmp = lauv(tmp); gate = lauv(gate); nvalid = lauv(nvalid); col0t = lauv(col0t); tmp8 = lauv(tmp8); }
    __device__ __forceinline__ void operator()(const AccT& acc, int wr, int wc, int fr, int fq) const {
        LAS unsigned char* st = (LAS unsigned char*)(unsigned)0;
        const __amdgpu_buffer_rsrc_t ri = __builtin_amdgcn_make_buffer_rsrc((void*)idx, 0, 256 * 4, 0x00020000), rg = __builtin_amdgcn_make_buffer_rsrc((void*)gts, 0, 256 * 4, 0x00020000);
        float gg[8];
#pragma unroll
        for (int q = 0; q < 8; ++q) { const int r = (q >> 2) * HALF + wr * 64 + (q & 3) * 16 + fr, rc = r < nvalid ? r : nvalid - 1; gg[q] = __builtin_bit_cast(float, __builtin_amdgcn_raw_buffer_load_b32(rg, rc * 4, 0, 0)); }
        const int tid = (wr * 4 + wc) * 64 + fq * 16 + fr;
        int vv[8];
#pragma unroll
        for (int it = 0; it < 8; ++it) { const int r = (tid >> 4) + it * 32, rc = r < nvalid ? r : nvalid - 1; vv[it] = (int)__builtin_amdgcn_raw_buffer_load_b32(ri, rc * 4, 0, 0); }
#pragma unroll
        for (int ai = 0; ai < 2; ++ai)
#pragma unroll
            for (int m = 0; m < 4; ++m) {
                const int r = ai * HALF + wr * 64 + m * 16 + fr;
                const float g = gg[ai * 4 + m] * (T8_SCALE / (W8_SCALE * A8_SCALE));
#pragma unroll
                for (int bj = 0; bj < 2; ++bj)
#pragma unroll
                    for (int n = 0; n < 2; ++n) { const f32x4 y = acc[ai][bj][m][n] * g; *(LAS unsigned*)(st + r * 272 + bj * HALF + wc * 32 + n * 16 + fq * 4) = pack_fp8x4(y[0], y[1], y[2], y[3]); }
            }
        __syncthreads();
        const __amdgpu_buffer_rsrc_t rt = __builtin_amdgcn_make_buffer_rsrc((void*)tmp, 0, 128 * 1024 * 1024, 0x00020000);
#pragma unroll
        for (int it = 0; it < 8; ++it) {
            const int r = (tid >> 4) + it * 32, ch = tid & 15;
            if (r < nvalid) {
                const int v = vv[it];
                const u32x4 d = *(const LAS u32x4*)(st + r * 272 + ch * 16);
                __builtin_amdgcn_raw_buffer_store_b128(d, rt, ((v & 1) << 26) + (v >> 1) * ND + col0t + ch * 16, 0, 0);
            }
        }
        __syncthreads();
    }
};

struct EpiGateLazy {
    int mt, nt;
    __device__ __forceinline__ void launder() { mt = lauv(mt); nt = lauv(nt); }
    __device__ __forceinline__ void operator()(const AccT& acc, int wr, int wc, int fr, int fq) const {
        const KA a; unsigned char* ws = a.ws();
        EpiGate E{(bf16_t*)(ws + WS_PROJ + PJ_ACT), mt * 256, nt * 128};
        E(acc, wr, wc, fr, fq);
    }
};
struct EpiMoeOutLazy {
    int e, r0, nvalid, layer, nt;
    __device__ __forceinline__ void launder() { e = lauv(e); r0 = lauv(r0); nvalid = lauv(nvalid); layer = lauv(layer); nt = lauv(nt); }
    __device__ __forceinline__ void operator()(const AccT& acc, int wr, int wc, int fr, int fq) const {
        const KA a; unsigned char* ws = a.ws();
        EpiMoeOut E{(const int*)(ws + WS_IDX) + e * 32768 + r0, (const float*)(ws + WS_GT) + e * 32768 + r0, nvalid, (bf16_t*)(ws + WS_TMP1), (bf16_t*)(ws + WS_TMP),
                    (const float*)(ws + WS_MOD) + (size_t)(2 * layer + 1) * 16 * 6144 + 4096, nt * 256, layer};
        E(acc, wr, wc, fr, fq);
    }
};
__device__ __forceinline__ void moe_phase1(int wv, unsigned char* ws0, int layer, unsigned char* lds) {
    const int nmt = moe_build_table(wv, (const unsigned*)(ws0 + WS_CTL + CTL_CNT + layer * 4096), lds);
    for (int k = 0, u = unit_index(0); u < nmt * 8; u = unit_index(++k)) {
        const KA a; unsigned char* ws = a.ws();
        const LAS int* tab = (const LAS int*)(lds + LDS_MISC + MOE_TAB_OFF);
        const int mt = u >> 3, nt = u & 7;
        const int e = __builtin_amdgcn_readfirstlane(tab[4 + mt * 4 + 0]), r0 = __builtin_amdgcn_readfirstlane(tab[4 + mt * 4 + 1]), cnt_e = __builtin_amdgcn_readfirstlane(tab[4 + mt * 4 + 2]);
        RowGather ro{(const int*)(ws + WS_IDX) + e * 32768 + r0, cnt_e - r0};
        EpiGateLazy E{mt, nt};
        gemm_unit<true>(wv, (bf16_t*)lds, (const bf16_t*)(ws + WS_H), ro, (const bf16_t*)(ws + WS_W13 + ((size_t)(layer * 16 + e) * 2048 + (size_t)nt * 256) * ND), ND / 2, ND / 2, E);
    }
}
__device__ __forceinline__ void moe_phase2(int wv, unsigned char* ws0, int layer, unsigned char* lds) {
    const int nmt = moe_build_table(wv, (const unsigned*)(ws0 + WS_CTL + CTL_CNT + layer * 4096), lds);
    for (int k = 0, u = unit_index(0); u < nmt * 8; u = unit_index(++k)) {
        const KA a; unsigned char* ws = a.ws();
        const LAS int* tab = (const LAS int*)(lds + LDS_MISC + MOE_TAB_OFF);
        const int mt = u >> 3, nt = u & 7;
        const int e = __builtin_amdgcn_readfirstlane(tab[4 + mt * 4 + 0]), r0 = __builtin_amdgcn_readfirstlane(tab[4 + mt * 4 + 1]), cnt_e = __builtin_amdgcn_readfirstlane(tab[4 + mt * 4 + 2]);
        RowPlain ro{(unsigned)(mt * 256) * (DEXP / 2), (unsigned)(DEXP / 2)};
        EpiMoeOutLazy E{e, r0, cnt_e - r0, layer, nt};
        gemm_unit<true>(wv, (bf16_t*)lds, (const bf16_t*)(ws + WS_PROJ + PJ_ACT), ro, (const bf16_t*)(ws + WS_W2 + ((size_t)(layer * 16 + e) * 2048 + (size_t)nt * 256) * DEXP), DEXP / 2, DEXP / 2, E);
    }
}

constexpr float Q8_SCALE = 8.0f;
struct EpiIn1 {
    unsigned char* proj; int pm, pn; float sc;
    __device__ __forceinline__ void launder() { proj = lauv(proj); pm = lauv(pm); pn = lauv(pn); }
    __device__ __forceinline__ void operator()(const AccT& acc, int wr, int wc, int fr, int fq) const {
        const int row0 = pm * BM + wr * 64 + fr;
        if (pn < 8 || (pn >= 9 && pn < 13)) {
            const bool isq = pn < 8;
            bf16_t* O = (bf16_t*)(proj + (isq ? PJ_Q1 : PJ_QI)); const int ld = isq ? 2048 : 1024, cb = (isq ? pn : pn - 9) * 256;
#pragma unroll
            for (int ai = 0; ai < 2; ++ai)
#pragma unroll
                for (int m = 0; m < 4; ++m) { bf16_t* rp = O + (size_t)(row0 + ai * HALF + m * 16) * ld + cb + wc * 32 + fq * 4;
                    unsigned char* rp8 = (unsigned char*)O + (size_t)(row0 + ai * HALF + m * 16) * 2048 + cb + wc * 32 + fq * 4;
#pragma unroll
                    for (int bj = 0; bj < 2; ++bj)
#pragma unroll
                        for (int n = 0; n < 2; ++n) {
                            if (isq) { const f32x4 v = acc[ai][bj][m][n] * (sc * Q8_SCALE); *(GAS unsigned*)(rp8 + bj * HALF + n * 16) = pack_fp8x4(v[0], v[1], v[2], v[3]); }
                            else st_bf16x4(rp + bj * HALF + n * 16, acc[ai][bj][m][n] * sc);
                        } }
        } else if (pn == 8) {
            bf16_t* KR = (bf16_t*)(proj + PJ_KR); bf16_t* VT = (bf16_t*)(proj + PJ_VT1);
#pragma unroll
            for (int ai = 0; ai < 2; ++ai)
#pragma unroll
                for (int m = 0; m < 4; ++m) {
                    const int t = row0 + ai * HALF + m * 16, pos = t & (NS - 1), bb = t >> 11;
#pragma unroll
                    for (int n = 0; n < 2; ++n) {
                        st_bf16x4(KR + (size_t)t * 128 + wc * 32 + n * 16 + fq * 4, acc[ai][0][m][n] * sc);
                        st_bf16x4(VT + (size_t)t * 128 + wc * 32 + n * 16 + fq * 4, acc[ai][1][m][n] * sc);
                    }
                }
        } else {
            bf16_t* KI = (bf16_t*)(proj + PJ_KI); float* WI = (float*)(proj + PJ_WI);
#pragma unroll
            for (int ai = 0; ai < 2; ++ai)
#pragma unroll
                for (int m = 0; m < 4; ++m) {
                    const int t = row0 + ai * HALF + m * 16;
                    if (wc < 2) {
#pragma unroll
                        for (int n = 0; n < 2; ++n) st_bf16x4(KI + (size_t)t * 64 + wc * 32 + n * 16 + fq * 4, acc[ai][0][m][n] * sc);
                    } else if (wc == 2) {
                        *(GAS f32x4*)(WI + (size_t)t * 16 + fq * 4) = acc[ai][0][m][0] * sc;
                    }
                }
        }
    }
};

constexpr float ATT_KS = 16.0f, ATT_QS = 64.0f;
__device__ __forceinline__ void knorm_phase(int wv, const unsigned char* proj, const float* __restrict__ k_norm, bf16_t* __restrict__ Kn) {
    const int tid = tid_fresh(wv), lane = tid & 63;
    const bf16_t* KR = (const bf16_t*)(proj + PJ_KR);
    const int sub = tid & 15;
    float kw[8];
#pragma unroll
    for (int i = 0; i < 8; ++i) kw[i] = k_norm[sub * 8 + i];
    for (int t = (blockIdx.x * NT + tid) >> 4; t < NTOK; t += (gridDim.x * NT) >> 4) {
        const u32x4 v = *(const u32x4*)(KR + (size_t)t * 128 + sub * 8);
        float f[8] = {bflo(v.x), bfhi(v.x), bflo(v.y), bfhi(v.y), bflo(v.z), bfhi(v.z), bflo(v.w), bfhi(v.w)};
        float ss = 0.f;
#pragma unroll
        for (int i = 0; i < 8; ++i) ss += f[i] * f[i];
        ss += shx(ss, 1, lane); ss += shx(ss, 2, lane); ss += shx(ss, 4, lane); ss += shx(ss, 8, lane);
        const float rs = rsqrtf(ss * (1.0f / 128.0f) + RMS_EPS);
        u32x2 o; o.x = pack_fp8x4(f[0] * rs * kw[0] * ATT_KS, f[1] * rs * kw[1] * ATT_KS, f[2] * rs * kw[2] * ATT_KS, f[3] * rs * kw[3] * ATT_KS);
        o.y = pack_fp8x4(f[4] * rs * kw[4] * ATT_KS, f[5] * rs * kw[5] * ATT_KS, f[6] * rs * kw[6] * ATT_KS, f[7] * rs * kw[7] * ATT_KS);
        *(u32x2*)((unsigned char*)Kn + (size_t)t * 128 + sub * 8) = o;
    }
}

__device__ __forceinline__ unsigned f2sort(float f) { const unsigned u = __float_as_uint(f); return (u & 0x80000000u) ? ~u : (u | 0x80000000u); }
constexpr int IDX_SC_BYTES = 8 * 2 * 2048 * 4;
constexpr int IDX_KT_BYTES = 64 * 144;
#define WRLANE2(word, lo, hi, lane_idx) asm("s_nop 1\n\tv_writelane_b32 %0, %1, " #lane_idx "\n\tv_writelane_b32 %0, %2, " #lane_idx "+1" : "+v"(word) : "s"(lo), "s"(hi))
typedef short s16x2_t __attribute__((ext_vector_type(2)));
__device__ __forceinline__ unsigned relu_bf16x2(unsigned v) { const s16x2_t z = {0, 0}; return __builtin_bit_cast(unsigned, __builtin_elementwise_max(__builtin_bit_cast(s16x2_t, v), z)); }
__device__ __forceinline__ void indexer_phase(int wv, const unsigned char* proj, unsigned* __restrict__ MASK, unsigned char* lds) {
    const int tid = tid_fresh(wv), lane = tid & 63, fr = lane & 15, fq = lane >> 4;
    const bf16_t* QI = (const bf16_t*)(proj + PJ_QI); const bf16_t* KI = (const bf16_t*)(proj + PJ_KI); const float* WI = (const float*)(proj + PJ_WI);
    float* scl = (float*)lds + (size_t)wv * 2 * 2048;
    unsigned char* ktl = lds + IDX_SC_BYTES;
    const int nunits = NB * 128;
    for (int uu = blockIdx.x; uu < nunits; uu += gridDim.x) {
        int b, q16;
        if (gridDim.x == 256) { b = blockIdx.x >> 4; const int r = blockIdx.x & 15, k = (uu - blockIdx.x) / 256; q16 = (k & 1) ? (k >> 1) * 32 + 31 - r : (k >> 1) * 32 + r; }
        else { b = uu >> 7; q16 = uu & 127; }
        const int p0 = q16 * 16, pw = p0 + 2 * wv;
        const size_t t0 = (size_t)b * NS + pw;
        bf16x8 qa[2][2], wa;
#pragma unroll
        for (int tk = 0; tk < 2; ++tk)
#pragma unroll
            for (int ks = 0; ks < 2; ++ks) qa[tk][ks] = *(const bf16x8*)(QI + (t0 + tk) * 1024 + fr * 64 + ks * 32 + fq * 8);
        {
            const f32x4 w0 = *(const f32x4*)(WI + (t0 + 0) * 16 + fq * 4), w1 = *(const f32x4*)(WI + (t0 + 1) * 16 + fq * 4);
            u32x4 wp = (u32x4){0u, 0u, 0u, 0u};
            if (fr == 0) { wp.x = cvt_pk_bf16(w0[0], w0[1]); wp.y = cvt_pk_bf16(w0[2], w0[3]); }
            if (fr == 1) { wp.z = cvt_pk_bf16(w1[0], w1[1]); wp.w = cvt_pk_bf16(w1[2], w1[3]); }
            wa = __builtin_bit_cast(bf16x8, wp);
        }
        const int nkt = (p0 >> 6) + 1;
        const int krow = tid >> 3, kch = tid & 7;
        const bf16_t* kgp = KI + ((size_t)b * NS + krow) * 64 + kch * 8;
        const int klast = nkt - 1;
#define IDX_LD(x) (*(const u32x4*)(kgp + (size_t)((x) < klast ? (x) : klast) * (64 * 64)))
        u32x4 kr0 = IDX_LD(0), kr1 = IDX_LD(1), kr2 = IDX_LD(2), kr3 = IDX_LD(3);
        __syncthreads();
        *(u32x4*)(ktl + krow * 144 + kch * 16) = kr0;
        kr0 = IDX_LD(4);
        __syncthreads();
#define IDX_SB __builtin_amdgcn_sched_barrier(0);
#define IDX_TILE(KT, KRN) { \
            const int kt_ = (KT); \
            const unsigned char* kc = ktl + (kt_ & 1) * IDX_KT_BYTES; \
            bf16x8 kf[4][2]; \
            _Pragma("unroll") \
            for (int st = 0; st < 4; ++st) { kf[st][0] = *(const bf16x8*)(kc + (st * 16 + fr) * 144 + fq * 16); kf[st][1] = *(const bf16x8*)(kc + (st * 16 + fr) * 144 + 64 + fq * 16); } \
            f32x4 dd[4][2]; \
            IDX_SB \
            _Pragma("unroll") \
            for (int st = 0; st < 4; ++st) { \
                _Pragma("unroll") \
                for (int tk = 0; tk < 2; ++tk) dd[st][tk] = __builtin_amdgcn_mfma_f32_16x16x32_bf16(qa[tk][0], kf[st][0], (f32x4){0.f, 0.f, 0.f, 0.f}, 0, 0, 0); } \
            IDX_SB \
            _Pragma("unroll") \
            for (int st = 0; st < 4; ++st) { \
                _Pragma("unroll") \
                for (int tk = 0; tk < 2; ++tk) dd[st][tk] = __builtin_amdgcn_mfma_f32_16x16x32_bf16(qa[tk][1], kf[st][1], dd[st][tk], 0, 0, 0); } \
            IDX_SB \
            u32x4 rb[4]; \
            _Pragma("unroll") \
            for (int st = 0; st < 4; ++st) { \
                rb[st].x = relu_bf16x2(cvt_pk_bf16(dd[st][0][0], dd[st][0][1])); rb[st].y = relu_bf16x2(cvt_pk_bf16(dd[st][0][2], dd[st][0][3])); \
                rb[st].z = relu_bf16x2(cvt_pk_bf16(dd[st][1][0], dd[st][1][1])); rb[st].w = relu_bf16x2(cvt_pk_bf16(dd[st][1][2], dd[st][1][3])); } \
            IDX_SB \
            f32x4 sc[4]; \
            _Pragma("unroll") \
            for (int st = 0; st < 4; ++st) sc[st] = __builtin_amdgcn_mfma_f32_16x16x32_bf16(wa, __builtin_bit_cast(bf16x8, rb[st]), (f32x4){0.f, 0.f, 0.f, 0.f}, 0, 0, 0); \
            IDX_SB \
            if (kt_ == klast) { \
                _Pragma("unroll") \
                for (int st = 0; st < 4; ++st) { \
                    const int s = kt_ * 64 + st * 16 + fr; \
                    float v0 = sc[st][0], v1 = sc[st][1]; \
                    if (s > pw) v0 = -__builtin_inff(); \
                    if (s > pw + 1) v1 = -__builtin_inff(); \
                    if (fq == 0) { scl[s] = v0; scl[2048 + s] = v1; } \
                } \
            } else { \
                _Pragma("unroll") \
                for (int st = 0; st < 4; ++st) if (fq == 0) { scl[kt_ * 64 + st * 16 + fr] = sc[st][0]; scl[2048 + kt_ * 64 + st * 16 + fr] = sc[st][1]; } \
            } \
            if (kt_ + 1 < nkt) *(u32x4*)(ktl + ((kt_ + 1) & 1) * IDX_KT_BYTES + krow * 144 + kch * 16) = KRN; \
            KRN = IDX_LD(kt_ + 5); \
            __syncthreads(); }
        for (int kt = 0; kt < nkt; kt += 4) {
            IDX_TILE(kt, kr1)
            if (kt + 1 >= nkt) break;
            IDX_TILE(kt + 1, kr2)
            if (kt + 2 >= nkt) break;
            IDX_TILE(kt + 2, kr3)
            if (kt + 3 >= nkt) break;
            IDX_TILE(kt + 3, kr0)
        }
#undef IDX_TILE
#undef IDX_LD
        const int kbmax = klast;
#pragma unroll
        for (int tk = 0; tk < 2; ++tk) {
            const int p = pw + tk;
            unsigned u[32];
#pragma unroll
            for (int kb = 0; kb < 32; ++kb) u[kb] = (kb <= kbmax) ? f2sort(scl[tk * 2048 + kb * 64 + lane]) : 0u;
            unsigned thr = 0x00800000u;
            if (p + 1 > 256) {
                unsigned t = 0u;
                for (int bit = 31; bit >= 0; --bit) {
                    const unsigned cand = t | (1u << bit);
                    int n = 0;
#pragma unroll
                    for (int g8 = 0; g8 < 4; ++g8) {
                        if (g8 * 8 <= kbmax) {
#pragma unroll
                            for (int h4 = 0; h4 < 2; ++h4) {
                                unsigned long long m[4];
#pragma unroll
                                for (int kk = 0; kk < 4; ++kk) m[kk] = __ballot(u[g8 * 8 + h4 * 4 + kk] >= cand);
                                IDX_SB
#pragma unroll
                                for (int kk = 0; kk < 4; ++kk) n += __builtin_popcountll(m[kk]);
                                IDX_SB
                            }
                        }
                    }
                    if (n >= 256) t = cand;
                    if (n == 256) break;
                }
                thr = t;
            }
            int word = 0;
#define IDX_W(kb) { const unsigned long long bm = __ballot(u[kb] >= thr); const int lo_ = (int)(unsigned)bm, hi_ = (int)(unsigned)(bm >> 32); WRLANE2(word, lo_, hi_, (kb) * 2); }
            IDX_W(0) IDX_W(1) IDX_W(2) IDX_W(3) IDX_W(4) IDX_W(5) IDX_W(6) IDX_W(7) IDX_W(8) IDX_W(9) IDX_W(10) IDX_W(11) IDX_W(12) IDX_W(13) IDX_W(14) IDX_W(15)
            IDX_W(16) IDX_W(17) IDX_W(18) IDX_W(19) IDX_W(20) IDX_W(21) IDX_W(22) IDX_W(23) IDX_W(24) IDX_W(25) IDX_W(26) IDX_W(27) IDX_W(28) IDX_W(29) IDX_W(30) IDX_W(31)
#undef IDX_W
            MASK[(t0 + tk) * 64 + lane] = (unsigned)word;
        }
#undef IDX_SB
    }
    __syncthreads();
}

constexpr int CV_ZONE = 81920;
__device__ __forceinline__ void cv_issue(int wv, int q) {
    static_assert(F8_L1, "the deferred tiles are fp8");
    const WTile d = wt_decode(wt_l1_tile(q));
    int l; asm volatile("v_mbcnt_lo_u32_b32 %0, -1, 0\n\tv_mbcnt_hi_u32_b32 %0, -1, %0" : "=v"(l));
    const float* sb = lauv(d.src);
    const int ldn = lauv(d.ldn), k0 = lauv(d.k0), n0 = lauv(d.n0), nmax = lauv(d.N) - 4;
#pragma unroll
    for (int j = 0; j < 8; ++j) {
        const int slot = j * 8 + wv, row = slot * 2 + (l >> 5), p = l & 31, c = p ^ ((row >> 4) & 7);
        int col = n0 + c * 4; col = col < nmax ? col : nmax;
        const unsigned voff = (unsigned)((k0 + row) * ldn + col) * 4u;
        const unsigned m0v = (unsigned)(CV_ZONE + slot * 1024);
        unsigned keep;
        asm volatile("s_mov_b32 %0, m0\n\ts_mov_b32 m0, %3\n\ts_nop 0\n\tglobal_load_lds_dwordx4 %1, %2\n\ts_mov_b32 m0, %0" : "=&s"(keep) : "v"(voff), "s"(sb), "s"(m0v) : "memory");
    }
}
__device__ __forceinline__ void cv_consume(int wv, int q, unsigned char* lds) {
    asm volatile("s_waitcnt vmcnt(0)" ::: "memory");
    __syncthreads();
    const WTile d = wt_decode(wt_l1_tile(q));
    const int tid = tid_fresh(wv);
    const float* zone = (const float*)(lds + CV_ZONE);
#pragma unroll
    for (int rep = 0; rep < 2; ++rep) {
        const int item = tid + rep * NT, nl = item >> 3, kc = item & 7, n = d.n0 + nl;
        if (n < d.N) {
            float f[16];
#pragma unroll
            for (int j = 0; j < 16; ++j) f[j] = zone[(kc * 16 + j) * 128 + ((nl >> 2) ^ kc) * 4 + (nl & 3)];
            const int row = wt_row(d, n);
            u32x4 o;
            o.x = pack_fp8x4(f[0] * W8_SCALE, f[1] * W8_SCALE, f[2] * W8_SCALE, f[3] * W8_SCALE); o.y = pack_fp8x4(f[4] * W8_SCALE, f[5] * W8_SCALE, f[6] * W8_SCALE, f[7] * W8_SCALE);
            o.z = pack_fp8x4(f[8] * W8_SCALE, f[9] * W8_SCALE, f[10] * W8_SCALE, f[11] * W8_SCALE); o.w = pack_fp8x4(f[12] * W8_SCALE, f[13] * W8_SCALE, f[14] * W8_SCALE, f[15] * W8_SCALE);
            *(GAS u32x4*)(d.dst + (size_t)row * d.ldk + d.k0 + kc * 16) = o;
        }
    }
    __syncthreads();
}
__device__ __forceinline__ void attn_phase(int wv, const unsigned char* proj, const unsigned* __restrict__ MASK, const float* __restrict__ q_norm, const float* __restrict__ k_norm, const float* __restrict__ rel_bias,
                           bf16_t* __restrict__ AO, unsigned char* lds) {
    const int tid = tid_fresh(wv), lane = tid & 63, w = wv  , fr = lane & 15, fq = lane >> 4;
    int vz = 0; asm volatile("" : "+v"(vz));
    const bf16_t* Q1 = (const bf16_t*)(proj + PJ_Q1); const bf16_t* Kn = (const bf16_t*)(proj + PJ_KN); const bf16_t* VT = (const bf16_t*)(proj + PJ_VT1);
    constexpr int ATT_BUF = 17408 + 18432;
    bf16_t* K_lds = (bf16_t*)lds;
    bf16_t* V_lds = (bf16_t*)(lds + 17408);
    float* bt = (float*)(lds + 2 * ATT_BUF);
    const float LOG2E = 1.4426950408889634f;
    float mq = 0.f, mk = 0.f;
    {
        mq = fmaxf(fabsf(q_norm[lane]), fabsf(q_norm[lane + 64])); mk = fmaxf(fabsf(k_norm[lane]), fabsf(k_norm[lane + 64]));
#pragma unroll
        for (int o = 32; o >= 1; o >>= 1) { mq = fmaxf(mq, shx(mq, o, lane)); mk = fmaxf(mk, shx(mk, o, lane)); }
    }
    const float Mb2 = 11.313708499f * mq * mk * LOG2E;
    __syncthreads();
    for (int i = tid; i < 128 * 16; i += NT) {
        const int d = i >> 4, h = i & 15;
        int bk = d;
        if (d >= 16) { bk = 16 + (int)(logf((float)d / 16.0f) / 2.0794415416798357f * 16.0f); bk = bk > 31 ? 31 : bk; }
        bt[i] = (rel_bias[bk * 16 + h] - rel_bias[31 * 16 + h]) * LOG2E;
    }
    __syncthreads();
    const int nunits = NB * 128;
    int cvq = blockIdx.x, cvcur = -1;
#define CV_STEP do { if (cvcur >= 0) { cv_consume(wv, cvcur, lds); cvcur = -1; } if (cvq < WT_L1) { cv_issue(wv, cvq); cvcur = cvq; cvq += (int)gridDim.x; } } while (0)
    for (int uu = blockIdx.x; uu < nunits; uu += gridDim.x) {
        int b, q16;
        if (gridDim.x == 256) { b = blockIdx.x >> 4; const int r = blockIdx.x & 15, k = (uu - blockIdx.x) / 256; q16 = (k & 1) ? (k >> 1) * 32 + 31 - r : (k >> 1) * 32 + r; }
        else { b = uu >> 7; q16 = uu & 127; }
        const int p0 = q16 * 16;
        const size_t tb = (size_t)b * NS;
        CV_STEP;
        v8i qf[2];
#pragma unroll
        for (int tk = 0; tk < 2; ++tk) {
            const size_t t = tb + p0 + 2 * w + tk;
            float f[32]; float ss = 0.f;
#pragma unroll
            for (int i = 0; i < 2; ++i) {
                const u32x4 v = *(const u32x4*)((const unsigned char*)Q1 + t * 2048 + fr * 128 + fq * 32 + i * 16);
                const int wds[4] = {(int)v.x, (int)v.y, (int)v.z, (int)v.w};
#pragma unroll
                for (int q4 = 0; q4 < 4; ++q4) {
                    f[i * 16 + q4 * 4 + 0] = __builtin_amdgcn_cvt_f32_fp8(wds[q4], 0); f[i * 16 + q4 * 4 + 1] = __builtin_amdgcn_cvt_f32_fp8(wds[q4], 1);
                    f[i * 16 + q4 * 4 + 2] = __builtin_amdgcn_cvt_f32_fp8(wds[q4], 2); f[i * 16 + q4 * 4 + 3] = __builtin_amdgcn_cvt_f32_fp8(wds[q4], 3);
                }
            }
#pragma unroll
            for (int i = 0; i < 32; ++i) ss += f[i] * f[i];
            ss += shx(ss, 16, lane); ss += shx(ss, 32, lane);
            const float rs = rsqrtf(ss * (1.0f / (128.0f * Q8_SCALE * Q8_SCALE)) + RMS_EPS) * (0.08838834764831845f * LOG2E * ATT_QS / Q8_SCALE);
            const float* qn = q_norm + fq * 32;
#pragma unroll
            for (int i = 0; i < 8; ++i) qf[tk][i] = (int)pack_fp8x4(f[i * 4 + 0] * rs * qn[i * 4 + 0], f[i * 4 + 1] * rs * qn[i * 4 + 1], f[i * 4 + 2] * rs * qn[i * 4 + 2], f[i * 4 + 3] * rs * qn[i * 4 + 3]);
        }
        f32x4 oacc[2][8];
#pragma unroll
        for (int tk = 0; tk < 2; ++tk)
#pragma unroll
            for (int dt = 0; dt < 8; ++dt) oacc[tk][dt] = (f32x4){0.f, 0.f, 0.f, 0.f};
        float lsum[2] = {0.f, 0.f};
        const int nkt = (p0 >> 6) + 1;
        const int kr0 = tid >> 3, kc0 = tid & 7, vr0 = tid >> 4, vc0 = tid & 15;
        const unsigned char* kgp = (const unsigned char*)Kn + (tb + kr0) * 128 + kc0 * 16;
        const bf16_t* vgp = VT + (tb + vr0) * 128 + vc0 * 8;
        const unsigned* mp0 = MASK + (tb + p0 + 2 * w) * 64 + vz;
        u32x4 kreg, vreg[2]; unsigned mreg[2][2];
        kreg = *(const u32x4*)(kgp);
        vreg[0] = *(const u32x4*)(vgp); vreg[1] = *(const u32x4*)(vgp + 32 * 128);
        mreg[0][0] = mp0[0]; mreg[0][1] = mp0[1]; mreg[1][0] = mp0[64]; mreg[1][1] = mp0[65];
        __syncthreads();
        *(u32x4*)((unsigned char*)K_lds + kr0 * 144 + kc0 * 16) = kreg;
        *(u32x4*)(V_lds + vr0 * 144 + vc0 * 8) = vreg[0]; *(u32x4*)(V_lds + (vr0 + 32) * 144 + vc0 * 8) = vreg[1];
        __syncthreads();
        for (int kt = 0; kt < nkt; ++kt) {
            const int s0 = kt * 64;
            const bf16_t* Kc = K_lds + (kt & 1) * (ATT_BUF / 2); const bf16_t* Vc = V_lds + (kt & 1) * (ATT_BUF / 2);
            const unsigned m00 = mreg[0][0], m01 = mreg[0][1], m10 = mreg[1][0], m11 = mreg[1][1];
            if (kt + 1 < nkt) {
                kreg = *(const u32x4*)(kgp + (size_t)(s0 + 64) * 128);
                vreg[0] = *(const u32x4*)(vgp + (size_t)(s0 + 64) * 128); vreg[1] = *(const u32x4*)(vgp + (size_t)(s0 + 64 + 32) * 128);
                mreg[0][0] = mp0[2 * kt + 2]; mreg[0][1] = mp0[2 * kt + 3]; mreg[1][0] = mp0[64 + 2 * kt + 2]; mreg[1][1] = mp0[64 + 2 * kt + 3];
            }
            const bool use_bias = (s0 + 63 + 128 > p0);
            f32x4 dA[2], dB[2]; unsigned pk[4][2][2];
            auto s_sub = [&](int sub, f32x4 (&d)[2]) {
                const unsigned char* kp = (const unsigned char*)Kc + (sub * 16 + fr) * 144 + fq * 32;
                const i32x4 klo = *(const i32x4*)kp, khi = *(const i32x4*)(kp + 16);
                const v8i kf = __builtin_shufflevector(klo, khi, 0, 1, 2, 3, 4, 5, 6, 7);
#pragma unroll
                for (int tk = 0; tk < 2; ++tk) {
                    d[tk] = (f32x4){-Mb2 * (ATT_QS * ATT_KS), -Mb2 * (ATT_QS * ATT_KS), -Mb2 * (ATT_QS * ATT_KS), -Mb2 * (ATT_QS * ATT_KS)};
                    d[tk] = __builtin_amdgcn_mfma_scale_f32_16x16x128_f8f6f4(kf, qf[tk], d[tk], 0, 0, 0, 0, 0, 0);
                }
            };
            auto soft = [&](int sub, const f32x4 (&d)[2]) {
#pragma unroll
                for (int tk = 0; tk < 2; ++tk) {
                    const int p = p0 + 2 * w + tk;
                    const unsigned mw = (sub < 2) ? (tk ? m10 : m00) : (tk ? m11 : m01);
                    const unsigned nib = (mw >> ((sub & 1) * 16 + fq * 4)) & 15u;
                    float pv[4];
                    f32x4 xx = d[tk] * (1.0f / (ATT_QS * ATT_KS));
                    if (use_bias) {
#pragma unroll
                        for (int j = 0; j < 4; ++j) { const int dd = p - (s0 + sub * 16 + fq * 4 + j); if (dd >= 0 && dd < 128) xx[j] += bt[dd * 16 + fr]; }
                    }
#pragma unroll
                    for (int j = 0; j < 4; ++j) {
                        const float x = xx[j];
                        float e = __builtin_amdgcn_exp2f(x);
                        e = ((nib >> j) & 1u) ? e : 0.f;
                        lsum[tk] += e; pv[j] = e;
                    }
                    pk[sub][tk][0] = cvt_pk_bf16(pv[0], pv[1]); pk[sub][tk][1] = cvt_pk_bf16(pv[2], pv[3]);
                }
            };
            auto pv_pair = [&](int kk) {
                bf16x8 pfr[2];
#pragma unroll
                for (int tk = 0; tk < 2; ++tk) { u32x4 a0; a0.x = pk[2 * kk][tk][0]; a0.y = pk[2 * kk][tk][1]; a0.z = pk[2 * kk + 1][tk][0]; a0.w = pk[2 * kk + 1][tk][1]; pfr[tk] = __builtin_bit_cast(bf16x8, a0); }
#pragma unroll
                for (int dt = 0; dt < 8; ++dt) {
                    const bf16_t* vp = Vc + ((2 * kk) * 16 + fq * 4 + (fr >> 2)) * 144 + dt * 16 + (fr & 3) * 4;
                    const s16x4_t va = __builtin_amdgcn_ds_read_tr16_b64_v4i16((__attribute__((address_space(3))) s16x4_t*)(vp));
                    const s16x4_t vb = __builtin_amdgcn_ds_read_tr16_b64_v4i16((__attribute__((address_space(3))) s16x4_t*)(vp + 16 * 144));
                    const bf16x8 vf = __builtin_bit_cast(bf16x8, __builtin_shufflevector(va, vb, 0, 1, 2, 3, 4, 5, 6, 7));
#pragma unroll
                    for (int tk = 0; tk < 2; ++tk) oacc[tk][dt] = __builtin_amdgcn_mfma_f32_16x16x32_bf16(vf, pfr[tk], oacc[tk][dt], 0, 0, 0);
                }
            };
            s_sub(0, dA);
            __builtin_amdgcn_sched_barrier(0);
            s_sub(1, dB); soft(0, dA);
            __builtin_amdgcn_sched_barrier(0);
            s_sub(2, dA); soft(1, dB); pv_pair(0);
            __builtin_amdgcn_sched_barrier(0);
            s_sub(3, dB); soft(2, dA);
            __builtin_amdgcn_sched_barrier(0);
            soft(3, dB); pv_pair(1);
            __builtin_amdgcn_sched_barrier(0);
            if (kt + 1 < nkt) {
                bf16_t* Kn_ = K_lds + ((kt + 1) & 1) * (ATT_BUF / 2); bf16_t* Vn_ = V_lds + ((kt + 1) & 1) * (ATT_BUF / 2);
                *(u32x4*)((unsigned char*)Kn_ + kr0 * 144 + kc0 * 16) = kreg;
                *(u32x4*)(Vn_ + vr0 * 144 + vc0 * 8) = vreg[0]; *(u32x4*)(Vn_ + (vr0 + 32) * 144 + vc0 * 8) = vreg[1];
            }
            __syncthreads();
            if ((kt & 3) == 3) CV_STEP;
        }
#pragma unroll
        for (int tk = 0; tk < 2; ++tk) {
            float l = lsum[tk];
            l += shx(l, 16, lane); l += shx(l, 32, lane);
            const float il = 1.0f / l;
            const size_t ob = (tb + p0 + 2 * w + tk) * 2048 + fr * 128 + fq * 4;
#pragma unroll
            for (int dt = 0; dt < 8; ++dt) {
                const f32x4 o = oacc[tk][dt] * il;
                if (F8_L1) *(unsigned*)((unsigned char*)AO + ob + dt * 16) = pack_fp8x4(o[0] * Y8_SCALE, o[1] * Y8_SCALE, o[2] * Y8_SCALE, o[3] * Y8_SCALE);
                else st_bf16x4(AO + ob + dt * 16, o);
            }
        }
    }
    while (cvcur >= 0 || cvq < WT_L1) CV_STEP;
#undef CV_STEP
    __syncthreads();
}

#ifndef DUPMASK
#define DUPMASK 0
#endif
#define REPS(k) (((DUPMASK >> (k)) & 1) ? 2 : 1)

__device__ __forceinline__ unsigned char* opq(unsigned char* p) { asm volatile("" : "+s"(p)); return p; }

__global__ void __launch_bounds__(NT, 2) fwd(Args a_unused) {
    extern __shared__ __attribute__((aligned(16))) unsigned char lds[];
    volatile LAS unsigned* misc = (volatile LAS unsigned*)(lds + LDS_MISC);
    const int wv = __builtin_amdgcn_readfirstlane((int)(threadIdx.x >> 6));
    { const int t0 = tid_fresh(wv); if (t0 < 4) misc[t0] = 0u; }
    __syncthreads();
    XcdBarrier bar = xcd_barrier_post((unsigned*)(KA().ws() + WS_CTL), misc, wv);
    const int G = gridDim.x, bx = blockIdx.x;

    for (int rep = 0; rep < REPS(0); ++rep) { p0_prologue(wv, lds); xcd_barrier(bar); }

    for (int rep = 0; rep < REPS(1); ++rep) {
        const KA a; unsigned char* ws = a.ws();
        norm_phase<false, false, F8_P2, false, F8_P2_MIX>(wv, a.in(I_X), nullptr, a.in(I_NORM_MIX), (const float*)(ws + WS_MOD) + 0 * 16 * 6144, (bf16_t*)(ws + WS_H), lds, nullptr, nullptr, nullptr, nullptr, nullptr);
        xcd_barrier(bar);
    }
    for (int rep = 0; rep < REPS(2); ++rep) {
        const KA a; unsigned char* ws = a.ws();
        const int nM = NTOK / BM, nN = N_IN0 / BM;
        for (int k = 0, u = unit_index(0); u < nM * nN; u = unit_index(++k)) {
            int pm, pn; dense_tile(u, nN, pm, pn);
            RowPlain ro{(unsigned)(pm * BM) * ND, (unsigned)ND};
            const bool t8 = F8_P2 || (((unsigned)F8_P2_TILES >> pn) & 1u) != 0u;
            EpiIn0 E{ws + WS_PROJ, (const float2*)(ws + WS_ROT), pm, pn, (LAS bf16_t*)lds, wv, t8 ? 1.0f / W8_SCALE : 1.0f};
            if (t8) { RowPlain r8{(unsigned)(pm * BM) * (ND / 2), (unsigned)(ND / 2)};
                      gemm_unit<true>(wv, (bf16_t*)lds, (const bf16_t*)(F8_P2 ? ws + WS_H : ws + WS_H8), r8, (const bf16_t*)(ws + WS_WIN0F8 + (size_t)pn * BM * ND), ND / 2, ND / 2, E); }
            else gemm_unit<false>(wv, (bf16_t*)lds, (const bf16_t*)(ws + WS_H), ro, (const bf16_t*)(ws + WS_WIN0) + (size_t)pn * BM * ND, ND, ND, E);
        }
        xcd_barrier(bar);
    }
    for (int rep = 0; rep < REPS(3); ++rep) { const KA a; unsigned char* ws = a.ws(); retention_phase(wv, ws + WS_PROJ, (bf16_t*)(ws + WS_O), lds); xcd_barrier(bar); }
    for (int rep = 0; rep < REPS(4); ++rep) { const KA a; unsigned char* ws = a.ws(); ycat_phase(wv, ws + WS_PROJ, (const bf16_t*)(ws + WS_O), a.in(I_CONVW), a.in(I_CONVB), (bf16_t*)(ws + WS_H)); xcd_barrier(bar); }
    for (int rep = 0; rep < REPS(5); ++rep) {
        const KA a; unsigned char* ws = a.ws();
        const int nM = NTOK / BM, nN = ND / BM;
        for (int k = 0, u = unit_index(0); u < nM * nN; u = unit_index(++k)) {
            int pm, pn; dense_tile(u, nN, pm, pn);
            RowPlain ro{(unsigned)(pm * BM) * ND, (unsigned)ND};
            EpiRes<false, true> E{a.in(I_X), nullptr, (bf16_t*)(ws + WS_XB), (const float*)(ws + WS_MOD) + 0 * 16 * 6144 + 4096, pm, pn, F8_P5 ? 1.0f / (W8_SCALE * Y8_SCALE) : 1.0f};
            if (F8_P5) { RowPlain r8{(unsigned)(pm * BM) * (ND / 2), (unsigned)(ND / 2)}; gemm_unit<true>(wv, (bf16_t*)lds, (const bf16_t*)(ws + WS_H), r8, (const bf16_t*)(ws + WS_WOUT0 + (size_t)pn * BM * ND), ND / 2, ND / 2, E); }
            else gemm_unit<false>(wv, (bf16_t*)lds, (const bf16_t*)(ws + WS_H), ro, (const bf16_t*)(ws + WS_WOUT0) + (size_t)pn * BM * ND, ND, ND, E);
        }
        xcd_barrier(bar);
    }
    {
        const KA a; unsigned char* ws = a.ws();
        route_phase(wv, (const bf16_t*)(ws + WS_XB), a.in(I_NORM_FFN), (const float*)(ws + WS_MOD) + 1 * 16 * 6144, ws + WS_H, lds, a.in(I_WR), a.in(I_BR), (unsigned*)(ws + WS_CTL + CTL_CNT + 0 * 4096), (int*)(ws + WS_IDX), (float*)(ws + WS_GT));
        xcd_barrier(bar);
    }
    for (int rep = 0; rep < REPS(7); ++rep) { moe_phase1(wv, KA().ws(), 0, lds); xcd_barrier(bar); }
    { moe_phase2(wv, KA().ws(), 0, lds); xcd_barrier(bar); }

    for (int rep = 0; rep < REPS(9); ++rep) {
        const KA a; unsigned char* ws = a.ws();
        norm_phase<true, false, F8_L1 != 0, true, false, true>(wv, ws + WS_XB, (const bf16_t*)(ws + WS_TMP), a.in(I_NORM_MIX) + ND, (const float*)(ws + WS_MOD) + 2 * 16 * 6144, (bf16_t*)(ws + WS_H), lds, nullptr, nullptr, nullptr, nullptr, nullptr, (const bf16_t*)(ws + WS_TMP + 64 * MiB), (const float*)(ws + WS_MOD) + 1 * 16 * 6144 + 4096);
        xcd_barrier(bar);
    }
    for (int rep = 0; rep < REPS(10); ++rep) {
        const int nM = NTOK / BM, nN = N_IN1P / BM;
        for (int k = 0, u = unit_index(0); u < nM * nN; u = unit_index(++k)) {
            const KA a; unsigned char* ws = a.ws();
            int pm, pn; dense_tile(u, nN, pm, pn);
            RowPlain ro{(unsigned)(pm * BM) * ND, (unsigned)ND};
            EpiIn1 E{ws + WS_PROJ, pm, pn, F8_L1 ? 1.0f / W8_SCALE : 1.0f};
            if (F8_L1) { RowPlain r8{(unsigned)(pm * BM) * (ND / 2), (unsigned)(ND / 2)}; gemm_unit<true>(wv, (bf16_t*)lds, (const bf16_t*)(ws + WS_H), r8, (const bf16_t*)(ws + WS_WIN1 + (size_t)pn * BM * ND), ND / 2, ND / 2, E); }
            else gemm_unit<false>(wv, (bf16_t*)lds, (const bf16_t*)(ws + WS_H), ro, (const bf16_t*)(ws + WS_WIN1) + (size_t)pn * BM * ND, ND, ND, E);
        }
        xcd_barrier(bar);
    }
    for (int rep = 0; rep < REPS(11); ++rep) {
        const KA a; unsigned char* ws = a.ws();
        knorm_phase(wv, ws + WS_PROJ, a.in(I_KN), (bf16_t*)(ws + WS_PROJ + PJ_KN));
        indexer_phase(wv, ws + WS_PROJ, (unsigned*)(ws + WS_MASK), lds);
        xcd_barrier(bar);
    }
    for (int rep = 0; rep < REPS(12); ++rep) { const KA a; unsigned char* ws = a.ws(); attn_phase(wv, ws + WS_PROJ, (const unsigned*)(ws + WS_MASK), a.in(I_QN), a.in(I_KN), a.in(I_RELB), (bf16_t*)(ws + WS_H), lds); xcd_barrier(bar); }
    {
        const KA a; unsigned char* ws = a.ws();
        const int nM = NTOK / BM, nN = ND / BM;
        for (int k = 0, u = unit_index(0); u < nM * nN; u = unit_index(++k)) {
            int pm, pn; dense_tile(u, nN, pm, pn);
            RowPlain ro{(unsigned)(pm * BM) * ND, (unsigned)ND};
            EpiRes<false, false> E{ws + WS_XB, nullptr, (bf16_t*)(ws + WS_XB), (const float*)(ws + WS_MOD) + 2 * 16 * 6144 + 4096, pm, pn, F8_L1 ? 1.0f / (W8_SCALE * Y8_SCALE) : 1.0f};
            if (F8_L1) { RowPlain r8{(unsigned)(pm * BM) * (ND / 2), (unsigned)(ND / 2)}; gemm_unit<true>(wv, (bf16_t*)lds, (const bf16_t*)(ws + WS_H), r8, (const bf16_t*)(ws + WS_WOUT1 + (size_t)pn * BM * ND), ND / 2, ND / 2, E); }
            else gemm_unit<false>(wv, (bf16_t*)lds, (const bf16_t*)(ws + WS_H), ro, (const bf16_t*)(ws + WS_WOUT1) + (size_t)pn * BM * ND, ND, ND, E);
        }
        xcd_barrier(bar);
    }
    {
        const KA a; unsigned char* ws = a.ws();
        route_phase(wv, (const bf16_t*)(ws + WS_XB), a.in(I_NORM_FFN) + ND, (const float*)(ws + WS_MOD) + 3 * 16 * 6144, ws + WS_H, lds, a.in(I_WR), a.in(I_BR), (unsigned*)(ws + WS_CTL + CTL_CNT + 1 * 4096), (int*)(ws + WS_IDX), (float*)(ws + WS_GT));
        xcd_barrier(bar);
    }
    { moe_phase1(wv, KA().ws(), 1, lds); xcd_barrier(bar); }
    { moe_phase2(wv, KA().ws(), 1, lds); xcd_barrier(bar); }
    {
        const KA a; unsigned char* ws = a.ws();
        const bf16_t* tp = (const bf16_t*)(ws + WS_TMP); const bf16_t* xp = (const bf16_t*)(ws + WS_XB); f32x4* op = (f32x4*)a.out();
        const unsigned char* tp8 = (const unsigned char*)tp;
        constexpr int U = 4;
        const size_t n8 = (size_t)NTOK * ND / 8, stride = (size_t)G * NT;
        for (size_t i = (size_t)bx * NT + tid_fresh(wv); i < n8; i += U * stride) {
            u32x4 xv[U]; u32x2 tv[U], tw[U]; f32x4 g0[U], g1[U];
#pragma unroll
            for (int j = 0; j < U; ++j) {
                const size_t q = i + j * stride, ii = q < n8 ? q : i;
                xv[j] = *(const u32x4*)(xp + ii * 8); tv[j] = *(const u32x2*)(tp8 + ii * 8); tw[j] = *(const u32x2*)(tp8 + 64 * MiB + ii * 8);
                const float* gp = (const float*)(ws + WS_MOD) + 3 * 16 * 6144 + 4096 + (size_t)((ii * 8) >> 22) * 6144 + ((ii * 8) & 2047);
                g0[j] = *(const f32x4*)gp * (1.0f / T8_SCALE); g1[j] = *(const f32x4*)(gp + 4) * (1.0f / T8_SCALE);
            }
#pragma unroll
            for (int j = 0; j < U; ++j) {
                const size_t q = i + j * stride;
                f32x4 a0, a1;
                a0[0] = bflo(xv[j].x) + (__builtin_amdgcn_cvt_f32_fp8((int)tv[j].x, 0) + __builtin_amdgcn_cvt_f32_fp8((int)tw[j].x, 0)) * g0[j][0]; a0[1] = bfhi(xv[j].x) + (__builtin_amdgcn_cvt_f32_fp8((int)tv[j].x, 1) + __builtin_amdgcn_cvt_f32_fp8((int)tw[j].x, 1)) * g0[j][1];
                a0[2] = bflo(xv[j].y) + (__builtin_amdgcn_cvt_f32_fp8((int)tv[j].x, 2) + __builtin_amdgcn_cvt_f32_fp8((int)tw[j].x, 2)) * g0[j][2]; a0[3] = bfhi(xv[j].y) + (__builtin_amdgcn_cvt_f32_fp8((int)tv[j].x, 3) + __builtin_amdgcn_cvt_f32_fp8((int)tw[j].x, 3)) * g0[j][3];
                a1[0] = bflo(xv[j].z) + (__builtin_amdgcn_cvt_f32_fp8((int)tv[j].y, 0) + __builtin_amdgcn_cvt_f32_fp8((int)tw[j].y, 0)) * g1[j][0]; a1[1] = bfhi(xv[j].z) + (__builtin_amdgcn_cvt_f32_fp8((int)tv[j].y, 1) + __builtin_amdgcn_cvt_f32_fp8((int)tw[j].y, 1)) * g1[j][1];
                a1[2] = bflo(xv[j].w) + (__builtin_amdgcn_cvt_f32_fp8((int)tv[j].y, 2) + __builtin_amdgcn_cvt_f32_fp8((int)tw[j].y, 2)) * g1[j][2]; a1[3] = bfhi(xv[j].w) + (__builtin_amdgcn_cvt_f32_fp8((int)tv[j].y, 3) + __builtin_amdgcn_cvt_f32_fp8((int)tw[j].y, 3)) * g1[j][3];
                if (q < n8) { op[q * 2] = a0; op[q * 2 + 1] = a1; }
            }
        }
    }
}

extern "C" void kernel_launch(void* const* d_in, const int* in_sizes, int n_in, void* d_out, int out_size, void* d_ws, size_t ws_size, hipStream_t stream) {
    static int grid = 0;
    if (grid == 0) {
        int dev = 0, cus = 0, per_cu = 0;
        if (n_in != 22 || ws_size < WS_END) { fprintf(stderr, "kernel_launch: unexpected n_in %d / ws_size %zu (need %zu)\n", n_in, ws_size, (size_t)WS_END); grid = -1; return; }
        (void)hipGetDevice(&dev);
        (void)hipDeviceGetAttribute(&cus, hipDeviceAttributeMultiprocessorCount, dev);
        if (hipFuncSetAttribute((const void*)fwd, hipFuncAttributeMaxDynamicSharedMemorySize, LDS_BYTES) != hipSuccess) { fprintf(stderr, "kernel_launch: hipFuncSetAttribute failed\n"); grid = -1; return; }
        (void)hipOccupancyMaxActiveBlocksPerMultiprocessor(&per_cu, (const void*)fwd, NT, LDS_BYTES);
        (void)hipGetLastError();
        if (per_cu < 1) fprintf(stderr, "kernel_launch: occupancy query reports %d\n", per_cu);
        grid = cus;
    }
    if (grid < 0) return;
    (void)hipMemsetAsync((char*)d_ws + WS_CTL, 0, 65536 + 4 * 16 * 6144 * 4, stream);
    Args a{};
    for (int i = 0; i < 22; ++i) a.in[i] = (const float*)d_in[i];
    a.out = (float*)d_out; a.ws = (unsigned char*)d_ws;
    hipLaunchKernelGGL(fwd, dim3(grid), dim3(NT), LDS_BYTES, stream, a);
}
```
